# Optimizing an MI355X kernel written in HIP

```python
import math
import jax, jax.numpy as jnp
from jax import lax
import numpy as np

D_MODEL = 1024
BATCH = 16
SEQ = 2048
DEPTH = 2

EPS = 1e-6
Q_BLOCK = 128
RET_HEADS = 4
RET_DK = 128
RET_DV = 256
RET_CHUNK = 128
DIFF_HEADS = 8
DIFF_DH = 64
MLA_HEADS = 16
MLA_Q_LORA = 256
MLA_KV_LORA = 128
MLA_NOPE = 64
MLA_ROPE = 32
MLA_V = 64
ROPE_THETA = 10000.0
REL_BUCKETS = 32
REL_MAX_DIST = 128
D_FF = 4 * D_MODEL
N_BRANCH = 3

RET_QK_W = RET_HEADS * RET_DK
RET_V_W = RET_HEADS * RET_DV
DIFF_QK_W = 2 * DIFF_HEADS * DIFF_DH
DIFF_V_W = DIFF_HEADS * 2 * DIFF_DH
MLA_QH = MLA_NOPE + MLA_ROPE
MLA_KVH = MLA_NOPE + MLA_V
MLA_V_W = MLA_HEADS * MLA_V
IN_SPLITS = (RET_QK_W, RET_QK_W, RET_V_W, RET_V_W,
             DIFF_QK_W, DIFF_QK_W, DIFF_V_W,
             MLA_Q_LORA, MLA_KV_LORA, MLA_ROPE,
             N_BRANCH * D_MODEL)
D_IN = sum(IN_SPLITS)

kernel_name = 'hybrid_gated_retention_diffattn_mla_block'


def rms_norm(x, g=None):
    xf = x.astype(jnp.float32)
    y = xf * lax.rsqrt(jnp.mean(xf * xf, axis=-1, keepdims=True) + EPS)
    if g is not None:
        y = y * g.astype(jnp.float32)
    return y.astype(x.dtype)


def rope_tables(inv_freq):
    pos = jnp.arange(SEQ, dtype=jnp.float32)
    ang = pos[:, None] * inv_freq[None, :]
    return jnp.cos(ang), jnp.sin(ang)


def apply_rope(x, cos, sin):
    d2 = x.shape[-1] // 2
    x1, x2 = x[..., :d2], x[..., d2:]
    c = cos[:, None, :].astype(x.dtype)
    s = sin[:, None, :].astype(x.dtype)
    return jnp.concatenate([x1 * c - x2 * s, x2 * c + x1 * s], axis=-1)


def t5_bucket(n):
    max_exact = REL_BUCKETS // 2
    nf = jnp.maximum(n, 1).astype(jnp.float32)
    large = max_exact + (jnp.log(nf / max_exact) / math.log(REL_MAX_DIST / max_exact)
                         * (REL_BUCKETS - max_exact)).astype(jnp.int32)
    large = jnp.minimum(large, REL_BUCKETS - 1)
    return jnp.where(n < max_exact, n, large)


def retention(q, k, v):
    b = q.shape[0]
    n_chunks = SEQ // RET_CHUNK

    def chunks(t):
        return t.reshape(b, n_chunks, RET_CHUNK, RET_HEADS, t.shape[-1]).transpose(1, 0, 3, 2, 4)

    log_g = jnp.log1p(-jnp.exp2(-5.0 - jnp.arange(RET_HEADS, dtype=jnp.float32)))
    idx = jnp.arange(RET_CHUNK, dtype=jnp.float32)
    rel = idx[:, None] - idx[None, :]
    dmask = jnp.where(rel >= 0, jnp.exp(jnp.maximum(rel, 0.0)[None] * log_g[:, None, None]), 0.0)
    xi = jnp.exp((idx + 1.0)[None, :] * log_g[:, None])[:, :, None]
    zeta = jnp.exp((RET_CHUNK - 1.0 - idx)[None, :] * log_g[:, None])[:, :, None]
    g_chunk = jnp.exp(RET_CHUNK * log_g)[:, None, None]

    def step(state, qkv):
        qc, kc, vc = qkv
        inner = jnp.einsum('bhid,bhjd->bhij', qc, kc) * dmask
        out = (jnp.einsum('bhij,bhje->bhie', inner, vc)
               + jnp.einsum('bhid,bhde->bhie', qc * xi, state))
        state = g_chunk * state + jnp.einsum('bhjd,bhje->bhde', kc * zeta, vc)
        return state, out

    state0 = jnp.zeros((b, RET_HEADS, RET_DK, RET_DV), jnp.float32)
    _, o = lax.scan(step, state0, (chunks(q), chunks(k), chunks(v)))
    return o.transpose(1, 0, 3, 2, 4).reshape(b, SEQ, RET_HEADS, RET_DV)


def diff_attention(q, k, v, lam, rel_bias):
    scale = DIFF_DH ** -0.5
    kpos = jnp.arange(SEQ)

    def block(i):
        q0 = i * Q_BLOCK
        qb = lax.dynamic_slice_in_dim(q, q0, Q_BLOCK, axis=1)
        dist = (q0 + jnp.arange(Q_BLOCK))[:, None] - kpos[None, :]
        bias = rel_bias[t5_bucket(jnp.maximum(dist, 0))].astype(jnp.float32)
        logits = (jnp.einsum('bqhcd,bkhcd->bhcqk', qb, k).astype(jnp.float32) * scale
                  + jnp.transpose(bias, (2, 0, 1))[None, :, None])
        logits = jnp.where(dist >= 0, logits, -jnp.inf)
        p = jax.nn.softmax(logits, axis=-1)
        a = p[:, :, 0] - lam * p[:, :, 1]
        return jnp.einsum('bhqk,bkhe->bqhe', a.astype(v.dtype), v)

    out = lax.map(block, jnp.arange(SEQ // Q_BLOCK))
    return jnp.swapaxes(out, 0, 1).reshape(v.shape)


def mla_attention(q_nope, q_pe, k_nope, k_pe, v):
    scale = MLA_QH ** -0.5
    kpos = jnp.arange(SEQ)

    def block(i):
        q0 = i * Q_BLOCK
        qn = lax.dynamic_slice_in_dim(q_nope, q0, Q_BLOCK, axis=1)
        qp = lax.dynamic_slice_in_dim(q_pe, q0, Q_BLOCK, axis=1)
        dist = (q0 + jnp.arange(Q_BLOCK))[:, None] - kpos[None, :]
        logits = (jnp.einsum('bqhd,bkhd->bhqk', qn, k_nope)
                  + jnp.einsum('bqhd,bkd->bhqk', qp, k_pe)).astype(jnp.float32) * scale
        logits = jnp.where(dist >= 0, logits, -jnp.inf)
        p = jax.nn.softmax(logits, axis=-1)
        return jnp.einsum('bhqk,bkhe->bqhe', p.astype(v.dtype), v)

    out = lax.map(block, jnp.arange(SEQ // Q_BLOCK))
    return jnp.swapaxes(out, 0, 1).reshape(v.shape)


def setup_inputs(seed: int = 0) -> dict:
    key = jax.random.key(seed)
    ks = jax.random.split(key, 32)
    f32 = jnp.float32

    def w(k, shape, fan_in):
        return jax.random.normal(k, shape, f32) * fan_in ** -0.5

    def gain(k, shape):
        return 1.0 + 0.05 * jax.random.normal(k, shape, f32)

    L = DEPTH
    return {
        'x': jax.random.normal(ks[0], (BATCH, SEQ, D_MODEL), f32),
        'rel_bias': 0.5 * jax.random.normal(ks[1], (REL_BUCKETS, DIFF_HEADS), f32),
        'pre_mix_g': gain(ks[2], (L, D_MODEL)),
        'w_in': w(ks[3], (L, D_MODEL, D_IN), D_MODEL),
        'w_ret_o': w(ks[4], (L, RET_V_W, D_MODEL), RET_V_W),
        'lambda_q1': 0.1 * jax.random.normal(ks[5], (L, DIFF_DH), f32),
        'lambda_k1': 0.1 * jax.random.normal(ks[6], (L, DIFF_DH), f32),
        'lambda_q2': 0.1 * jax.random.normal(ks[7], (L, DIFF_DH), f32),
        'lambda_k2': 0.1 * jax.random.normal(ks[8], (L, DIFF_DH), f32),
        'diff_subln_g': gain(ks[9], (L, 2 * DIFF_DH)),
        'w_diff_o': w(ks[10], (L, DIFF_V_W, D_MODEL), DIFF_V_W),
        'mla_q_norm_g': gain(ks[11], (L, MLA_Q_LORA)),
        'w_mla_uq': w(ks[12], (L, MLA_Q_LORA, MLA_HEADS * MLA_QH), MLA_Q_LORA),
        'mla_kv_norm_g': gain(ks[13], (L, MLA_KV_LORA)),
        'w_mla_ukv': w(ks[14], (L, MLA_KV_LORA, MLA_HEADS * MLA_KVH), MLA_KV_LORA),
        'w_mla_o': w(ks[15], (L, MLA_V_W, D_MODEL), MLA_V_W),
        'w_out': w(ks[16], (L, D_MODEL, D_MODEL), D_MODEL),
        'post_mix_g': gain(ks[17], (L, D_MODEL)),
        'pre_mlp_g': gain(ks[18], (L, D_MODEL)),
        'w_up': w(ks[19], (L, D_MODEL, D_FF), D_MODEL),
        'w_down': w(ks[20], (L, D_FF, D_MODEL), D_FF),
        'post_mlp_g': gain(ks[21], (L, D_MODEL)),
    }


def reference(x, rel_bias, pre_mix_g, w_in, w_ret_o, lambda_q1, lambda_k1, lambda_q2, lambda_k2,
              diff_subln_g, w_diff_o, mla_q_norm_g, w_mla_uq, mla_kv_norm_g, w_mla_ukv, w_mla_o,
              w_out, post_mix_g, pre_mlp_g, w_up, w_down, post_mlp_g):
    b = x.shape[0]
    offs = np.cumsum(np.array(IN_SPLITS))[:-1].tolist()
    ret_cos, ret_sin = rope_tables(1.0 / (10000.0 ** jnp.linspace(0.0, 1.0, RET_DK // 2)))
    mla_cos, mla_sin = rope_tables(1.0 / (ROPE_THETA ** (jnp.arange(0, MLA_ROPE, 2, dtype=jnp.float32) / MLA_ROPE)))

    for l in range(DEPTH):
        h = rms_norm(x, pre_mix_g[l])
        (rq, rk, rv, rg, dq, dk, dv, cq, ckv, kpe, gates) = jnp.split(h @ w_in[l], offs, axis=-1)

        rq = apply_rope(rq.reshape(b, SEQ, RET_HEADS, RET_DK), ret_cos, ret_sin)
        rk = apply_rope(rk.reshape(b, SEQ, RET_HEADS, RET_DK), ret_cos, ret_sin) * (RET_DK ** -0.5)
        ret = retention(rq, rk, rv.reshape(b, SEQ, RET_HEADS, RET_DV))
        ret = rms_norm(ret).reshape(b, SEQ, RET_V_W).astype(h.dtype)
        branch_a = (jax.nn.silu(rg) * ret) @ w_ret_o[l]

        lambda_init = 0.8 - 0.6 * math.exp(-0.3 * l)
        lam = (jnp.exp(jnp.sum(lambda_q1[l] * lambda_k1[l]).astype(jnp.float32))
               - jnp.exp(jnp.sum(lambda_q2[l] * lambda_k2[l]).astype(jnp.float32)) + lambda_init)
        da = diff_attention(dq.reshape(b, SEQ, DIFF_HEADS, 2, DIFF_DH),
                            dk.reshape(b, SEQ, DIFF_HEADS, 2, DIFF_DH),
                            dv.reshape(b, SEQ, DIFF_HEADS, 2 * DIFF_DH), lam, rel_bias)
        da = rms_norm(da, diff_subln_g[l]) * (1.0 - lambda_init)
        branch_b = da.reshape(b, SEQ, DIFF_V_W).astype(h.dtype) @ w_diff_o[l]

        qh = (rms_norm(cq, mla_q_norm_g[l]) @ w_mla_uq[l]).reshape(b, SEQ, MLA_HEADS, MLA_QH)
        q_nope, q_pe = qh[..., :MLA_NOPE], apply_rope(qh[..., MLA_NOPE:], mla_cos, mla_sin)
        kvh = (rms_norm(ckv, mla_kv_norm_g[l]) @ w_mla_ukv[l]).reshape(b, SEQ, MLA_HEADS, MLA_KVH)
        k_nope, v_mla = kvh[..., :MLA_NOPE], kvh[..., MLA_NOPE:]
        k_pe = apply_rope(kpe[:, :, None, :], mla_cos, mla_sin)[:, :, 0, :]
        mo = mla_attention(q_nope, q_pe, k_nope, k_pe, v_mla)
        branch_c = mo.reshape(b, SEQ, MLA_V_W) @ w_mla_o[l]

        g = jax.nn.sigmoid(gates).reshape(b, SEQ, N_BRANCH, D_MODEL)
        merged = g[:, :, 0] * branch_a + g[:, :, 1] * branch_b + g[:, :, 2] * branch_c
        x = x + rms_norm(merged @ w_out[l], post_mix_g[l])

        h = rms_norm(x, pre_mlp_g[l])
        m = jnp.square(jax.nn.relu(h @ w_up[l])) @ w_down[l]
        x = x + rms_norm(m, post_mlp_g[l])
    return x
```

```cpp
#include <hip/hip_runtime.h>
#include <hip/hip_cooperative_groups.h>
#include <cstdio>
#include <cstdint>
namespace cg = cooperative_groups;
__device__ __forceinline__ int tidx(int wv) { int t = (wv << 6) | (int)__builtin_amdgcn_mbcnt_hi(~0u, __builtin_amdgcn_mbcnt_lo(~0u, 0u)); asm volatile("" : "+v"(t)); return t; }
namespace pg8 {
#define PG8_LAS __attribute__((address_space(3)))
typedef unsigned short bf16_t;
typedef short bf16x8 __attribute__((ext_vector_type(8)));
typedef float f32x4 __attribute__((ext_vector_type(4)));
typedef unsigned u32x4 __attribute__((ext_vector_type(4)));
constexpr int BM = 256, BK = 64, HALF = 128, HTB = HALF * BK * 2  , STAGE_BYTES = 8 * HTB, NXCD = 8, WGM = 8;

__host__ __device__ __forceinline__ int lds_byte(int r, int c) { const int st = (r >> 4) * 2 + (c >> 5), rr = r & 15, cc = c & 31, ob = rr * 64 + cc * 2; return st * 1024 + (ob ^ (((ob >> 9) & 1) << 5)); }
__host__ __device__ __forceinline__ void stage_rc(int b, int& R, int& C) { const int st = b / 1024, sb = b % 1024, swz = sb ^ (((sb >> 9) & 1) << 5); R = (st >> 1) * 16 + swz / 64; C = (st & 1) * 32 + (swz % 64) / 2; }
__host__ __device__ __forceinline__ int perm32(int rho) { const int n = rho >> 4, i = rho & 15; return 8 * (i >> 2) + 4 * n + (i & 3); }

struct Unit { int pm, pn; };
struct Gemm { const bf16_t* A; const bf16_t* Bt; int M, N, K; };

struct StaticOrder {
    int nM, nN, nwg, G, c, wv;
    __host__ __device__ void init(int M, int N, int G_, int c_) { nM = M / BM; nN = N / BM; nwg = nM * nN; G = G_; c = c_; }
    __host__ __device__ bool next(int i, Unit& u) const {
        const long L = (long)i * G + c; if (L >= nwg) return false;
        int wgid = (int)L; { const int q = nwg / NXCD, r = nwg % NXCD, xcd = wgid % NXCD, off = wgid / NXCD; wgid = (xcd < r ? xcd * (q + 1) : r * (q + 1) + (xcd - r) * q) + off; }
        const int nig = WGM * nN, gid = wgid / nig, fm = gid * WGM, gsz = (nM - fm) < WGM ? (nM - fm) : WGM;
        u.pm = fm + ((wgid % nig) % gsz); u.pn = (wgid % nig) / gsz; return true;
    }
    __device__ __forceinline__ void a_ready(const Unit&) const {}
    __device__ __forceinline__ void done(const Unit&) const {}
};

__device__ __forceinline__ unsigned cvt_pk_bf16(float lo, float hi) { unsigned r; asm volatile("v_cvt_pk_bf16_f32 %0, %1, %2" : "=v"(r) : "v"(lo), "v"(hi)); return r; }
template <class Epi, class Sched, bool ALIGN_EPI = false, bool SP2 = false>
__device__ __forceinline__ void gemm_phase(PG8_LAS unsigned char* lds, const Gemm g, const Sched& S, const Epi& E) {
    const int tid = tidx(S.wv), wid = __builtin_amdgcn_readfirstlane(tid >> 6), lane = tid & 63, wr = wid >> 2, wc = wid & 3, fr = lane & 15, fq = lane >> 4;
    const int K = g.K, nt = K / BK;
    unsigned voffA[2], voffB[2];
#pragma unroll
    for (int i = 0; i < 2; ++i) { int R, C; stage_rc(tid * 16 + i * 8192, R, C); const int Rb = Epi::PERM ? ((R & ~31) + perm32(R & 31)) : R;
        voffA[i] = (unsigned)(R * K + C) * 2u; voffB[i] = (unsigned)(Rb * K + C) * 2u; }
    const size_t kstep = (size_t)(BK * 2);
    const size_t hstep = (size_t)HALF * K * 2;
    const size_t tstep = 2 * hstep;
    const unsigned ldsw = (unsigned)wid * 1024u;
    const int aoff = lds_byte(wr * 64 + fr, fq * 8), boff = lds_byte(wc * 32 + fr, fq * 8);
#define PG8_SA(b, h) (((b) * 2 + (h)) * HTB)
#define PG8_SB(b, h) ((4 + (b) * 2 + (h)) * HTB)
#define PG8_STAGE(bufoff, gbase, voff) do { _Pragma("unroll") for (int _i = 0; _i < 2; ++_i) \
        __builtin_amdgcn_global_load_lds((const unsigned*)((const char*)(gbase) + (voff)[_i]), (PG8_LAS unsigned*)(lds + (bufoff) + ldsw + _i * 8192), 16, 0, 0); } while (0)
#define PG8_LDA(dst, b, h) do { _Pragma("unroll") for (int m = 0; m < 4; ++m) _Pragma("unroll") for (int k = 0; k < 2; ++k) dst[m][k] = *(const PG8_LAS bf16x8*)(lds + PG8_SA(b, h) + aoff + m * 2048 + k * 1024); } while (0)
#define PG8_LDB(dst, b, h) do { _Pragma("unroll") for (int n = 0; n < 2; ++n) _Pragma("unroll") for (int k = 0; k < 2; ++k) dst[n][k] = *(const PG8_LAS bf16x8*)(lds + PG8_SB(b, h) + boff + n * 2048 + k * 1024); } while (0)
#define PG8_MMA(ai, bj, At, Bt) do { __builtin_amdgcn_s_setprio(1); _Pragma("unroll") for (int m = 0; m < 4; ++m) _Pragma("unroll") for (int n = 0; n < 2; ++n) _Pragma("unroll") for (int k = 0; k < 2; ++k) \
        acc[ai][bj][m][n] = __builtin_amdgcn_mfma_f32_16x16x32_bf16(Bt[n][k], At[m][k], acc[ai][bj][m][n], 0, 0, 0); __builtin_amdgcn_s_setprio(0); } while (0)
#define PG8_WAIT_V(n) asm volatile("s_waitcnt vmcnt(" #n ")" ::: "memory")
#define PG8_WAIT_L(n) asm volatile("s_waitcnt lgkmcnt(" #n ")" ::: "memory")
#define PG8_BAR __builtin_amdgcn_s_barrier()
#define PG8_SCHED __builtin_amdgcn_sched_barrier(0)
    Unit cur, nxt; int ui = 0;
    if (!S.next(0, cur)) return;
    f32x4 acc[2][2][4][2];
#pragma unroll
    for (int a = 0; a < 2; ++a)
#pragma unroll
        for (int b = 0; b < 2; ++b)
#pragma unroll
            for (int m = 0; m < 4; ++m)
#pragma unroll
                for (int n = 0; n < 2; ++n) acc[a][b][m][n] = (f32x4){0.f, 0.f, 0.f, 0.f};
    bf16x8 At[4][2], B0[2][2], B1[2][2];
    const char* cA = (const char*)g.A + (size_t)cur.pm * tstep; const char* cB = (const char*)g.Bt + (size_t)cur.pn * tstep;
    S.a_ready(cur);
    if constexpr (SP2) {
        PG8_STAGE(PG8_SB(0, 0), cB, voffB); PG8_STAGE(PG8_SB(0, 1), cB + hstep, voffB); PG8_STAGE(PG8_SA(0, 0), cA, voffA); PG8_STAGE(PG8_SA(0, 1), cA + hstep, voffA);
        if (wr == 1) PG8_BAR;
        PG8_WAIT_V(2); PG8_BAR;
        PG8_STAGE(PG8_SB(1, 0), cB + kstep, voffB); PG8_STAGE(PG8_SA(1, 0), cA + kstep, voffA); PG8_STAGE(PG8_SB(1, 1), cB + hstep + kstep, voffB);
        PG8_WAIT_V(6); PG8_BAR;
    } else {
        PG8_STAGE(PG8_SB(0, 0), cB, voffB); PG8_STAGE(PG8_SA(0, 0), cA, voffA); PG8_STAGE(PG8_SB(0, 1), cB + hstep, voffB); PG8_STAGE(PG8_SA(0, 1), cA + hstep, voffA);
        if (wr == 1) PG8_BAR;
        PG8_WAIT_V(4); PG8_BAR;
        PG8_STAGE(PG8_SB(1, 0), cB + kstep, voffB); PG8_STAGE(PG8_SA(1, 0), cA + kstep, voffA); PG8_STAGE(PG8_SB(1, 1), cB + hstep + kstep, voffB);
        PG8_WAIT_V(6); PG8_BAR;
    }
    for (;;) {
        const bool has_next = S.next(ui + 1, nxt);
        const char* nA = has_next ? (const char*)g.A + (size_t)nxt.pm * tstep : cA; const char* nB = has_next ? (const char*)g.Bt + (size_t)nxt.pn * tstep : cB;
        for (int t = 0; t < nt; t += 2) {
            const bool last = (t == nt - 2);
            const char* a1 = cA + (size_t)(t + 1) * kstep;
            const char* a2 = last ? nA : cA + (size_t)(t + 2) * kstep; const char* b2 = last ? nB : cB + (size_t)(t + 2) * kstep;
            const char* a3 = a2 + kstep; const char* b3 = b2 + kstep;
            if (last && has_next) S.a_ready(nxt);
            if constexpr (SP2) {
            PG8_LDB(B0, 0, 0); PG8_LDB(B1, 0, 1); PG8_SCHED; PG8_LDA(At, 0, 0); PG8_STAGE(PG8_SA(1, 1), a1 + hstep, voffA);
            PG8_WAIT_V(8); PG8_WAIT_L(0); PG8_BAR; PG8_MMA(0, 0, At, B0); PG8_MMA(0, 1, At, B1); PG8_BAR; PG8_SCHED;
            PG8_LDA(At, 0, 1); PG8_STAGE(PG8_SB(0, 0), b2, voffB); PG8_STAGE(PG8_SB(0, 1), b2 + hstep, voffB); PG8_STAGE(PG8_SA(0, 0), a2, voffA);
            PG8_WAIT_V(8); PG8_WAIT_L(0); PG8_BAR; PG8_MMA(1, 0, At, B0); PG8_MMA(1, 1, At, B1); PG8_BAR; PG8_SCHED;
            PG8_LDB(B0, 1, 0); PG8_LDB(B1, 1, 1); PG8_SCHED; PG8_LDA(At, 1, 0); PG8_STAGE(PG8_SA(0, 1), a2 + hstep, voffA);
            PG8_WAIT_V(8); PG8_WAIT_L(0); PG8_BAR; PG8_MMA(0, 0, At, B0); PG8_MMA(0, 1, At, B1); PG8_BAR; PG8_SCHED;
            PG8_LDA(At, 1, 1); PG8_STAGE(PG8_SB(1, 0), b3, voffB); PG8_STAGE(PG8_SB(1, 1), b3 + hstep, voffB); PG8_STAGE(PG8_SA(1, 0), a3, voffA);
            PG8_WAIT_V(8); PG8_WAIT_L(0); PG8_BAR; PG8_MMA(1, 0, At, B0); PG8_MMA(1, 1, At, B1); PG8_BAR; PG8_SCHED;
            } else {
            PG8_LDB(B0, 0, 0); PG8_SCHED; PG8_LDA(At, 0, 0); PG8_STAGE(PG8_SA(1, 1), a1 + hstep, voffA);
            PG8_WAIT_L(8); PG8_BAR; PG8_WAIT_L(0); PG8_MMA(0, 0, At, B0); PG8_BAR; PG8_SCHED;
            PG8_LDB(B1, 0, 1); PG8_STAGE(PG8_SB(0, 0), b2, voffB);
            PG8_BAR; PG8_WAIT_L(0); PG8_MMA(0, 1, At, B1); PG8_BAR;
            PG8_LDA(At, 0, 1); PG8_STAGE(PG8_SA(0, 0), a2, voffA);
            PG8_BAR; PG8_WAIT_L(0); PG8_MMA(1, 0, At, B0); PG8_BAR; PG8_SCHED;
            PG8_STAGE(PG8_SB(0, 1), b2 + hstep, voffB);
            PG8_WAIT_V(6); PG8_BAR; PG8_MMA(1, 1, At, B1); PG8_BAR;
            PG8_LDB(B0, 1, 0); PG8_SCHED; PG8_LDA(At, 1, 0); PG8_STAGE(PG8_SA(0, 1), a2 + hstep, voffA);
            PG8_WAIT_L(8); PG8_BAR; PG8_WAIT_L(0); PG8_MMA(0, 0, At, B0); PG8_BAR; PG8_SCHED;
            PG8_LDB(B1, 1, 1); PG8_STAGE(PG8_SB(1, 0), b3, voffB);
            PG8_BAR; PG8_WAIT_L(0); PG8_MMA(0, 1, At, B1); PG8_BAR;
            PG8_LDA(At, 1, 1); PG8_STAGE(PG8_SA(1, 0), a3, voffA);
            PG8_BAR; PG8_WAIT_L(0); PG8_MMA(1, 0, At, B0); PG8_BAR; PG8_SCHED;
            PG8_STAGE(PG8_SB(1, 1), b3 + hstep, voffB);
            PG8_WAIT_V(6); PG8_BAR; PG8_MMA(1, 1, At, B1); PG8_BAR;
            }
        }
        if constexpr (ALIGN_EPI) { if (wr == 0) PG8_BAR; }
        if constexpr (!Epi::AFTER_DRAIN) { E(acc, cur, wr, wc, fr, fq); S.done(cur); }
        if (!has_next) break;
#pragma unroll
        for (int a = 0; a < 2; ++a)
#pragma unroll
            for (int b = 0; b < 2; ++b)
#pragma unroll
                for (int m = 0; m < 4; ++m)
#pragma unroll
                    for (int n = 0; n < 2; ++n) acc[a][b][m][n] = (f32x4){0.f, 0.f, 0.f, 0.f};
        cur = nxt; cA = nA; cB = nB; ++ui;
        if constexpr (ALIGN_EPI) { if (wr == 1) PG8_BAR; }
    }
    PG8_WAIT_V(0);
    if constexpr (!ALIGN_EPI) { if (wr == 0) PG8_BAR; }
    PG8_BAR;
    if constexpr (Epi::AFTER_DRAIN) { E.fused(acc, cur, wr, wc, fr, fq, lds, wid, lane); S.done(cur); }
#undef PG8_SA
#undef PG8_SB
#undef PG8_STAGE
#undef PG8_LDA
#undef PG8_LDB
#undef PG8_MMA
#undef PG8_WAIT_V
#undef PG8_WAIT_L
#undef PG8_BAR
#undef PG8_SCHED
}
}


#ifndef MK_MULTI
#define MK_MULTI 0
#endif
#define DI __device__ __forceinline__
#define LAS __attribute__((address_space(3)))
typedef unsigned short bf16;
typedef short bf16x8 __attribute__((ext_vector_type(8)));
typedef float f32x4 __attribute__((ext_vector_type(4)));
typedef float f32x16 __attribute__((ext_vector_type(16)));
typedef unsigned u32x4 __attribute__((ext_vector_type(4)));
typedef unsigned u32x2 __attribute__((ext_vector_type(2)));
typedef float f32x2_t __attribute__((ext_vector_type(2)));
typedef __bf16 bf16x2_t __attribute__((ext_vector_type(2)));
typedef LAS unsigned char* lptr;


constexpr int SEQ = 2048, DM = 1024, TH = 16384  , DFF = 4096, DIN = 9632;
constexpr float EPS = 1e-6f, LOG2E = 1.4426950408889634f;
constexpr float QSC_DIFF = 0.125f * LOG2E;
constexpr float QSC_MLA = 0.10206207261596575f * LOG2E;
constexpr float KSC_RET = 0.08838834764831845f;
constexpr int NTHR = 512;
constexpr int LDS_BYTES = 147456;

constexpr size_t MiB = 1u << 20;
constexpr size_t WS_CNT = 0, WS_LAM = 256, WS_BIAS = 1024, WS_GAIN = 65536;
constexpr size_t WS_SUBG = WS_GAIN + 4 * 2 * 1024 * 4;
constexpr size_t WS_RCOS = 1 * MiB, WS_RSIN = WS_RCOS + 512 * 1024, WS_MCOS = 2 * MiB, WS_MSIN = WS_MCOS + 128 * 1024;
constexpr size_t WS_W = 4 * MiB;
constexpr size_t WO_IN1 = 0, WO_V = WO_IN1 + 4608 * 1024, WO_G = WO_V + 2048 * 1024, WO_UQ = WO_G + 3072 * 1024, WO_UK = WO_UQ + 1536 * 256,
                 WO_UV = WO_UK + 1024 * 256, WO_RO = WO_UV + 1024 * 256, WO_DO = WO_RO + 1024 * 1024, WO_MO = WO_DO + 1024 * 1024, WO_OUT = WO_MO + 1024 * 1024,
                 WO_UP = WO_OUT + 1024 * 1024, WO_DOWN = WO_UP + 4096 * 1024, WO_END = WO_DOWN + 4096 * 1024;
static_assert(WS_W + 2 * WO_END * 2 <= 96 * MiB, "weights fit");
constexpr size_t WS_H = 96 * MiB;
constexpr size_t WS_RQ = 128 * MiB, WS_RK = 144 * MiB, WS_RVT = 160 * MiB, WS_RG = 192 * MiB, WS_G = 128 * MiB;
constexpr size_t WS_DQ = 224 * MiB, WS_DK = 256 * MiB, WS_DVT = 288 * MiB, WS_M32 = 256 * MiB;
constexpr size_t WS_CQ = 320 * MiB, WS_CKV = 328 * MiB  , WS_KPE = 336 * MiB, WS_SSQ_CQ = 337 * MiB, WS_SSQ_CKV = WS_SSQ_CQ + 256 * 1024;
constexpr size_t WS_QMN = 338 * MiB, WS_QMP = 370 * MiB, WS_KMN = 386 * MiB, WS_VMT = 418 * MiB, WS_RO = 450 * MiB;
constexpr size_t WS_MG = 370 * MiB, WS_Y = 402 * MiB, WS_SSQ_Y = 434 * MiB, WS_U = 128 * MiB, WS_END = 482 * MiB;

struct Params {
    const float *x, *rel_bias, *pre_mix_g, *w_in, *w_ret_o, *lq1, *lk1, *lq2, *lk2, *subln_g, *w_diff_o, *q_norm_g, *w_uq, *kv_norm_g, *w_ukv, *w_mla_o,
                *w_out, *post_mix_g, *pre_mlp_g, *w_up, *w_down, *post_mlp_g;
    float* out; unsigned char* ws; int ph_lo, ph_hi;
};

DI unsigned cvtpk(float lo, float hi) { f32x2_t v = {lo, hi}; bf16x2_t b = __builtin_convertvector(v, bf16x2_t); return __builtin_bit_cast(unsigned, b); }
DI u32x4 pack8(f32x4 a, f32x4 b) { u32x4 w; w.x = cvtpk(a[0], a[1]); w.y = cvtpk(a[2], a[3]); w.z = cvtpk(b[0], b[1]); w.w = cvtpk(b[2], b[3]); return w; }
DI float bflo(unsigned u) { return __uint_as_float(u << 16); }
DI float bfhi(unsigned u) { return __uint_as_float(u & 0xffff0000u); }
DI void unpack8(u32x4 w, f32x4& a, f32x4& b) { a = (f32x4){bflo(w.x), bfhi(w.x), bflo(w.y), bfhi(w.y)}; b = (f32x4){bflo(w.z), bfhi(w.z), bflo(w.w), bfhi(w.w)}; }
DI float ex2(float x) { return __builtin_amdgcn_exp2f(x); }
DI float sigm(float x) { return __builtin_amdgcn_rcpf(1.f + ex2(-x * LOG2E)); }
DI float shx(float v, int m, int lane) { return __int_as_float(__builtin_amdgcn_ds_bpermute((lane ^ m) << 2, __float_as_int(v))); }
DI float wave_sum(float v, int lane) {
#pragma unroll
    for (int o = 1; o < 64; o <<= 1) v += shx(v, o, lane);
    return v;
}
DI float sq4(f32x4 v) { return (v[0] * v[0] + v[1] * v[1]) + (v[2] * v[2] + v[3] * v[3]); }

DI int colmap(int map, int n, int off) {
    switch (map) {
        case 0: return off + n;
        case 1: { const int p = n & 127, bj = (n >> 7) & 1; return off + (n & ~255) + (p >> 6) * 128 + bj * 64 + (p & 63); }
        case 2: { if (n < 128) return 6400 + n; if (n >= 160) return -1; const int q = n - 128; return 6528 + 16 * ((q >> 2) & 1) + 4 * (q >> 3) + (q & 3); }
        case 3: { if (n < 1024) return (n >> 6) * 96 + (n & 63); const int q = n - 1024, hh = q >> 5, pos = q & 31; return hh * 96 + 64 + 16 * ((pos >> 2) & 1) + 4 * (pos >> 3) + (pos & 3); }
        case 4: return (n >> 6) * 128 + (n & 63);
        default: return (n >> 6) * 128 + 64 + (n & 63);
    }
}
DI void conv_item(const float* W, int ldw, int K, int kvalid, bf16* WT, int map, int off, const float* gs, LAS float* scr, int item, int nblk, int lane) {
    const int kb = item / nblk, nb = item % nblk, k0 = 64 * kb, n0 = 32 * nb;
    const int oc = colmap(map, n0 + (lane & 31), off);
#pragma unroll 8
    for (int i = 0; i < 32; ++i) { const int kk = 2 * i + (lane >> 5); float v = 0.f; if (oc >= 0 && k0 + kk < kvalid) { v = W[(size_t)(k0 + kk) * ldw + oc]; if (gs) v *= gs[k0 + kk]; } scr[kk * 33 + (lane & 31)] = v; }
    asm volatile("s_waitcnt lgkmcnt(0)" ::: "memory");
    const int c = lane & 7;
#pragma unroll
    for (int j = 0; j < 4; ++j) { const int n = (lane >> 3) + 8 * j; const LAS float* s = scr + (8 * c) * 33 + n;
        u32x4 o; o.x = cvtpk(s[0 * 33], s[1 * 33]); o.y = cvtpk(s[2 * 33], s[3 * 33]); o.z = cvtpk(s[4 * 33], s[5 * 33]); o.w = cvtpk(s[6 * 33], s[7 * 33]);
        *(u32x4*)(WT + (size_t)(n0 + n) * K + k0 + 8 * c) = o; }
    asm volatile("s_waitcnt lgkmcnt(0)" ::: "memory");
}
DI int t5_bucket(int n) {
    if (n < 16) return n;
    int large = 16 + (int)(logf((float)n / 16.f) / 2.0794415416798357f * 16.f);
    return large < 31 ? large : 31;
}
DI void prologue(const Params& p, lptr lds, int wv) {
    const int tid = tidx(wv), lane = tid & 63, wave = tid >> 6;
    const int gw = blockIdx.x * 8 + wave, NGW = gridDim.x * 8, gt = blockIdx.x * NTHR + tid, NGT = gridDim.x * NTHR;
    unsigned char* ws = p.ws;
    if (blockIdx.x == 0) {
        if (tid < 16) ((unsigned*)(ws + WS_CNT))[tid] = 0u;
        if (tid >= 64 && tid < 66) {
            const int l = tid - 64; float a = 0.f, b = 0.f;
            for (int i = 0; i < 64; ++i) { a += p.lq1[l * 64 + i] * p.lk1[l * 64 + i]; b += p.lq2[l * 64 + i] * p.lk2[l * 64 + i]; }
            const float linit = 0.8f - 0.6f * expf(-0.3f * (float)l);
            ((float*)(ws + WS_LAM))[l] = expf(a) - expf(b) + linit;
        }
    }
    for (int i = gt; i < 2048; i += NGT) { float* gd = (float*)(ws + WS_GAIN); gd[i] = p.pre_mix_g[i]; gd[2048 + i] = p.post_mix_g[i]; gd[4096 + i] = p.pre_mlp_g[i]; gd[6144 + i] = p.post_mlp_g[i]; if (i < 256) ((float*)(ws + WS_SUBG))[i] = p.subln_g[i]; }
    for (int i = gt; i < 8 * 128; i += NGT) { const int hh = i >> 7, n = i & 127; ((float*)(ws + WS_BIAS))[i] = p.rel_bias[t5_bucket(n) * 8 + hh] * LOG2E; }
    for (int i = gt; i < SEQ * 64; i += NGT) { const int s = i >> 6, d = i & 63; const float inv = (float)(1.0 / pow(10000.0, (double)d / 63.0)); const float ang = (float)s * inv;
        ((float*)(ws + WS_RCOS))[i] = (float)cos((double)ang); ((float*)(ws + WS_RSIN))[i] = (float)sin((double)ang); }
    for (int i = gt; i < SEQ * 16; i += NGT) { const int s = i >> 4, d = i & 15; const float inv = (float)(1.0 / pow(10000.0, (double)(2 * d) / 32.0)); const float ang = (float)s * inv;
        ((float*)(ws + WS_MCOS))[i] = (float)cos((double)ang); ((float*)(ws + WS_MSIN))[i] = (float)sin((double)ang); }
    LAS float* scr = (LAS float*)(lds + wave * 16384);
    for (int l = 0; l < 2; ++l) {
        bf16* Wb = (bf16*)(ws + WS_W) + (size_t)l * WO_END;
        const float* win = p.w_in + (size_t)l * DM * DIN;
        for (int job = 0; job < 19; ++job) {
            const float* src = win; int ldw = DIN, K = 1024, kvalid = 4096, ns = 1024, map = 0, off = 0; const float* gs = nullptr; bf16* dst = Wb;
            switch (job) {
                case 0: ns = 512; map = 1; off = 0; dst = Wb + WO_IN1; break;
                case 1: ns = 512; map = 1; off = 512; dst = Wb + WO_IN1 + (size_t)512 * 1024; break;
                case 2: off = 2048; dst = Wb + WO_IN1 + (size_t)1024 * 1024; break;
                case 3: off = 3072; dst = Wb + WO_IN1 + (size_t)2048 * 1024; break;
                case 4: off = 4096; dst = Wb + WO_IN1 + (size_t)3072 * 1024; break;
                case 5: ns = 256; off = 6144; dst = Wb + WO_IN1 + (size_t)4096 * 1024; break;
                case 6: ns = 256; map = 2; dst = Wb + WO_IN1 + (size_t)4352 * 1024; break;
                case 7: off = 1024; dst = Wb + WO_V; break;
                case 8: off = 5120; dst = Wb + WO_V + (size_t)1024 * 1024; break;
                case 9: ns = 3072; off = 6560; dst = Wb + WO_G; break;
                case 10: src = p.w_uq + (size_t)l * 256 * 1536; ldw = 1536; K = 256; ns = 1536; map = 3; gs = p.q_norm_g + l * 256; dst = Wb + WO_UQ; break;
                case 11: src = p.w_ukv + (size_t)l * 128 * 2048; ldw = 2048; K = 256; kvalid = 128; map = 4; gs = p.kv_norm_g + l * 128; dst = Wb + WO_UK; break;
                case 12: src = p.w_ukv + (size_t)l * 128 * 2048; ldw = 2048; K = 256; kvalid = 128; map = 5; gs = p.kv_norm_g + l * 128; dst = Wb + WO_UV; break;
                case 13: src = p.w_ret_o + (size_t)l * 1024 * 1024; ldw = 1024; dst = Wb + WO_RO; break;
                case 14: src = p.w_diff_o + (size_t)l * 1024 * 1024; ldw = 1024; dst = Wb + WO_DO; break;
                case 15: src = p.w_mla_o + (size_t)l * 1024 * 1024; ldw = 1024; dst = Wb + WO_MO; break;
                case 16: src = p.w_out + (size_t)l * 1024 * 1024; ldw = 1024; dst = Wb + WO_OUT; break;
                case 17: src = p.w_up + (size_t)l * 1024 * 4096; ldw = 4096; ns = 4096; dst = Wb + WO_UP; break;
                default: src = p.w_down + (size_t)l * 4096 * 1024; ldw = 1024; K = 4096; dst = Wb + WO_DOWN; break;
            }
            const int nblk = ns / 32, items = (K / 64) * nblk;
            for (int it = gw; it < items; it += NGW) conv_item(src, ldw, K, kvalid, dst, map, off, gs, scr, it, nblk, lane);
        }
    }
}

DI void norm_rows(const float* x, const float* g, bf16* o, int rows, int wv) {
    const int tid_ = tidx(wv); const int lane = tid_ & 63, gw = blockIdx.x * 8 + (tid_ >> 6), NGW = gridDim.x * 8;
    for (int m = gw; m < rows; m += NGW) {
        const f32x4* xr = (const f32x4*)(x + (size_t)m * DM) + lane; f32x4 v[4]; float s = 0.f;
#pragma unroll
        for (int j = 0; j < 4; ++j) { v[j] = xr[64 * j]; s += sq4(v[j]); }
        const float rs = 1.0f / sqrtf(wave_sum(s, lane) * (1.f / DM) + EPS);
        u32x2* o8 = (u32x2*)(o + (size_t)m * DM) + lane;
#pragma unroll
        for (int j = 0; j < 4; ++j) { const f32x4 gg = ((const f32x4*)g)[lane + 64 * j]; u32x2 w; w.x = cvtpk(v[j][0] * rs * gg[0], v[j][1] * rs * gg[1]); w.y = cvtpk(v[j][2] * rs * gg[2], v[j][3] * rs * gg[3]); o8[64 * j] = w; }
    }
}
DI void resid_rows(const float* xin, const bf16* y, const float* ssq, const float* gpost, float* xout, const float* gnext, bf16* hout, int rows, int wv, bool ablate = false) {
    const int tid_ = tidx(wv); const int lane = tid_ & 63, gw = blockIdx.x * 8 + (tid_ >> 6), NGW = gridDim.x * 8;
    for (int m = gw; m < rows; m += NGW) {
        const float part = lane < 16 ? ssq[(size_t)m * 16 + lane] : 0.f;
        float rs = 1.0f / sqrtf(wave_sum(part, lane) * (1.f / DM) + EPS);
#ifdef ABL_MLP
        if (!gnext || gnext == (const float*)0 + 1) rs = rs; if (ablate) rs = 0.f;
#endif
        const f32x4* xr = (const f32x4*)(xin + (size_t)m * DM) + lane; const u32x2* yr = (const u32x2*)(y + (size_t)m * DM) + lane; f32x4* xo = (f32x4*)(xout + (size_t)m * DM) + lane;
        f32x4 v[4]; float s = 0.f;
#pragma unroll
        for (int j = 0; j < 4; ++j) { const f32x4 xv = xr[64 * j]; const u32x2 yw = yr[64 * j]; const f32x4 gg = ((const f32x4*)gpost)[lane + 64 * j];
            f32x4 yv = (f32x4){bflo(yw.x), bfhi(yw.x), bflo(yw.y), bfhi(yw.y)};
            v[j] = xv + yv * rs * gg; xo[64 * j] = v[j]; s += sq4(v[j]); }
        if (gnext) {
            const float rs2 = 1.0f / sqrtf(wave_sum(s, lane) * (1.f / DM) + EPS);
            u32x2* o8 = (u32x2*)(hout + (size_t)m * DM) + lane;
#pragma unroll
            for (int j = 0; j < 4; ++j) { const f32x4 gg = ((const f32x4*)gnext)[lane + 64 * j]; u32x2 w; w.x = cvtpk(v[j][0] * rs2 * gg[0], v[j][1] * rs2 * gg[1]); w.y = cvtpk(v[j][2] * rs2 * gg[2], v[j][3] * rs2 * gg[3]); o8[64 * j] = w; }
        }
    }
}

#define EPI_ARGS const f32x4 (&acc)[2][2][4][2], const pg8::Unit& u, int wr, int wc, int fr, int fq
#define FOR_AI_M _Pragma("unroll") for (int ai = 0; ai < 2; ++ai) _Pragma("unroll") for (int m = 0; m < 4; ++m)
#define FOR_BJ _Pragma("unroll") for (int bj = 0; bj < 2; ++bj)

struct EpiIn1 {
    static constexpr bool PERM = true, AFTER_DRAIN = false;
    unsigned char* ws;
    DI void operator()(EPI_ARGS) const {
        asm volatile("" : "+v"(fr), "+v"(fq));
        bf16 *RQ = (bf16*)(ws + WS_RQ), *RK = (bf16*)(ws + WS_RK), *RG = (bf16*)(ws + WS_RG), *DQ = (bf16*)(ws + WS_DQ), *DK = (bf16*)(ws + WS_DK), *CQ = (bf16*)(ws + WS_CQ), *CKV = (bf16*)(ws + WS_CKV), *KPE = (bf16*)(ws + WS_KPE);
        float *SSQ_CQ = (float*)(ws + WS_SSQ_CQ), *SSQ_CKV = (float*)(ws + WS_SSQ_CKV);
        const float *rcos = (const float*)(ws + WS_RCOS), *rsin = (const float*)(ws + WS_RSIN), *mcos = (const float*)(ws + WS_MCOS), *msin = (const float*)(ws + WS_MSIN);
        const int pn = u.pn, row0 = u.pm * 256 + wr * 64 + fr, c8 = wc * 32 + 8 * fq;
        if (pn < 4) {
            bf16* dst = pn < 2 ? RQ : RK; const float sc = pn < 2 ? 1.f : KSC_RET; const int head = 2 * (pn & 1) + (wc >> 1), d0 = c8 & 63;
            FOR_AI_M { const int t = row0 + ai * 128 + m * 16, s = t & (SEQ - 1);
                const f32x4 c0 = *(const f32x4*)(rcos + s * 64 + d0), c1 = *(const f32x4*)(rcos + s * 64 + d0 + 4), s0 = *(const f32x4*)(rsin + s * 64 + d0), s1 = *(const f32x4*)(rsin + s * 64 + d0 + 4);
                const f32x4 x1a = acc[ai][0][m][0], x1b = acc[ai][0][m][1], x2a = acc[ai][1][m][0], x2b = acc[ai][1][m][1];
                bf16* o = dst + (size_t)t * 512 + head * 128 + d0;
                *(u32x4*)o = pack8((x1a * c0 - x2a * s0) * sc, (x1b * c1 - x2b * s1) * sc);
                *(u32x4*)(o + 64) = pack8((x2a * c0 + x1a * s0) * sc, (x2b * c1 + x1b * s1) * sc); asm volatile("" ::: "memory"); }
        } else if (pn < 16) {
            const int seg = (pn - 4) >> 2; bf16* dst = seg == 0 ? RG : (seg == 1 ? DQ : DK); const int colb = ((pn - 4) & 3) * 256 + c8;
            FOR_AI_M { const int t = row0 + ai * 128 + m * 16;
                FOR_BJ { f32x4 v0 = acc[ai][bj][m][0], v1 = acc[ai][bj][m][1];
                    if (seg == 0) {
#pragma unroll
                        for (int i = 0; i < 4; ++i) { v0[i] = v0[i] * sigm(v0[i]); v1[i] = v1[i] * sigm(v1[i]); } }
                    else if (seg == 1) { v0 = v0 * QSC_DIFF; v1 = v1 * QSC_DIFF; }
                    *(u32x4*)(dst + (size_t)t * 1024 + colb + bj * 128) = pack8(v0, v1); } }
        } else if (pn == 16) {
            FOR_AI_M { const int t = row0 + ai * 128 + m * 16; float ss = 0.f;
                FOR_BJ { const f32x4 v0 = acc[ai][bj][m][0], v1 = acc[ai][bj][m][1]; ss += sq4(v0) + sq4(v1); *(u32x4*)(CQ + (size_t)t * 256 + c8 + bj * 128) = pack8(v0, v1); }
                ss += shx(ss, 16, fq * 16 + fr); ss += shx(ss, 32, fq * 16 + fr);
                if (fq == 0) SSQ_CQ[(size_t)t * 4 + wc] = ss; }
        } else {
            FOR_AI_M { const int t = row0 + ai * 128 + m * 16, s = t & (SEQ - 1);
                const f32x4 v0 = acc[ai][0][m][0], v1 = acc[ai][0][m][1]; float ss = sq4(v0) + sq4(v1);
                *(u32x4*)(CKV + (size_t)t * 256 + c8) = pack8(v0, v1); *(u32x4*)(CKV + (size_t)t * 256 + 128 + c8) = pack8(acc[ai][1][m][0], acc[ai][1][m][1]);
                ss += shx(ss, 16, fq * 16 + fr); ss += shx(ss, 32, fq * 16 + fr);
                if (fq == 0) SSQ_CKV[(size_t)t * 4 + wc] = ss;
                if (wc == 0) { const f32x4 x1 = acc[ai][1][m][0], x2 = acc[ai][1][m][1]; const f32x4 c = *(const f32x4*)(mcos + s * 16 + 4 * fq), sn = *(const f32x4*)(msin + s * 16 + 4 * fq);
                    const f32x4 o1 = x1 * c - x2 * sn, o2 = x2 * c + x1 * sn; u32x2 w1, w2; w1.x = cvtpk(o1[0], o1[1]); w1.y = cvtpk(o1[2], o1[3]); w2.x = cvtpk(o2[0], o2[1]); w2.y = cvtpk(o2[2], o2[3]);
                    *(u32x2*)(KPE + (size_t)t * 32 + 4 * fq) = w1; *(u32x2*)(KPE + (size_t)t * 32 + 16 + 4 * fq) = w2; } }
        }
    }
};
struct EpiVt {
    static constexpr bool PERM = true, AFTER_DRAIN = false;
    bf16 *T0, *T1; const float* ssq; float inv_n;
    DI void operator()(EPI_ARGS) const {
        asm volatile("" : "+v"(fr), "+v"(fq));
        const int b = u.pn >> 3, s0 = (u.pn & 7) * 256 + wc * 32 + 8 * fq;
        float rs[2][8];
        FOR_BJ {
#pragma unroll
            for (int k = 0; k < 8; ++k) { rs[bj][k] = 1.f; if (ssq) { const f32x4 q = *(const f32x4*)(ssq + (size_t)(b * SEQ + s0 + bj * 128 + k) * 4); rs[bj][k] = 1.0f / sqrtf(((q[0] + q[1]) + (q[2] + q[3])) * inv_n + EPS); } } }
        FOR_AI_M { const int R = u.pm * 256 + ai * 128 + wr * 64 + m * 16 + fr;
            bf16* rowp = (R < 1024 ? T0 + (size_t)(b * 1024 + R) * SEQ : T1 + (size_t)(b * 1024 + R - 1024) * SEQ) + s0;
            FOR_BJ { f32x4 v0 = acc[ai][bj][m][0], v1 = acc[ai][bj][m][1];
#pragma unroll
                for (int i = 0; i < 4; ++i) { v0[i] *= rs[bj][i]; v1[i] *= rs[bj][4 + i]; }
                *(u32x4*)(rowp + bj * 128) = pack8(v0, v1); } }
    }
};
struct EpiUq {
    static constexpr bool PERM = true, AFTER_DRAIN = false;
    bf16 *QMn, *QMp; const float *ssq, *mcos, *msin; int wv;
    DI void operator()(EPI_ARGS) const {
        { const int t_ = tidx(wv); fr = t_ & 15; fq = (t_ >> 4) & 3; }
        const int pn = u.pn, row0 = u.pm * 256 + wr * 64 + fr, c8 = wc * 32 + 8 * fq;
        FOR_AI_M { const int t = row0 + ai * 128 + m * 16, s = t & (SEQ - 1);
            const f32x4 q = *(const f32x4*)(ssq + (size_t)t * 4); const float rs = QSC_MLA / sqrtf(((q[0] + q[1]) + (q[2] + q[3])) * (1.f / 256.f) + EPS);
            if (pn < 4) { FOR_BJ { *(u32x4*)(QMn + (size_t)t * 1024 + pn * 256 + bj * 128 + c8) = pack8(acc[ai][bj][m][0] * rs, acc[ai][bj][m][1] * rs); } }
            else { const f32x4 c = *(const f32x4*)(mcos + s * 16 + 4 * fq), sn = *(const f32x4*)(msin + s * 16 + 4 * fq);
                FOR_BJ { const int hh = (pn - 4) * 8 + bj * 4 + wc; const f32x4 x1 = acc[ai][bj][m][0] * rs, x2 = acc[ai][bj][m][1] * rs;
                    const f32x4 o1 = x1 * c - x2 * sn, o2 = x2 * c + x1 * sn; u32x2 w1, w2; w1.x = cvtpk(o1[0], o1[1]); w1.y = cvtpk(o1[2], o1[3]); w2.x = cvtpk(o2[0], o2[1]); w2.y = cvtpk(o2[2], o2[3]);
                    *(u32x2*)(QMp + (size_t)t * 512 + hh * 32 + 4 * fq) = w1; *(u32x2*)(QMp + (size_t)t * 512 + hh * 32 + 16 + 4 * fq) = w2; } }
            asm volatile("" ::: "memory");
        }
    }
};
struct EpiUk {
    static constexpr bool PERM = true, AFTER_DRAIN = false;
    bf16* KMn; const float* ssq;
    DI void operator()(EPI_ARGS) const {
        asm volatile("" : "+v"(fr), "+v"(fq));
        const int row0 = u.pm * 256 + wr * 64 + fr, c8 = wc * 32 + 8 * fq;
        FOR_AI_M { const int t = row0 + ai * 128 + m * 16;
            const f32x4 q = *(const f32x4*)(ssq + (size_t)t * 4); const float rs = 1.0f / sqrtf(((q[0] + q[1]) + (q[2] + q[3])) * (1.f / 128.f) + EPS);
            FOR_BJ { *(u32x4*)(KMn + (size_t)t * 1024 + u.pn * 256 + bj * 128 + c8) = pack8(acc[ai][bj][m][0] * rs, acc[ai][bj][m][1] * rs); } }
    }
};
template <int ACT  > struct EpiAct {
    static constexpr bool PERM = true, AFTER_DRAIN = false;
    bf16* O; int ldc;
    DI void operator()(EPI_ARGS) const {
        asm volatile("" : "+v"(fr), "+v"(fq));
        const int row0 = u.pm * 256 + wr * 64 + fr, c8 = u.pn * 256 + wc * 32 + 8 * fq;
        FOR_AI_M { const int t = row0 + ai * 128 + m * 16;
            FOR_BJ { f32x4 v0 = acc[ai][bj][m][0], v1 = acc[ai][bj][m][1];
#pragma unroll
                for (int i = 0; i < 4; ++i) { if (ACT == 0) { v0[i] = sigm(v0[i]); v1[i] = sigm(v1[i]); } else { const float a = fmaxf(v0[i], 0.f), b = fmaxf(v1[i], 0.f); v0[i] = a * a; v1[i] = b * b; } }
                *(u32x4*)(O + (size_t)t * ldc + c8 + bj * 128) = pack8(v0, v1); } }
    }
};
template <int I> struct EpiBranch {
    static constexpr bool PERM = true, AFTER_DRAIN = false;
    const bf16* G; float* M32; bf16* MG;
    DI void operator()(EPI_ARGS) const {
        asm volatile("" : "+v"(fr), "+v"(fq));
        const int row0 = u.pm * 256 + wr * 64 + fr, c8 = u.pn * 256 + wc * 32 + 8 * fq;
        FOR_AI_M { const int t = row0 + ai * 128 + m * 16;
            FOR_BJ { const size_t idx = (size_t)t * 1024 + c8 + bj * 128; f32x4 g0, g1; unpack8(*(const u32x4*)(G + idx), g0, g1);
                f32x4 v0 = acc[ai][bj][m][0] * g0, v1 = acc[ai][bj][m][1] * g1;
#ifdef ABL_BRANCH
                if (I == ABL_BRANCH) { v0 = v0 * 0.f; v1 = v1 * 0.f; }
#endif
                if (I > 0) { v0 = v0 + *(const f32x4*)(M32 + idx); v1 = v1 + *(const f32x4*)(M32 + idx + 4); }
                if (I < 2) { *(f32x4*)(M32 + idx) = v0; *(f32x4*)(M32 + idx + 4) = v1; } else *(u32x4*)(MG + idx) = pack8(v0, v1); } }
    }
};
struct EpiY {
    static constexpr bool PERM = true, AFTER_DRAIN = false;
    bf16* Y; float* SSQ;
    DI void operator()(EPI_ARGS) const {
        asm volatile("" : "+v"(fr), "+v"(fq));
        const int row0 = u.pm * 256 + wr * 64 + fr, c8 = u.pn * 256 + wc * 32 + 8 * fq;
        FOR_AI_M { const int t = row0 + ai * 128 + m * 16; float ss = 0.f;
            FOR_BJ { const f32x4 v0 = acc[ai][bj][m][0], v1 = acc[ai][bj][m][1]; ss += sq4(v0) + sq4(v1); *(u32x4*)(Y + (size_t)t * 1024 + c8 + bj * 128) = pack8(v0, v1); }
            ss += shx(ss, 16, fq * 16 + fr); ss += shx(ss, 32, fq * 16 + fr);
            if (fq == 0) SSQ[(size_t)t * 16 + u.pn * 4 + wc] = ss; }
    }
};

template <int MODE> struct AC;
template <> struct AC<0> { static constexpr int DQK = 128, KW = 128, DVW = 128, VTR = 256, QR = 128; };
template <> struct AC<1> { static constexpr int DQK = 64, KW = 128, DVW = 128, VTR = 128, QR = 128; };
template <> struct AC<2> { static constexpr int DQK = 96, KW = 96, DVW = 64, VTR = 64, QR = 256; };
constexpr int A_KBUF = 17408, A_VBUF = 36864, A_V0 = 2 * A_KBUF, A_MISC = 2 * A_KBUF + 2 * A_VBUF;
constexpr int A_LUT = A_MISC + 64, A_XCH = A_MISC + 1024;
static_assert(A_XCH + 2048 <= LDS_BYTES, "attention LDS map");
struct AttnP { unsigned char* ws; const float* subg; float lam, oml; };
struct AttnPtrs { const bf16 *RQ, *RK, *RVt, *RG; bf16* RO; bf16* DQ; const bf16 *DK, *DVt; bf16* QMn; const bf16 *QMp, *KMn, *KPE, *VMt; const float *biasl, *subg; float lam, oml; };

template <int MODE> DI void attn_unit(lptr lds, const AttnP PP, const int b, const int hd, const int qb, const int wv) {
    using C = AC<MODE>;
    unsigned char* const ws = PP.ws;
    const AttnPtrs P{(const bf16*)(ws + WS_RQ), (const bf16*)(ws + WS_RK), (const bf16*)(ws + WS_RVT), (const bf16*)(ws + WS_RG), (bf16*)(ws + WS_RO), (bf16*)(ws + WS_DQ),
                     (const bf16*)(ws + WS_DK), (const bf16*)(ws + WS_DVT), (bf16*)(ws + WS_QMN), (const bf16*)(ws + WS_QMP), (const bf16*)(ws + WS_KMN), (const bf16*)(ws + WS_KPE),
                     (const bf16*)(ws + WS_VMT), (const float*)(ws + WS_BIAS), PP.subg, PP.lam, PP.oml};
    constexpr int NKS = C::DQK / 16, NVB = C::DVW / 32, KS = (C::KW + 8) * 2, VS = 144, KCH = C::KW / 8, NKC = 64 * KCH, NVR = C::VTR / 64;
    const int tid = tidx(wv), w = __builtin_amdgcn_readfirstlane(tid >> 6), lane = tid & 63, r = lane & 31, h = lane >> 5;
    const int rg = MODE == 2 ? w : (w >> 1), pp = MODE == 2 ? 0 : (w & 1);
    const int q0 = qb * C::QR, q0w = q0 + rg * 32, tok0 = b * SEQ, qq = q0w + r;
    const int ntiles = (q0 + C::QR) / 64;
    const bf16* Kg; const bf16* Vg;
    if (MODE == 0) { Kg = P.RK + (size_t)tok0 * 512 + hd * 128; Vg = P.RVt + (size_t)(b * 4 + hd) * 256 * SEQ; }
    else if (MODE == 1) { Kg = P.DK + (size_t)tok0 * 1024 + hd * 128; Vg = P.DVt + (size_t)(b * 8 + hd) * 128 * SEQ; }
    else { Kg = P.KMn + (size_t)tok0 * 1024 + hd * 64; Vg = P.VMt + (size_t)(b * 16 + hd) * 64 * SEQ; }
    const bf16* Kpe = P.KPE + (size_t)tok0 * 32;
    bf16x8 q[NKS];
    { const size_t t = (size_t)(tok0 + qq);
#pragma unroll
        for (int ks = 0; ks < NKS; ++ks) {
            const bf16* src;
            if (MODE == 0) src = P.RQ + t * 512 + hd * 128 + ks * 16 + 8 * h;
            else if (MODE == 1) src = P.DQ + t * 1024 + hd * 128 + pp * 64 + ks * 16 + 8 * h;
            else src = ks < 4 ? P.QMn + t * 1024 + hd * 64 + ks * 16 + 8 * h : P.QMp + t * 512 + hd * 32 + (ks - 4) * 16 + 8 * h;
            q[ks] = *(const bf16x8*)src; } }
    if (MODE == 1) { if (tid < 128) ((LAS float*)(lds + A_LUT))[tid] = P.biasl[hd * 128 + tid]; }
    u32x4 kreg[2], vreg[NVR];
#define A_GLOAD(kt) do { \
    _Pragma("unroll") for (int i_ = 0; i_ < 2; ++i_) { const int id_ = tid + 512 * i_; if (id_ < NKC) { const int row_ = id_ / KCH, cc_ = id_ % KCH; const size_t kr_ = (size_t)((kt) * 64 + row_); \
        const bf16* s_; if (MODE == 2) s_ = cc_ < 8 ? Kg + kr_ * 1024 + cc_ * 8 : Kpe + kr_ * 32 + (cc_ - 8) * 8; else s_ = Kg + kr_ * (MODE == 0 ? 512 : 1024) + cc_ * 8; kreg[i_] = *(const u32x4*)s_; } } \
    _Pragma("unroll") for (int i_ = 0; i_ < NVR; ++i_) { const int id_ = tid + 512 * i_, row_ = id_ >> 3, cc_ = id_ & 7; vreg[i_] = *(const u32x4*)(Vg + (size_t)row_ * SEQ + (kt) * 64 + cc_ * 8); } } while (0)
#define A_LWRITE(buf) do { \
    _Pragma("unroll") for (int i_ = 0; i_ < 2; ++i_) { const int id_ = tid + 512 * i_; if (id_ < NKC) { const int row_ = id_ / KCH, cc_ = id_ % KCH; *(LAS u32x4*)(lds + (buf) * A_KBUF + row_ * KS + cc_ * 16) = kreg[i_]; } } \
    _Pragma("unroll") for (int i_ = 0; i_ < NVR; ++i_) { const int id_ = tid + 512 * i_, row_ = id_ >> 3, cc_ = id_ & 7; *(LAS u32x4*)(lds + A_V0 + (buf) * A_VBUF + row_ * VS + cc_ * 16) = vreg[i_]; } } while (0)
    f32x16 O[NVB];
#pragma unroll
    for (int vb = 0; vb < NVB; ++vb)
#pragma unroll
        for (int i = 0; i < 16; ++i) O[vb][i] = 0.f;
    float mrun = -INFINITY, lrun = 0.f;
    const float l2g = MODE == 0 ? log2f(1.f - ex2(-5.f - (float)hd)) : 0.f;
    const float b31 = MODE == 1 ? P.biasl[hd * 128 + 127] : 0.f;
    const int pir = (r & 0x13) | ((r & 8) >> 1) | ((r & 4) << 1);
    const int koffb = ((MODE == 1 ? pp * 64 : 0) + 8 * h) * 2;
    const int vrow0 = (MODE == 0 ? pp * 128 : 0) + r;
    A_GLOAD(0); A_LWRITE(0);
    __syncthreads();
    for (int kt = 0; kt < ntiles; ++kt) {
        const int cur = kt & 1;
        if (kt + 1 < ntiles) A_GLOAD(kt + 1);
        if (kt * 64 <= q0w + 31) {
            const lptr Kb = lds + cur * A_KBUF + koffb, Vb = lds + A_V0 + cur * A_VBUF + (8 * h) * 2;
            f32x16 S0, S1;
#pragma unroll
            for (int i = 0; i < 16; ++i) { S0[i] = 0.f; S1[i] = 0.f; }
#pragma unroll
            for (int ks = 0; ks < NKS; ++ks) {
                const bf16x8 a0 = *(const LAS bf16x8*)(Kb + pir * KS + ks * 32), a1 = *(const LAS bf16x8*)(Kb + (32 + pir) * KS + ks * 32);
                S0 = __builtin_amdgcn_mfma_f32_32x32x16_bf16(a0, q[ks], S0, 0, 0, 0);
                S1 = __builtin_amdgcn_mfma_f32_32x32x16_bf16(a1, q[ks], S1, 0, 0, 0);
            }
            const int kb0 = kt * 64 + 8 * h;
            const bool diag = (kt * 64 + 63 > q0w);
            if (MODE == 0) {
#pragma unroll
                for (int i = 0; i < 16; ++i) { const int k0 = kb0 + 16 * (i >> 3) + (i & 7); const int d0 = qq - k0, d1 = d0 - 32;
                    const float e0 = ex2(l2g * (float)d0), e1 = ex2(l2g * (float)d1);
                    S0[i] = (d0 >= 0) ? S0[i] * e0 : 0.f; S1[i] = (d1 >= 0) ? S1[i] * e1 : 0.f; }
            } else {
                if (MODE == 1) {
                    if (q0w - (kt * 64 + 63) >= 113) {
#pragma unroll
                        for (int i = 0; i < 16; ++i) { S0[i] += b31; S1[i] += b31; }
                    } else {
                        const LAS float* lut = (const LAS float*)(lds + A_LUT);
#pragma unroll
                        for (int i = 0; i < 16; ++i) { const int k0 = kb0 + 16 * (i >> 3) + (i & 7); int d0 = qq - k0, d1 = d0 - 32;
                            d0 = d0 < 0 ? 0 : (d0 > 127 ? 127 : d0); d1 = d1 < 0 ? 0 : (d1 > 127 ? 127 : d1); S0[i] += lut[d0]; S1[i] += lut[d1]; }
                    }
                }
                if (diag) {
#pragma unroll
                    for (int i = 0; i < 16; ++i) { const int k0 = kb0 + 16 * (i >> 3) + (i & 7); if (k0 > qq) S0[i] = -INFINITY; if (k0 + 32 > qq) S1[i] = -INFINITY; }
                }
                float mx = fmaxf(S0[0], S1[0]);
#pragma unroll
                for (int i = 1; i < 16; ++i) mx = fmaxf(mx, fmaxf(S0[i], S1[i]));
                mx = fmaxf(mx, shx(mx, 32, lane));
                const float mn = fmaxf(mrun, mx), al = ex2(mrun - mn); mrun = mn;
                float ps = 0.f;
#pragma unroll
                for (int i = 0; i < 16; ++i) { S0[i] = ex2(S0[i] - mn); S1[i] = ex2(S1[i] - mn); ps += S0[i] + S1[i]; }
                lrun = lrun * al + ps;
#pragma unroll
                for (int vb = 0; vb < NVB; ++vb)
#pragma unroll
                    for (int i = 0; i < 16; ++i) O[vb][i] *= al;
            }
            bf16x8 pf[2][2];
#pragma unroll
            for (int s = 0; s < 2; ++s) {
                u32x4 t0, t1;
                t0.x = cvtpk(S0[8 * s + 0], S0[8 * s + 1]); t0.y = cvtpk(S0[8 * s + 2], S0[8 * s + 3]); t0.z = cvtpk(S0[8 * s + 4], S0[8 * s + 5]); t0.w = cvtpk(S0[8 * s + 6], S0[8 * s + 7]);
                t1.x = cvtpk(S1[8 * s + 0], S1[8 * s + 1]); t1.y = cvtpk(S1[8 * s + 2], S1[8 * s + 3]); t1.z = cvtpk(S1[8 * s + 4], S1[8 * s + 5]); t1.w = cvtpk(S1[8 * s + 6], S1[8 * s + 7]);
                pf[0][s] = __builtin_bit_cast(bf16x8, t0); pf[1][s] = __builtin_bit_cast(bf16x8, t1);
            }
#pragma unroll
            for (int vb = 0; vb < NVB; ++vb)
#pragma unroll
                for (int kb = 0; kb < 2; ++kb)
#pragma unroll
                    for (int s = 0; s < 2; ++s) {
                        const bf16x8 a = *(const LAS bf16x8*)(Vb + (vrow0 + vb * 32) * VS + (kb * 32 + 16 * s) * 2);
                        O[vb] = __builtin_amdgcn_mfma_f32_32x32x16_bf16(a, pf[kb][s], O[vb], 0, 0, 0);
                    }
        }
        if (kt + 1 < ntiles) A_LWRITE(cur ^ 1);
        __syncthreads();
    }
#undef A_GLOAD
#undef A_LWRITE
    const size_t trow = (size_t)(tok0 + qq);
    if (MODE == 0) {
        float ss = 0.f;
#pragma unroll
        for (int vb = 0; vb < NVB; ++vb)
#pragma unroll
            for (int i = 0; i < 16; ++i) ss += O[vb][i] * O[vb][i];
        ss += shx(ss, 32, lane);
        LAS float* xch = (LAS float*)(lds + A_XCH);
        if (h == 0) xch[w * 32 + r] = ss;
        __syncthreads();
        const float tot = ss + xch[(w ^ 1) * 32 + r];
        const float rs = 1.0f / sqrtf(tot * (1.f / 256.f) + EPS);
#pragma unroll
        for (int vb = 0; vb < NVB; ++vb)
#pragma unroll
            for (int g = 0; g < 4; ++g) { const size_t idx = trow * 1024 + hd * 256 + pp * 128 + vb * 32 + 8 * g + 4 * h; const u32x2 gw = *(const u32x2*)(P.RG + idx);
                u32x2 o; o.x = cvtpk(O[vb][4 * g] * rs * bflo(gw.x), O[vb][4 * g + 1] * rs * bfhi(gw.x)); o.y = cvtpk(O[vb][4 * g + 2] * rs * bflo(gw.y), O[vb][4 * g + 3] * rs * bfhi(gw.y));
                *(u32x2*)(P.RO + idx) = o; }
    } else if (MODE == 1) {
        const float lt = lrun + shx(lrun, 32, lane), il = 1.0f / lt;
        LAS float* X = (LAS float*)lds + (size_t)rg * 64 * 64;
        if (pp == 1) {
#pragma unroll
            for (int vb = 0; vb < NVB; ++vb)
#pragma unroll
                for (int i = 0; i < 16; ++i) X[(vb * 16 + i) * 64 + lane] = O[vb][i] * il;
        }
        __syncthreads();
        if (pp == 0) {
            float ss = 0.f;
#pragma unroll
            for (int vb = 0; vb < NVB; ++vb)
#pragma unroll
                for (int i = 0; i < 16; ++i) { const float v = O[vb][i] * il - P.lam * X[(vb * 16 + i) * 64 + lane]; O[vb][i] = v; ss += v * v; }
            ss += shx(ss, 32, lane);
            const float rs = P.oml / sqrtf(ss * (1.f / 128.f) + EPS);
#pragma unroll
            for (int vb = 0; vb < NVB; ++vb)
#pragma unroll
                for (int g = 0; g < 4; ++g) { const int dv = vb * 32 + 8 * g + 4 * h; const f32x4 gg = *(const f32x4*)(P.subg + dv);
                    u32x2 o; o.x = cvtpk(O[vb][4 * g] * rs * gg[0], O[vb][4 * g + 1] * rs * gg[1]); o.y = cvtpk(O[vb][4 * g + 2] * rs * gg[2], O[vb][4 * g + 3] * rs * gg[3]);
                    *(u32x2*)(P.DQ + trow * 1024 + hd * 128 + dv) = o; }
        }
    } else {
        const float lt = lrun + shx(lrun, 32, lane), il = 1.0f / lt;
#pragma unroll
        for (int vb = 0; vb < NVB; ++vb)
#pragma unroll
            for (int g = 0; g < 4; ++g) { u32x2 o; o.x = cvtpk(O[vb][4 * g] * il, O[vb][4 * g + 1] * il); o.y = cvtpk(O[vb][4 * g + 2] * il, O[vb][4 * g + 3] * il);
                *(u32x2*)(P.QMn + trow * 1024 + hd * 64 + vb * 32 + 8 * g + 4 * h) = o; }
    }
}
DI void attn_phase(lptr lds, const AttnP P, unsigned* counter, const int wv) {
    for (;;) {
        __syncthreads();
        if (tidx(wv) == 0) *(LAS int*)(lds + A_MISC) = (int)atomicAdd(counter, 1u);
        __syncthreads();
        const int idx = __builtin_amdgcn_readfirstlane(*(LAS int*)(lds + A_MISC));
        if (idx >= 2560) break;
        const int pr = 7 - idx / 320, rem = idx % 320;
        if (rem < 128) attn_unit<2>(lds, P, rem >> 4, rem & 15, pr, wv);
        else if (rem < 160) { const int e = rem - 128; attn_unit<0>(lds, P, e >> 2, e & 3, 2 * pr + 1, wv); }
        else if (rem < 224) { const int e = rem - 160; attn_unit<1>(lds, P, e >> 3, e & 7, 2 * pr + 1, wv); }
        else if (rem < 256) { const int e = rem - 224; attn_unit<0>(lds, P, e >> 2, e & 3, 2 * pr, wv); }
        else { const int e = rem - 256; attn_unit<1>(lds, P, e >> 3, e & 7, 2 * pr, wv); }
    }
}

constexpr int N_PHASES = 39;
template <class Epi> DI void run_gemm(lptr lds, int wv, const bf16* A, const bf16* Bt, int M, int N, int K, const Epi& E) {
#ifdef DIS_GEMM
    return;
#endif
    int bx_ = (int)blockIdx.x; asm volatile("" : "+s"(bx_));
    pg8::Gemm g{A, Bt, M, N, K}; pg8::StaticOrder S; S.init(M, N, (int)gridDim.x, bx_); S.wv = wv;
    pg8::gemm_phase<Epi, pg8::StaticOrder, true, true>(lds, g, S, E);
}
__global__ void __launch_bounds__(NTHR) mega_fwd(Params p) {
    extern __shared__ __attribute__((aligned(16))) unsigned char lds_raw[];
    lptr lds = (lptr)lds_raw;
#if !MK_MULTI
    cg::grid_group grid = cg::this_grid();
#endif
    const int wv = __builtin_amdgcn_readfirstlane((int)threadIdx.x >> 6);
    int ph = p.ph_lo; const int ph_hi = p.ph_hi;
    if (ph == 0) {
#ifndef DIS_PRO
        prologue(p, lds, wv);
#endif
        ++ph;
#if !MK_MULTI
        if (ph < ph_hi) grid.sync();
#endif
    }
    const float* xin0 = p.x; float* const outp = p.out; unsigned char* ws0 = p.ws;
    for (; ph < ph_hi; ++ph) {
        unsigned char* ws = ws0;
        asm volatile("" : "+s"(ws));
        const float* gains = (const float*)(ws + WS_GAIN);
        bf16* H = (bf16*)(ws + WS_H);
        const int hb = (ph - 1) / 19, k19 = (ph - 1) % 19;
        const size_t xoff = (size_t)hb * TH * DM;
        if (k19 == 0) norm_rows(xin0 + xoff, gains, H, TH, wv);
        else {
            const int l = (k19 - 1) / 9, k = (k19 - 1) % 9;
            const bf16* Wb = (const bf16*)(ws + WS_W) + (size_t)l * WO_END;
            if (k == 0) {
                EpiIn1 E1{ws};
                run_gemm(lds, wv, H, Wb + WO_IN1, TH, 4608, 1024, E1);
                EpiVt E2{(bf16*)(ws + WS_RVT), (bf16*)(ws + WS_DVT), nullptr, 0.f};
                run_gemm(lds, wv, Wb + WO_V, H, 2048, TH, 1024, E2);
            } else if (k == 1) {
                EpiUq Eq{(bf16*)(ws + WS_QMN), (bf16*)(ws + WS_QMP), (const float*)(ws + WS_SSQ_CQ), (const float*)(ws + WS_MCOS), (const float*)(ws + WS_MSIN), wv};
                run_gemm(lds, wv, (const bf16*)(ws + WS_CQ), Wb + WO_UQ, TH, 1536, 256, Eq);
                EpiUk Ek{(bf16*)(ws + WS_KMN), (const float*)(ws + WS_SSQ_CKV)};
                run_gemm(lds, wv, (const bf16*)(ws + WS_CKV), Wb + WO_UK, TH, 1024, 256, Ek);
                EpiVt Ev{(bf16*)(ws + WS_VMT), (bf16*)(ws + WS_VMT), (const float*)(ws + WS_SSQ_CKV), 1.f / 128.f};
                run_gemm(lds, wv, Wb + WO_UV, (const bf16*)(ws + WS_CKV), 1024, TH, 256, Ev);
            } else if (k == 2) {
#ifndef DIS_ATTN
                AttnP P{ws, (const float*)(ws + WS_SUBG) + l * 128, ((const float*)(ws + WS_LAM))[l], 0.6f * expf(-0.3f * (float)l) + 0.2f};
                attn_phase(lds, P, (unsigned*)(ws + WS_CNT) + hb * 2 + l, wv);
#endif
            } else if (k == 3) {
                bf16* G = (bf16*)(ws + WS_G); float* M32 = (float*)(ws + WS_M32); bf16* MG = (bf16*)(ws + WS_MG);
                const size_t GS = (size_t)TH * 1024;
                run_gemm(lds, wv, H, Wb + WO_G, TH, 1024, 1024, EpiAct<0>{G, 1024});
                run_gemm(lds, wv, (const bf16*)(ws + WS_RO), Wb + WO_RO, TH, 1024, 1024, EpiBranch<0>{G, M32, MG});
                run_gemm(lds, wv, H, Wb + WO_G + (size_t)1024 * 1024, TH, 1024, 1024, EpiAct<0>{G + GS, 1024});
                run_gemm(lds, wv, (const bf16*)(ws + WS_DQ), Wb + WO_DO, TH, 1024, 1024, EpiBranch<1>{G + GS, M32, MG});
                run_gemm(lds, wv, H, Wb + WO_G + (size_t)2048 * 1024, TH, 1024, 1024, EpiAct<0>{G + 2 * GS, 1024});
                run_gemm(lds, wv, (const bf16*)(ws + WS_QMN), Wb + WO_MO, TH, 1024, 1024, EpiBranch<2>{G + 2 * GS, M32, MG});
            } else if (k == 4) {
                run_gemm(lds, wv, (const bf16*)(ws + WS_MG), Wb + WO_OUT, TH, 1024, 1024, EpiY{(bf16*)(ws + WS_Y), (float*)(ws + WS_SSQ_Y)});
            } else if (k == 5) {
                resid_rows((l == 0 ? xin0 : (const float*)outp) + xoff, (const bf16*)(ws + WS_Y), (const float*)(ws + WS_SSQ_Y), gains + 2048 + l * DM, outp + xoff, gains + 4096 + l * DM, H, TH, wv);
            } else if (k == 6) {
                run_gemm(lds, wv, H, Wb + WO_UP, TH, DFF, 1024, EpiAct<1>{(bf16*)(ws + WS_U), DFF});
            } else if (k == 7) {
                run_gemm(lds, wv, (const bf16*)(ws + WS_U), Wb + WO_DOWN, TH, 1024, DFF, EpiY{(bf16*)(ws + WS_Y), (float*)(ws + WS_SSQ_Y)});
            } else {
                resid_rows(outp + xoff, (const bf16*)(ws + WS_Y), (const float*)(ws + WS_SSQ_Y), gains + 6144 + l * DM, outp + xoff, l == 0 ? gains + DM : nullptr, H, TH, wv, true);
            }
        }
#if !MK_MULTI
        if (ph + 1 < ph_hi) grid.sync();
#endif
    }
}

extern "C" void kernel_launch(void* const* d_in, const int* in_sizes, int n_in, void* d_out, int out_size, void* d_ws, size_t ws_size, hipStream_t stream) {
    static int grid = 0;
    if (grid == 0) {
        if (n_in != 22 || ws_size < WS_END) { fprintf(stderr, "kernel_launch: unexpected inputs (n_in %d, ws %zu)\n", n_in, ws_size); grid = -1; return; }
        int dev = 0, cus = 0, per_cu = 0;
        hipGetDevice(&dev); hipDeviceGetAttribute(&cus, hipDeviceAttributeMultiprocessorCount, dev);
        if (hipFuncSetAttribute((const void*)mega_fwd, hipFuncAttributeMaxDynamicSharedMemorySize, LDS_BYTES) != hipSuccess) { fprintf(stderr, "kernel_launch: hipFuncSetAttribute failed\n"); grid = -1; return; }
        if (hipOccupancyMaxActiveBlocksPerMultiprocessor(&per_cu, (const void*)mega_fwd, NTHR, LDS_BYTES) != hipSuccess || per_cu < 1) { fprintf(stderr, "kernel_launch: occupancy query gave %d\n", per_cu); per_cu = 1; }
        (void)hipGetLastError();
        grid = cus * per_cu;
        if (grid > 256) grid = 256;
    }
    if (grid < 0) return;
    Params p{};
    const float** pf = (const float**)&p;
    for (int i = 0; i < 22; ++i) pf[i] = (const float*)d_in[i];
    p.out = (float*)d_out; p.ws = (unsigned char*)d_ws;
#if MK_MULTI
#ifdef MK_CHECK
    hipLaunchKernelGGL(chk_clear, dim3(1), dim3(128), 0, stream, (unsigned char*)d_ws);
#endif
    for (int ph = 0; ph < N_PHASES; ++ph) { p.ph_lo = ph; p.ph_hi = ph + 1; hipLaunchKernelGGL(mega_fwd, dim3(grid), dim3(NTHR), LDS_BYTES, stream, p);
#ifdef MK_CHECK
        if (ph >= 1) hipLaunchKernelGGL(chk, dim3(256), dim3(256), 0, stream, p, ph);
#endif
    }
#ifdef MK_CHECK
    hipLaunchKernelGGL(chk_report, dim3(1), dim3(64), 0, stream, (unsigned char*)d_ws, (float*)d_out);
#endif
#else
    p.ph_lo = 0; p.ph_hi = N_PHASES;
    void* args[] = {&p};
    hipError_t e = hipLaunchCooperativeKernel((const void*)mega_fwd, dim3(grid), dim3(NTHR), args, LDS_BYTES, stream);
    if (e != hipSuccess) fprintf(stderr, "cooperative launch failed: %s (grid %d)\n", hipGetErrorString(e), grid);
#endif
}
```

```cpp
#include <hip/hip_runtime.h>
#include <hip/hip_cooperative_groups.h>
#include <cstdio>
#include <cstdint>
namespace cg = cooperative_groups;
__device__ __forceinline__ int tidx(int wv) { int t = (wv << 6) | (int)__builtin_amdgcn_mbcnt_hi(~0u, __builtin_amdgcn_mbcnt_lo(~0u, 0u)); asm volatile("" : "+v"(t)); return t; }
namespace pg8 {
#define PG8_LAS __attribute__((address_space(3)))
typedef unsigned short bf16_t;
typedef short bf16x8 __attribute__((ext_vector_type(8)));
typedef float f32x4 __attribute__((ext_vector_type(4)));
typedef unsigned u32x4 __attribute__((ext_vector_type(4)));
constexpr int BM = 256, BK = 64, HALF = 128, HTB = HALF * BK * 2  , STAGE_BYTES = 8 * HTB, NXCD = 8, WGM = 8;

__host__ __device__ __forceinline__ int lds_byte(int r, int c) { const int st = (r >> 4) * 2 + (c >> 5), rr = r & 15, cc = c & 31, ob = rr * 64 + cc * 2; return st * 1024 + (ob ^ (((ob >> 9) & 1) << 5)); }
__host__ __device__ __forceinline__ void stage_rc(int b, int& R, int& C) { const int st = b / 1024, sb = b % 1024, swz = sb ^ (((sb >> 9) & 1) << 5); R = (st >> 1) * 16 + swz / 64; C = (st & 1) * 32 + (swz % 64) / 2; }
__host__ __device__ __forceinline__ int perm32(int rho) { const int n = rho >> 4, i = rho & 15; return 8 * (i >> 2) + 4 * n + (i & 3); }

struct Unit { int pm, pn; };
struct Gemm { const bf16_t* A; const bf16_t* Bt; int M, N, K; };

struct StaticOrder {
    int nM, nN, nwg, G, c, wv;
    __host__ __device__ void init(int M, int N, int G_, int c_) { nM = M / BM; nN = N / BM; nwg = nM * nN; G = G_; c = c_; }
    __host__ __device__ bool next(int i, Unit& u) const {
        const long L = (long)i * G + c; if (L >= nwg) return false;
        int wgid = (int)L; { const int q = nwg / NXCD, r = nwg % NXCD, xcd = wgid % NXCD, off = wgid / NXCD; wgid = (xcd < r ? xcd * (q + 1) : r * (q + 1) + (xcd - r) * q) + off; }
        const int nig = WGM * nN, gid = wgid / nig, fm = gid * WGM, gsz = (nM - fm) < WGM ? (nM - fm) : WGM;
        u.pm = fm + ((wgid % nig) % gsz); u.pn = (wgid % nig) / gsz; return true;
    }
    __device__ __forceinline__ void a_ready(const Unit&) const {}
    __device__ __forceinline__ void done(const Unit&) const {}
};

__device__ __forceinline__ unsigned cvt_pk_bf16(float lo, float hi) { unsigned r; asm volatile("v_cvt_pk_bf16_f32 %0, %1, %2" : "=v"(r) : "v"(lo), "v"(hi)); return r; }
template <class Epi, class Sched, bool ALIGN_EPI = false, bool SP2 = false>
__device__ __forceinline__ void gemm_phase(PG8_LAS unsigned char* lds, const Gemm g, const Sched& S, const Epi& E) {
    const int tid = tidx(S.wv), wid = __builtin_amdgcn_readfirstlane(tid >> 6), lane = tid & 63, wr = wid >> 2, wc = wid & 3, fr = lane & 15, fq = lane >> 4;
    const int K = g.K, nt = K / BK;
    unsigned voffA[2], voffB[2];
#pragma unroll
    for (int i = 0; i < 2; ++i) { int R, C; stage_rc(tid * 16 + i * 8192, R, C); const int Rb = Epi::PERM ? ((R & ~31) + perm32(R & 31)) : R;
        voffA[i] = (unsigned)(R * K + C) * 2u; voffB[i] = (unsigned)(Rb * K + C) * 2u; }
    const size_t kstep = (size_t)(BK * 2);
    const size_t hstep = (size_t)HALF * K * 2;
    const size_t tstep = 2 * hstep;
    const unsigned ldsw = (unsigned)wid * 1024u;
    const int aoff = lds_byte(wr * 64 + fr, fq * 8), boff = lds_byte(wc * 32 + fr, fq * 8);
#define PG8_SA(b, h) (((b) * 2 + (h)) * HTB)
#define PG8_SB(b, h) ((4 + (b) * 2 + (h)) * HTB)
#define PG8_STAGE(bufoff, gbase, voff) do { _Pragma("unroll") for (int _i = 0; _i < 2; ++_i) \
        __builtin_amdgcn_global_load_lds((const unsigned*)((const char*)(gbase) + (voff)[_i]), (PG8_LAS unsigned*)(lds + (bufoff) + ldsw + _i * 8192), 16, 0, 0); } while (0)
#define PG8_LDA(dst, b, h) do { _Pragma("unroll") for (int m = 0; m < 4; ++m) _Pragma("unroll") for (int k = 0; k < 2; ++k) dst[m][k] = *(const PG8_LAS bf16x8*)(lds + PG8_SA(b, h) + aoff + m * 2048 + k * 1024); } while (0)
#define PG8_LDB(dst, b, h) do { _Pragma("unroll") for (int n = 0; n < 2; ++n) _Pragma("unroll") for (int k = 0; k < 2; ++k) dst[n][k] = *(const PG8_LAS bf16x8*)(lds + PG8_SB(b, h) + boff + n * 2048 + k * 1024); } while (0)
#define PG8_MMA(ai, bj, At, Bt) do { __builtin_amdgcn_s_setprio(1); _Pragma("unroll") for (int m = 0; m < 4; ++m) _Pragma("unroll") for (int n = 0; n < 2; ++n) _Pragma("unroll") for (int k = 0; k < 2; ++k) \
        acc[ai][bj][m][n] = __builtin_amdgcn_mfma_f32_16x16x32_bf16(Bt[n][k], At[m][k], acc[ai][bj][m][n], 0, 0, 0); __builtin_amdgcn_s_setprio(0); } while (0)
#define PG8_WAIT_V(n) asm volatile("s_waitcnt vmcnt(" #n ")" ::: "memory")
#define PG8_WAIT_L(n) asm volatile("s_waitcnt lgkmcnt(" #n ")" ::: "memory")
#define PG8_BAR __builtin_amdgcn_s_barrier()
#define PG8_SCHED __builtin_amdgcn_sched_barrier(0)
    Unit cur, nxt; int ui = 0;
    if (!S.next(0, cur)) return;
    f32x4 acc[2][2][4][2];
#pragma unroll
    for (int a = 0; a < 2; ++a)
#pragma unroll
        for (int b = 0; b < 2; ++b)
#pragma unroll
            for (int m = 0; m < 4; ++m)
#pragma unroll
                for (int n = 0; n < 2; ++n) acc[a][b][m][n] = (f32x4){0.f, 0.f, 0.f, 0.f};
    bf16x8 At[4][2], B0[2][2], B1[2][2];
    const char* cA = (const char*)g.A + (size_t)cur.pm * tstep; const char* cB = (const char*)g.Bt + (size_t)cur.pn * tstep;
    S.a_ready(cur);
    if constexpr (SP2) {
        PG8_STAGE(PG8_SB(0, 0), cB, voffB); PG8_STAGE(PG8_SB(0, 1), cB + hstep, voffB); PG8_STAGE(PG8_SA(0, 0), cA, voffA); PG8_STAGE(PG8_SA(0, 1), cA + hstep, voffA);
        if (wr == 1) PG8_BAR;
        PG8_WAIT_V(2); PG8_BAR;
        PG8_STAGE(PG8_SB(1, 0), cB + kstep, voffB); PG8_STAGE(PG8_SA(1, 0), cA + kstep, voffA); PG8_STAGE(PG8_SB(1, 1), cB + hstep + kstep, voffB);
        PG8_WAIT_V(6); PG8_BAR;
    } else {
        PG8_STAGE(PG8_SB(0, 0), cB, voffB); PG8_STAGE(PG8_SA(0, 0), cA, voffA); PG8_STAGE(PG8_SB(0, 1), cB + hstep, voffB); PG8_STAGE(PG8_SA(0, 1), cA + hstep, voffA);
        if (wr == 1) PG8_BAR;
        PG8_WAIT_V(4); PG8_BAR;
        PG8_STAGE(PG8_SB(1, 0), cB + kstep, voffB); PG8_STAGE(PG8_SA(1, 0), cA + kstep, voffA); PG8_STAGE(PG8_SB(1, 1), cB + hstep + kstep, voffB);
        PG8_WAIT_V(6); PG8_BAR;
    }
    for (;;) {
        const bool has_next = S.next(ui + 1, nxt);
        const char* nA = has_next ? (const char*)g.A + (size_t)nxt.pm * tstep : cA; const char* nB = has_next ? (const char*)g.Bt + (size_t)nxt.pn * tstep : cB;
        for (int t = 0; t < nt; t += 2) {
            const bool last = (t == nt - 2);
            const char* a1 = cA + (size_t)(t + 1) * kstep;
            const char* a2 = last ? nA : cA + (size_t)(t + 2) * kstep; const char* b2 = last ? nB : cB + (size_t)(t + 2) * kstep;
            const char* a3 = a2 + kstep; const char* b3 = b2 + kstep;
            if (last && has_next) S.a_ready(nxt);
            if constexpr (SP2) {
            PG8_LDB(B0, 0, 0); PG8_LDB(B1, 0, 1); PG8_SCHED; PG8_LDA(At, 0, 0); PG8_STAGE(PG8_SA(1, 1), a1 + hstep, voffA);
            PG8_WAIT_V(8); PG8_WAIT_L(0); PG8_BAR; PG8_MMA(0, 0, At, B0); PG8_MMA(0, 1, At, B1); PG8_BAR; PG8_SCHED;
            PG8_LDA(At, 0, 1); PG8_STAGE(PG8_SB(0, 0), b2, voffB); PG8_STAGE(PG8_SB(0, 1), b2 + hstep, voffB); PG8_STAGE(PG8_SA(0, 0), a2, voffA);
            PG8_WAIT_V(8); PG8_WAIT_L(0); PG8_BAR; PG8_MMA(1, 0, At, B0); PG8_MMA(1, 1, At, B1); PG8_BAR; PG8_SCHED;
            PG8_LDB(B0, 1, 0); PG8_LDB(B1, 1, 1); PG8_SCHED; PG8_LDA(At, 1, 0); PG8_STAGE(PG8_SA(0, 1), a2 + hstep, voffA);
            PG8_WAIT_V(8); PG8_WAIT_L(0); PG8_BAR; PG8_MMA(0, 0, At, B0); PG8_MMA(0, 1, At, B1); PG8_BAR; PG8_SCHED;
            PG8_LDA(At, 1, 1); PG8_STAGE(PG8_SB(1, 0), b3, voffB); PG8_STAGE(PG8_SB(1, 1), b3 + hstep, voffB); PG8_STAGE(PG8_SA(1, 0), a3, voffA);
            PG8_WAIT_V(8); PG8_WAIT_L(0); PG8_BAR; PG8_MMA(1, 0, At, B0); PG8_MMA(1, 1, At, B1); PG8_BAR; PG8_SCHED;
            } else {
            PG8_LDB(B0, 0, 0); PG8_SCHED; PG8_LDA(At, 0, 0); PG8_STAGE(PG8_SA(1, 1), a1 + hstep, voffA);
            PG8_WAIT_L(8); PG8_BAR; PG8_WAIT_L(0); PG8_MMA(0, 0, At, B0); PG8_BAR; PG8_SCHED;
            PG8_LDB(B1, 0, 1); PG8_STAGE(PG8_SB(0, 0), b2, voffB);
            PG8_BAR; PG8_WAIT_L(0); PG8_MMA(0, 1, At, B1); PG8_BAR;
            PG8_LDA(At, 0, 1); PG8_STAGE(PG8_SA(0, 0), a2, voffA);
            PG8_BAR; PG8_WAIT_L(0); PG8_MMA(1, 0, At, B0); PG8_BAR; PG8_SCHED;
            PG8_STAGE(PG8_SB(0, 1), b2 + hstep, voffB);
            PG8_WAIT_V(6); PG8_BAR; PG8_MMA(1, 1, At, B1); PG8_BAR;
            PG8_LDB(B0, 1, 0); PG8_SCHED; PG8_LDA(At, 1, 0); PG8_STAGE(PG8_SA(0, 1), a2 + hstep, voffA);
            PG8_WAIT_L(8); PG8_BAR; PG8_WAIT_L(0); PG8_MMA(0, 0, At, B0); PG8_BAR; PG8_SCHED;
            PG8_LDB(B1, 1, 1); PG8_STAGE(PG8_SB(1, 0), b3, voffB);
            PG8_BAR; PG8_WAIT_L(0); PG8_MMA(0, 1, At, B1); PG8_BAR;
            PG8_LDA(At, 1, 1); PG8_STAGE(PG8_SA(1, 0), a3, voffA);
            PG8_BAR; PG8_WAIT_L(0); PG8_MMA(1, 0, At, B0); PG8_BAR; PG8_SCHED;
            PG8_STAGE(PG8_SB(1, 1), b3 + hstep, voffB);
            PG8_WAIT_V(6); PG8_BAR; PG8_MMA(1, 1, At, B1); PG8_BAR;
            }
        }
        if constexpr (ALIGN_EPI) { if (wr == 0) PG8_BAR; }
        if constexpr (!Epi::AFTER_DRAIN) { E(acc, cur, wr, wc, fr, fq); S.done(cur); }
        if (!has_next) break;
#pragma unroll
        for (int a = 0; a < 2; ++a)
#pragma unroll
            for (int b = 0; b < 2; ++b)
#pragma unroll
                for (int m = 0; m < 4; ++m)
#pragma unroll
                    for (int n = 0; n < 2; ++n) acc[a][b][m][n] = (f32x4){0.f, 0.f, 0.f, 0.f};
        cur = nxt; cA = nA; cB = nB; ++ui;
        if constexpr (ALIGN_EPI) { if (wr == 1) PG8_BAR; }
    }
    PG8_WAIT_V(0);
    if constexpr (!ALIGN_EPI) { if (wr == 0) PG8_BAR; }
    PG8_BAR;
    if constexpr (Epi::AFTER_DRAIN) { E.fused(acc, cur, wr, wc, fr, fq, lds, wid, lane); S.done(cur); }
#undef PG8_SA
#undef PG8_SB
#undef PG8_STAGE
#undef PG8_LDA
#undef PG8_LDB
#undef PG8_MMA
#undef PG8_WAIT_V
#undef PG8_WAIT_L
#undef PG8_BAR
#undef PG8_SCHED
}
}


#ifndef MK_MULTI
#define MK_MULTI 0
#endif
#define DI __device__ __forceinline__
#define LAS __attribute__((address_space(3)))
typedef unsigned short bf16;
typedef short bf16x8 __attribute__((ext_vector_type(8)));
typedef float f32x4 __attribute__((ext_vector_type(4)));
typedef float f32x16 __attribute__((ext_vector_type(16)));
typedef unsigned u32x4 __attribute__((ext_vector_type(4)));
typedef unsigned u32x2 __attribute__((ext_vector_type(2)));
typedef float f32x2_t __attribute__((ext_vector_type(2)));
typedef __bf16 bf16x2_t __attribute__((ext_vector_type(2)));
typedef LAS unsigned char* lptr;


constexpr int SEQ = 2048, DM = 1024, TH = 16384  , DFF = 4096, DIN = 9632;
constexpr float EPS = 1e-6f, LOG2E = 1.4426950408889634f;
constexpr float QSC_DIFF = 0.125f * LOG2E;
constexpr float QSC_MLA = 0.10206207261596575f * LOG2E;
constexpr float KSC_RET = 0.08838834764831845f;
constexpr int NTHR = 512;
constexpr int LDS_BYTES = 147456;

constexpr size_t MiB = 1u << 20;
constexpr size_t WS_CNT = 0, WS_LAM = 256, WS_BIAS = 1024, WS_GAIN = 65536;
constexpr size_t WS_SUBG = WS_GAIN + 4 * 2 * 1024 * 4;
constexpr size_t WS_RCOS = 1 * MiB, WS_RSIN = WS_RCOS + 512 * 1024, WS_MCOS = 2 * MiB, WS_MSIN = WS_MCOS + 128 * 1024;
constexpr size_t WS_W = 4 * MiB;
constexpr size_t WO_IN1 = 0, WO_V = WO_IN1 + 4608 * 1024, WO_G = WO_V + 2048 * 1024, WO_UQ = WO_G + 3072 * 1024, WO_UK = WO_UQ + 1536 * 256,
                 WO_UV = WO_UK + 1024 * 256, WO_RO = WO_UV + 1024 * 256, WO_DO = WO_RO + 1024 * 1024, WO_MO = WO_DO + 1024 * 1024, WO_OUT = WO_MO + 1024 * 1024,
                 WO_UP = WO_OUT + 1024 * 1024, WO_DOWN = WO_UP + 4096 * 1024, WO_END = WO_DOWN + 4096 * 1024;
static_assert(WS_W + 2 * WO_END * 2 <= 96 * MiB, "weights fit");
constexpr size_t WS_H = 96 * MiB;
constexpr size_t WS_RQ = 128 * MiB, WS_RK = 144 * MiB, WS_RVT = 160 * MiB, WS_RG = 192 * MiB, WS_G = 128 * MiB;
constexpr size_t WS_DQ = 224 * MiB, WS_DK = 256 * MiB, WS_DVT = 288 * MiB, WS_M32 = 256 * MiB;
constexpr size_t WS_CQ = 320 * MiB, WS_CKV = 328 * MiB  , WS_KPE = 336 * MiB, WS_SSQ_CQ = 337 * MiB, WS_SSQ_CKV = WS_SSQ_CQ + 256 * 1024;
constexpr size_t WS_QMN = 338 * MiB, WS_QMP = 370 * MiB, WS_KMN = 386 * MiB, WS_VMT = 418 * MiB, WS_RO = 450 * MiB;
constexpr size_t WS_MG = 370 * MiB, WS_Y = 402 * MiB, WS_SSQ_Y = 434 * MiB, WS_U = 128 * MiB, WS_END = 482 * MiB;

struct Params {
    const float *x, *rel_bias, *pre_mix_g, *w_in, *w_ret_o, *lq1, *lk1, *lq2, *lk2, *subln_g, *w_diff_o, *q_norm_g, *w_uq, *kv_norm_g, *w_ukv, *w_mla_o,
                *w_out, *post_mix_g, *pre_mlp_g, *w_up, *w_down, *post_mlp_g;
    float* out; unsigned char* ws; int ph_lo, ph_hi;
};

DI unsigned cvtpk(float lo, float hi) { f32x2_t v = {lo, hi}; bf16x2_t b = __builtin_convertvector(v, bf16x2_t); return __builtin_bit_cast(unsigned, b); }
DI u32x4 pack8(f32x4 a, f32x4 b) { u32x4 w; w.x = cvtpk(a[0], a[1]); w.y = cvtpk(a[2], a[3]); w.z = cvtpk(b[0], b[1]); w.w = cvtpk(b[2], b[3]); return w; }
DI float bflo(unsigned u) { return __uint_as_float(u << 16); }
DI float bfhi(unsigned u) { return __uint_as_float(u & 0xffff0000u); }
DI void unpack8(u32x4 w, f32x4& a, f32x4& b) { a = (f32x4){bflo(w.x), bfhi(w.x), bflo(w.y), bfhi(w.y)}; b = (f32x4){bflo(w.z), bfhi(w.z), bflo(w.w), bfhi(w.w)}; }
DI float ex2(float x) { return __builtin_amdgcn_exp2f(x); }
DI float sigm(float x) { return __builtin_amdgcn_rcpf(1.f + ex2(-x * LOG2E)); }
DI float shx(float v, int m, int lane) { return __int_as_float(__builtin_amdgcn_ds_bpermute((lane ^ m) << 2, __float_as_int(v))); }
DI float wave_sum(float v, int lane) {
#pragma unroll
    for (int o = 1; o < 64; o <<= 1) v += shx(v, o, lane);
    return v;
}
DI float sq4(f32x4 v) { return (v[0] * v[0] + v[1] * v[1]) + (v[2] * v[2] + v[3] * v[3]); }

DI int colmap(int map, int n, int off) {
    switch (map) {
        case 0: return off + n;
        case 1: { const int p = n & 127, bj = (n >> 7) & 1; return off + (n & ~255) + (p >> 6) * 128 + bj * 64 + (p & 63); }
        case 2: { if (n < 128) return 6400 + n; if (n >= 160) return -1; const int q = n - 128; return 6528 + 16 * ((q >> 2) & 1) + 4 * (q >> 3) + (q & 3); }
        case 3: { if (n < 1024) return (n >> 6) * 96 + (n & 63); const int q = n - 1024, hh = q >> 5, pos = q & 31; return hh * 96 + 64 + 16 * ((pos >> 2) & 1) + 4 * (pos >> 3) + (pos & 3); }
        case 4: return (n >> 6) * 128 + (n & 63);
        default: return (n >> 6) * 128 + 64 + (n & 63);
    }
}
DI void conv_item(const float* W, int ldw, int K, int kvalid, bf16* WT, int map, int off, const float* gs, LAS float* scr, int item, int nblk, int lane) {
    const int kb = item / nblk, nb = item % nblk, k0 = 64 * kb, n0 = 32 * nb;
    const int oc = colmap(map, n0 + (lane & 31), off);
#pragma unroll 8
    for (int i = 0; i < 32; ++i) { const int kk = 2 * i + (lane >> 5); float v = 0.f; if (oc >= 0 && k0 + kk < kvalid) { v = W[(size_t)(k0 + kk) * ldw + oc]; if (gs) v *= gs[k0 + kk]; } scr[kk * 33 + (lane & 31)] = v; }
    asm volatile("s_waitcnt lgkmcnt(0)" ::: "memory");
    const int c = lane & 7;
#pragma unroll
    for (int j = 0; j < 4; ++j) { const int n = (lane >> 3) + 8 * j; const LAS float* s = scr + (8 * c) * 33 + n;
        u32x4 o; o.x = cvtpk(s[0 * 33], s[1 * 33]); o.y = cvtpk(s[2 * 33], s[3 * 33]); o.z = cvtpk(s[4 * 33], s[5 * 33]); o.w = cvtpk(s[6 * 33], s[7 * 33]);
        *(u32x4*)(WT + (size_t)(n0 + n) * K + k0 + 8 * c) = o; }
    asm volatile("s_waitcnt lgkmcnt(0)" ::: "memory");
}
DI int t5_bucket(int n) {
    if (n < 16) return n;
    int large = 16 + (int)(logf((float)n / 16.f) / 2.0794415416798357f * 16.f);
    return large < 31 ? large : 31;
}
DI void prologue(const Params& p, lptr lds, int wv) {
    const int tid = tidx(wv), lane = tid & 63, wave = tid >> 6;
    const int gw = blockIdx.x * 8 + wave, NGW = gridDim.x * 8, gt = blockIdx.x * NTHR + tid, NGT = gridDim.x * NTHR;
    unsigned char* ws = p.ws;
    if (blockIdx.x == 0) {
        if (tid < 16) ((unsigned*)(ws + WS_CNT))[tid] = 0u;
        if (tid >= 64 && tid < 66) {
            const int l = tid - 64; float a = 0.f, b = 0.f;
            for (int i = 0; i < 64; ++i) { a += p.lq1[l * 64 + i] * p.lk1[l * 64 + i]; b += p.lq2[l * 64 + i] * p.lk2[l * 64 + i]; }
            const float linit = 0.8f - 0.6f * expf(-0.3f * (float)l);
            ((float*)(ws + WS_LAM))[l] = expf(a) - expf(b) + linit;
        }
    }
    for (int i = gt; i < 2048; i += NGT) { float* gd = (float*)(ws + WS_GAIN); gd[i] = p.pre_mix_g[i]; gd[2048 + i] = p.post_mix_g[i]; gd[4096 + i] = p.pre_mlp_g[i]; gd[6144 + i] = p.post_mlp_g[i]; if (i < 256) ((float*)(ws + WS_SUBG))[i] = p.subln_g[i]; }
    for (int i = gt; i < 8 * 128; i += NGT) { const int hh = i >> 7, n = i & 127; ((float*)(ws + WS_BIAS))[i] = p.rel_bias[t5_bucket(n) * 8 + hh] * LOG2E; }
    for (int i = gt; i < SEQ * 64; i += NGT) { const int s = i >> 6, d = i & 63; const float inv = (float)(1.0 / pow(10000.0, (double)d / 63.0)); const float ang = (float)s * inv;
        ((float*)(ws + WS_RCOS))[i] = (float)cos((double)ang); ((float*)(ws + WS_RSIN))[i] = (float)sin((double)ang); }
    for (int i = gt; i < SEQ * 16; i += NGT) { const int s = i >> 4, d = i & 15; const float inv = (float)(1.0 / pow(10000.0, (double)(2 * d) / 32.0)); const float ang = (float)s * inv;
        ((float*)(ws + WS_MCOS))[i] = (float)cos((double)ang); ((float*)(ws + WS_MSIN))[i] = (float)sin((double)ang); }
    LAS float* scr = (LAS float*)(lds + wave * 16384);
    for (int l = 0; l < 2; ++l) {
        bf16* Wb = (bf16*)(ws + WS_W) + (size_t)l * WO_END;
        const float* win = p.w_in + (size_t)l * DM * DIN;
        for (int job = 0; job < 19; ++job) {
            const float* src = win; int ldw = DIN, K = 1024, kvalid = 4096, ns = 1024, map = 0, off = 0; const float* gs = nullptr; bf16* dst = Wb;
            switch (job) {
                case 0: ns = 512; map = 1; off = 0; dst = Wb + WO_IN1; break;
                case 1: ns = 512; map = 1; off = 512; dst = Wb + WO_IN1 + (size_t)512 * 1024; break;
                case 2: off = 2048; dst = Wb + WO_IN1 + (size_t)1024 * 1024; break;
                case 3: off = 3072; dst = Wb + WO_IN1 + (size_t)2048 * 1024; break;
                case 4: off = 4096; dst = Wb + WO_IN1 + (size_t)3072 * 1024; break;
                case 5: ns = 256; off = 6144; dst = Wb + WO_IN1 + (size_t)4096 * 1024; break;
                case 6: ns = 256; map = 2; dst = Wb + WO_IN1 + (size_t)4352 * 1024; break;
                case 7: off = 1024; dst = Wb + WO_V; break;
                case 8: off = 5120; dst = Wb + WO_V + (size_t)1024 * 1024; break;
                case 9: ns = 3072; off = 6560; dst = Wb + WO_G; break;
                case 10: src = p.w_uq + (size_t)l * 256 * 1536; ldw = 1536; K = 256; ns = 1536; map = 3; gs = p.q_norm_g + l * 256; dst = Wb + WO_UQ; break;
                case 11: src = p.w_ukv + (size_t)l * 128 * 2048; ldw = 2048; K = 256; kvalid = 128; map = 4; gs = p.kv_norm_g + l * 128; dst = Wb + WO_UK; break;
                case 12: src = p.w_ukv + (size_t)l * 128 * 2048; ldw = 2048; K = 256; kvalid = 128; map = 5; gs = p.kv_norm_g + l * 128; dst = Wb + WO_UV; break;
                case 13: src = p.w_ret_o + (size_t)l * 1024 * 1024; ldw = 1024; dst = Wb + WO_RO; break;
                case 14: src = p.w_diff_o + (size_t)l * 1024 * 1024; ldw = 1024; dst = Wb + WO_DO; break;
                case 15: src = p.w_mla_o + (size_t)l * 1024 * 1024; ldw = 1024; dst = Wb + WO_MO; break;
                case 16: src = p.w_out + (size_t)l * 1024 * 1024; ldw = 1024; dst = Wb + WO_OUT; break;
                case 17: src = p.w_up + (size_t)l * 1024 * 4096; ldw = 4096; ns = 4096; dst = Wb + WO_UP; break;
                default: src = p.w_down + (size_t)l * 4096 * 1024; ldw = 1024; K = 4096; dst = Wb + WO_DOWN; break;
            }
            const int nblk = ns / 32, items = (K / 64) * nblk;
            for (int it = gw; it < items; it += NGW) conv_item(src, ldw, K, kvalid, dst, map, off, gs, scr, it, nblk, lane);
        }
    }
}

DI void norm_rows(const float* x, const float* g, bf16* o, int rows, int wv) {
    const int tid_ = tidx(wv); const int lane = tid_ & 63, gw = blockIdx.x * 8 + (tid_ >> 6), NGW = gridDim.x * 8;
    for (int m = gw; m < rows; m += NGW) {
        const f32x4* xr = (const f32x4*)(x + (size_t)m * DM) + lane; f32x4 v[4]; float s = 0.f;
#pragma unroll
        for (int j = 0; j < 4; ++j) { v[j] = xr[64 * j]; s += sq4(v[j]); }
        const float rs = 1.0f / sqrtf(wave_sum(s, lane) * (1.f / DM) + EPS);
        u32x2* o8 = (u32x2*)(o + (size_t)m * DM) + lane;
#pragma unroll
        for (int j = 0; j < 4; ++j) { const f32x4 gg = ((const f32x4*)g)[lane + 64 * j]; u32x2 w; w.x = cvtpk(v[j][0] * rs * gg[0], v[j][1] * rs * gg[1]); w.y = cvtpk(v[j][2] * rs * gg[2], v[j][3] * rs * gg[3]); o8[64 * j] = w; }
    }
}
DI void resid_rows(const float* xin, const bf16* y, const float* ssq, const float* gpost, float* xout, const float* gnext, bf16* hout, int rows, int wv, bool ablate = false) {
    const int tid_ = tidx(wv); const int lane = tid_ & 63, gw = blockIdx.x * 8 + (tid_ >> 6), NGW = gridDim.x * 8;
    for (int m = gw; m < rows; m += NGW) {
        const float part = lane < 16 ? ssq[(size_t)m * 16 + lane] : 0.f;
        float rs = 1.0f / sqrtf(wave_sum(part, lane) * (1.f / DM) + EPS);
#ifdef ABL_MLP
        if (!gnext || gnext == (const float*)0 + 1) rs = rs; if (ablate) rs = 0.f;
#endif
        const f32x4* xr = (const f32x4*)(xin + (size_t)m * DM) + lane; const u32x2* yr = (const u32x2*)(y + (size_t)m * DM) + lane; f32x4* xo = (f32x4*)(xout + (size_t)m * DM) + lane;
        f32x4 v[4]; float s = 0.f;
#pragma unroll
        for (int j = 0; j < 4; ++j) { const f32x4 xv = xr[64 * j]; const u32x2 yw = yr[64 * j]; const f32x4 gg = ((const f32x4*)gpost)[lane + 64 * j];
            f32x4 yv = (f32x4){bflo(yw.x), bfhi(yw.x), bflo(yw.y), bfhi(yw.y)};
            v[j] = xv + yv * rs * gg; xo[64 * j] = v[j]; s += sq4(v[j]); }
        if (gnext) {
            const float rs2 = 1.0f / sqrtf(wave_sum(s, lane) * (1.f / DM) + EPS);
            u32x2* o8 = (u32x2*)(hout + (size_t)m * DM) + lane;
#pragma unroll
            for (int j = 0; j < 4; ++j) { const f32x4 gg = ((const f32x4*)gnext)[lane + 64 * j]; u32x2 w; w.x = cvtpk(v[j][0] * rs2 * gg[0], v[j][1] * rs2 * gg[1]); w.y = cvtpk(v[j][2] * rs2 * gg[2], v[j][3] * rs2 * gg[3]); o8[64 * j] = w; }
        }
    }
}

#define EPI_ARGS const f32x4 (&acc)[2][2][4][2], const pg8::Unit& u, int wr, int wc, int fr, int fq
#define FOR_AI_M _Pragma("unroll") for (int ai = 0; ai < 2; ++ai) _Pragma("unroll") for (int m = 0; m < 4; ++m)
#define FOR_BJ _Pragma("unroll") for (int bj = 0; bj < 2; ++bj)

struct EpiIn1 {
    static constexpr bool PERM = true, AFTER_DRAIN = false;
    unsigned char* ws;
    DI void operator()(EPI_ARGS) const {
        asm volatile("" : "+v"(fr), "+v"(fq));
        bf16 *RQ = (bf16*)(ws + WS_RQ), *RK = (bf16*)(ws + WS_RK), *RG = (bf16*)(ws + WS_RG), *DQ = (bf16*)(ws + WS_DQ), *DK = (bf16*)(ws + WS_DK), *CQ = (bf16*)(ws + WS_CQ), *CKV = (bf16*)(ws + WS_CKV), *KPE = (bf16*)(ws + WS_KPE);
        float *SSQ_CQ = (float*)(ws + WS_SSQ_CQ), *SSQ_CKV = (float*)(ws + WS_SSQ_CKV);
        const float *rcos = (const float*)(ws + WS_RCOS), *rsin = (const float*)(ws + WS_RSIN), *mcos = (const float*)(ws + WS_MCOS), *msin = (const float*)(ws + WS_MSIN);
        const int pn = u.pn, row0 = u.pm * 256 + wr * 64 + fr, c8 = wc * 32 + 8 * fq;
        if (pn < 4) {
            bf16* dst = pn < 2 ? RQ : RK; const float sc = pn < 2 ? 1.f : KSC_RET; const int head = 2 * (pn & 1) + (wc >> 1), d0 = c8 & 63;
            FOR_AI_M { const int t = row0 + ai * 128 + m * 16, s = t & (SEQ - 1);
                const f32x4 c0 = *(const f32x4*)(rcos + s * 64 + d0), c1 = *(const f32x4*)(rcos + s * 64 + d0 + 4), s0 = *(const f32x4*)(rsin + s * 64 + d0), s1 = *(const f32x4*)(rsin + s * 64 + d0 + 4);
                const f32x4 x1a = acc[ai][0][m][0], x1b = acc[ai][0][m][1], x2a = acc[ai][1][m][0], x2b = acc[ai][1][m][1];
                bf16* o = dst + (size_t)t * 512 + head * 128 + d0;
                *(u32x4*)o = pack8((x1a * c0 - x2a * s0) * sc, (x1b * c1 - x2b * s1) * sc);
                *(u32x4*)(o + 64) = pack8((x2a * c0 + x1a * s0) * sc, (x2b * c1 + x1b * s1) * sc); asm volatile("" ::: "memory"); }
        } else if (pn < 16) {
            const int seg = (pn - 4) >> 2; bf16* dst = seg == 0 ? RG : (seg == 1 ? DQ : DK); const int colb = ((pn - 4) & 3) * 256 + c8;
            FOR_AI_M { const int t = row0 + ai * 128 + m * 16;
                FOR_BJ { f32x4 v0 = acc[ai][bj][m][0], v1 = acc[ai][bj][m][1];
                    if (seg == 0) {
#pragma unroll
                        for (int i = 0; i < 4; ++i) { v0[i] = v0[i] * sigm(v0[i]); v1[i] = v1[i] * sigm(v1[i]); } }
                    else if (seg == 1) { v0 = v0 * QSC_DIFF; v1 = v1 * QSC_DIFF; }
                    *(u32x4*)(dst + (size_t)t * 1024 + colb + bj * 128) = pack8(v0, v1); } }
        } else if (pn == 16) {
            FOR_AI_M { const int t = row0 + ai * 128 + m * 16; float ss = 0.f;
                FOR_BJ { const f32x4 v0 = acc[ai][bj][m][0], v1 = acc[ai][bj][m][1]; ss += sq4(v0) + sq4(v1); *(u32x4*)(CQ + (size_t)t * 256 + c8 + bj * 128) = pack8(v0, v1); }
                ss += shx(ss, 16, fq * 16 + fr); ss += shx(ss, 32, fq * 16 + fr);
                if (fq == 0) SSQ_CQ[(size_t)t * 4 + wc] = ss; }
        } else {
            FOR_AI_M { const int t = row0 + ai * 128 + m * 16, s = t & (SEQ - 1);
                const f32x4 v0 = acc[ai][0][m][0], v1 = acc[ai][0][m][1]; float ss = sq4(v0) + sq4(v1);
                *(u32x4*)(CKV + (size_t)t * 256 + c8) = pack8(v0, v1); *(u32x4*)(CKV + (size_t)t * 256 + 128 + c8) = pack8(acc[ai][1][m][0], acc[ai][1][m][1]);
                ss += shx(ss, 16, fq * 16 + fr); ss += shx(ss, 32, fq * 16 + fr);
                if (fq == 0) SSQ_CKV[(size_t)t * 4 + wc] = ss;
                if (wc == 0) { const f32x4 x1 = acc[ai][1][m][0], x2 = acc[ai][1][m][1]; const f32x4 c = *(const f32x4*)(mcos + s * 16 + 4 * fq), sn = *(const f32x4*)(msin + s * 16 + 4 * fq);
                    const f32x4 o1 = x1 * c - x2 * sn, o2 = x2 * c + x1 * sn; u32x2 w1, w2; w1.x = cvtpk(o1[0], o1[1]); w1.y = cvtpk(o1[2], o1[3]); w2.x = cvtpk(o2[0], o2[1]); w2.y = cvtpk(o2[2], o2[3]);
                    *(u32x2*)(KPE + (size_t)t * 32 + 4 * fq) = w1; *(u32x2*)(KPE + (size_t)t * 32 + 16 + 4 * fq) = w2; } }
        }
    }
};
struct EpiVt {
    static constexpr bool PERM = true, AFTER_DRAIN = false;
    bf16 *T0, *T1; const float* ssq; float inv_n;
    DI void operator()(EPI_ARGS) const {
        asm volatile("" : "+v"(fr), "+v"(fq));
        const int b = u.pn >> 3, s0 = (u.pn & 7) * 256 + wc * 32 + 8 * fq;
        float rs[2][8];
        FOR_BJ {
#pragma unroll
            for (int k = 0; k < 8; ++k) { rs[bj][k] = 1.f; if (ssq) { const f32x4 q = *(const f32x4*)(ssq + (size_t)(b * SEQ + s0 + bj * 128 + k) * 4); rs[bj][k] = 1.0f / sqrtf(((q[0] + q[1]) + (q[2] + q[3])) * inv_n + EPS); } } }
        FOR_AI_M { const int R = u.pm * 256 + ai * 128 + wr * 64 + m * 16 + fr;
            bf16* rowp = (R < 1024 ? T0 + (size_t)(b * 1024 + R) * SEQ : T1 + (size_t)(b * 1024 + R - 1024) * SEQ) + s0;
            FOR_BJ { f32x4 v0 = acc[ai][bj][m][0], v1 = acc[ai][bj][m][1];
#pragma unroll
                for (int i = 0; i < 4; ++i) { v0[i] *= rs[bj][i]; v1[i] *= rs[bj][4 + i]; }
                *(u32x4*)(rowp + bj * 128) = pack8(v0, v1); } }
    }
};
struct EpiUq {
    static constexpr bool PERM = true, AFTER_DRAIN = false;
    bf16 *QMn, *QMp; const float *ssq, *mcos, *msin; int wv;
    DI void operator()(EPI_ARGS) const {
        { const int t_ = tidx(wv); fr = t_ & 15; fq = (t_ >> 4) & 3; }
        const int pn = u.pn, row0 = u.pm * 256 + wr * 64 + fr, c8 = wc * 32 + 8 * fq;
        FOR_AI_M { const int t = row0 + ai * 128 + m * 16, s = t & (SEQ - 1);
            const f32x4 q = *(const f32x4*)(ssq + (size_t)t * 4); const float rs = QSC_MLA / sqrtf(((q[0] + q[1]) + (q[2] + q[3])) * (1.f / 256.f) + EPS);
            if (pn < 4) { FOR_BJ { *(u32x4*)(QMn + (size_t)t * 1024 + pn * 256 + bj * 128 + c8) = pack8(acc[ai][bj][m][0] * rs, acc[ai][bj][m][1] * rs); } }
            else { const f32x4 c = *(const f32x4*)(mcos + s * 16 + 4 * fq), sn = *(const f32x4*)(msin + s * 16 + 4 * fq);
                FOR_BJ { const int hh = (pn - 4) * 8 + bj * 4 + wc; const f32x4 x1 = acc[ai][bj][m][0] * rs, x2 = acc[ai][bj][m][1] * rs;
                    const f32x4 o1 = x1 * c - x2 * sn, o2 = x2 * c + x1 * sn; u32x2 w1, w2; w1.x = cvtpk(o1[0], o1[1]); w1.y = cvtpk(o1[2], o1[3]); w2.x = cvtpk(o2[0], o2[1]); w2.y = cvtpk(o2[2], o2[3]);
                    *(u32x2*)(QMp + (size_t)t * 512 + hh * 32 + 4 * fq) = w1; *(u32x2*)(QMp + (size_t)t * 512 + hh * 32 + 16 + 4 * fq) = w2; } }
            asm volatile("" ::: "memory");
        }
    }
};
struct EpiUk {
    static constexpr bool PERM = true, AFTER_DRAIN = false;
    bf16* KMn; const float* ssq;
    DI void operator()(EPI_ARGS) const {
        asm volatile("" : "+v"(fr), "+v"(fq));
        const int row0 = u.pm * 256 + wr * 64 + fr, c8 = wc * 32 + 8 * fq;
        FOR_AI_M { const int t = row0 + ai * 128 + m * 16;
            const f32x4 q = *(const f32x4*)(ssq + (size_t)t * 4); const float rs = 1.0f / sqrtf(((q[0] + q[1]) + (q[2] + q[3])) * (1.f / 128.f) + EPS);
            FOR_BJ { *(u32x4*)(KMn + (size_t)t * 1024 + u.pn * 256 + bj * 128 + c8) = pack8(acc[ai][bj][m][0] * rs, acc[ai][bj][m][1] * rs); } }
    }
};
template <int ACT  > struct EpiAct {
    static constexpr bool PERM = true, AFTER_DRAIN = false;
    bf16* O; int ldc;
    DI void operator()(EPI_ARGS) const {
        asm volatile("" : "+v"(fr), "+v"(fq));
        const int row0 = u.pm * 256 + wr * 64 + fr, c8 = u.pn * 256 + wc * 32 + 8 * fq;
        FOR_AI_M { const int t = row0 + ai * 128 + m * 16;
            FOR_BJ { f32x4 v0 = acc[ai][bj][m][0], v1 = acc[ai][bj][m][1];
#pragma unroll
                for (int i = 0; i < 4; ++i) { if (ACT == 0) { v0[i] = sigm(v0[i]); v1[i] = sigm(v1[i]); } else { const float a = fmaxf(v0[i], 0.f), b = fmaxf(v1[i], 0.f); v0[i] = a * a; v1[i] = b * b; } }
                *(u32x4*)(O + (size_t)t * ldc + c8 + bj * 128) = pack8(v0, v1); } }
    }
};
template <int I> struct EpiBranch {
    static constexpr bool PERM = true, AFTER_DRAIN = false;
    const bf16* G; float* M32; bf16* MG;
    DI void operator()(EPI_ARGS) const {
        asm volatile("" : "+v"(fr), "+v"(fq));
        const int row0 = u.pm * 256 + wr * 64 + fr, c8 = u.pn * 256 + wc * 32 + 8 * fq;
        FOR_AI_M { const int t = row0 + ai * 128 + m * 16;
            FOR_BJ { const size_t idx = (size_t)t * 1024 + c8 + bj * 128; f32x4 g0, g1; unpack8(*(const u32x4*)(G + idx), g0, g1);
                f32x4 v0 = acc[ai][bj][m][0] * g0, v1 = acc[ai][bj][m][1] * g1;
#ifdef ABL_BRANCH
                if (I == ABL_BRANCH) { v0 = v0 * 0.f; v1 = v1 * 0.f; }
#endif
                if (I > 0) { v0 = v0 + *(const f32x4*)(M32 + idx); v1 = v1 + *(const f32x4*)(M32 + idx + 4); }
                if (I < 2) { *(f32x4*)(M32 + idx) = v0; *(f32x4*)(M32 + idx + 4) = v1; } else *(u32x4*)(MG + idx) = pack8(v0, v1); } }
    }
};
struct EpiY {
    static constexpr bool PERM = true, AFTER_DRAIN = false;
    bf16* Y; float* SSQ;
    DI void operator()(EPI_ARGS) const {
        asm volatile("" : "+v"(fr), "+v"(fq));
        const int row0 = u.pm * 256 + wr * 64 + fr, c8 = u.pn * 256 + wc * 32 + 8 * fq;
        FOR_AI_M { const int t = row0 + ai * 128 + m * 16; float ss = 0.f;
            FOR_BJ { const f32x4 v0 = acc[ai][bj][m][0], v1 = acc[ai][bj][m][1]; ss += sq4(v0) + sq4(v1); *(u32x4*)(Y + (size_t)t * 1024 + c8 + bj * 128) = pack8(v0, v1); }
            ss += shx(ss, 16, fq * 16 + fr); ss += shx(ss, 32, fq * 16 + fr);
            if (fq == 0) SSQ[(size_t)t * 16 + u.pn * 4 + wc] = ss; }
    }
};

template <int MODE> struct AC;
template <> struct AC<0> { static constexpr int DQK = 128, KW = 128, DVW = 128, VTR = 256, QR = 128; };
template <> struct AC<1> { static constexpr int DQK = 64, KW = 128, DVW = 128, VTR = 128, QR = 128; };
template <> struct AC<2> { static constexpr int DQK = 96, KW = 96, DVW = 64, VTR = 64, QR = 256; };
constexpr int A_KBUF = 17408, A_VBUF = 36864, A_V0 = 2 * A_KBUF, A_MISC = 2 * A_KBUF + 2 * A_VBUF;
constexpr int A_LUT = A_MISC + 64, A_XCH = A_MISC + 1024;
static_assert(A_XCH + 2048 <= LDS_BYTES, "attention LDS map");
struct AttnP { unsigned char* ws; const float* subg; float lam, oml; };
struct AttnPtrs { const bf16 *RQ, *RK, *RVt, *RG; bf16* RO; bf16* DQ; const bf16 *DK, *DVt; bf16* QMn; const bf16 *QMp, *KMn, *KPE, *VMt; const float *biasl, *subg; float lam, oml; };

template <int MODE> DI void attn_unit(lptr lds, const AttnP PP, const int b, const int hd, const int qb, const int wv) {
    using C = AC<MODE>;
    unsigned char* const ws = PP.ws;
    const AttnPtrs P{(const bf16*)(ws + WS_RQ), (const bf16*)(ws + WS_RK), (const bf16*)(ws + WS_RVT), (const bf16*)(ws + WS_RG), (bf16*)(ws + WS_RO), (bf16*)(ws + WS_DQ),
                     (const bf16*)(ws + WS_DK), (const bf16*)(ws + WS_DVT), (bf16*)(ws + WS_QMN), (const bf16*)(ws + WS_QMP), (const bf16*)(ws + WS_KMN), (const bf16*)(ws + WS_KPE),
                     (const bf16*)(ws + WS_VMT), (const float*)(ws + WS_BIAS), PP.subg, PP.lam, PP.oml};
    constexpr int NKS = C::DQK / 16, NVB = C::DVW / 32, KS = (C::KW + 8) * 2, VS = 144, KCH = C::KW / 8, NKC = 64 * KCH, NVR = C::VTR / 64;
    const int tid = tidx(wv), w = __builtin_amdgcn_readfirstlane(tid >> 6), lane = tid & 63, r = lane & 31, h = lane >> 5;
    const int rg = MODE == 2 ? w : (w >> 1), pp = MODE == 2 ? 0 : (w & 1);
    const int q0 = qb * C::QR, q0w = q0 + rg * 32, tok0 = b * SEQ, qq = q0w + r;
    const int ntiles = (q0 + C::QR) / 64;
    const bf16* Kg; const bf16* Vg;
    if (MODE == 0) { Kg = P.RK + (size_t)tok0 * 512 + hd * 128; Vg = P.RVt + (size_t)(b * 4 + hd) * 256 * SEQ; }
    else if (MODE == 1) { Kg = P.DK + (size_t)tok0 * 1024 + hd * 128; Vg = P.DVt + (size_t)(b * 8 + hd) * 128 * SEQ; }
    else { Kg = P.KMn + (size_t)tok0 * 1024 + hd * 64; Vg = P.VMt + (size_t)(b * 16 + hd) * 64 * SEQ; }
    const bf16* Kpe = P.KPE + (size_t)tok0 * 32;
    bf16x8 q[NKS];
    { const size_t t = (size_t)(tok0 + qq);
#pragma unroll
        for (int ks = 0; ks < NKS; ++ks) {
            const bf16* src;
            if (MODE == 0) src = P.RQ + t * 512 + hd * 128 + ks * 16 + 8 * h;
            else if (MODE == 1) src = P.DQ + t * 1024 + hd * 128 + pp * 64 + ks * 16 + 8 * h;
            else src = ks < 4 ? P.QMn + t * 1024 + hd * 64 + ks * 16 + 8 * h : P.QMp + t * 512 + hd * 32 + (ks - 4) * 16 + 8 * h;
            q[ks] = *(const bf16x8*)src; } }
    if (MODE == 1) { if (tid < 128) ((LAS float*)(lds + A_LUT))[tid] = P.biasl[hd * 128 + tid]; }
    u32x4 kreg[2], vreg[NVR];
#define A_GLOAD(kt) do { \
    _Pragma("unroll") for (int i_ = 0; i_ < 2; ++i_) { const int id_ = tid + 512 * i_; if (id_ < NKC) { const int row_ = id_ / KCH, cc_ = id_ % KCH; const size_t kr_ = (size_t)((kt) * 64 + row_); \
        const bf16* s_; if (MODE == 2) s_ = cc_ < 8 ? Kg + kr_ * 1024 + cc_ * 8 : Kpe + kr_ * 32 + (cc_ - 8) * 8; else s_ = Kg + kr_ * (MODE == 0 ? 512 : 1024) + cc_ * 8; kreg[i_] = *(const u32x4*)s_; } } \
    _Pragma("unroll") for (int i_ = 0; i_ < NVR; ++i_) { const int id_ = tid + 512 * i_, row_ = id_ >> 3, cc_ = id_ & 7; vreg[i_] = *(const u32x4*)(Vg + (size_t)row_ * SEQ + (kt) * 64 + cc_ * 8); } } while (0)
#define A_LWRITE(buf) do { \
    _Pragma("unroll") for (int i_ = 0; i_ < 2; ++i_) { const int id_ = tid + 512 * i_; if (id_ < NKC) { const int row_ = id_ / KCH, cc_ = id_ % KCH; *(LAS u32x4*)(lds + (buf) * A_KBUF + row_ * KS + cc_ * 16) = kreg[i_]; } } \
    _Pragma("unroll") for (int i_ = 0; i_ < NVR; ++i_) { const int id_ = tid + 512 * i_, row_ = id_ >> 3, cc_ = id_ & 7; *(LAS u32x4*)(lds + A_V0 + (buf) * A_VBUF + row_ * VS + cc_ * 16) = vreg[i_]; } } while (0)
    f32x16 O[NVB];
#pragma unroll
    for (int vb = 0; vb < NVB; ++vb)
#pragma unroll
        for (int i = 0; i < 16; ++i) O[vb][i] = 0.f;
    float mrun = -INFINITY, lrun = 0.f;
    const float l2g = MODE == 0 ? log2f(1.f - ex2(-5.f - (float)hd)) : 0.f;
    const float b31 = MODE == 1 ? P.biasl[hd * 128 + 127] : 0.f;
    const int pir = (r & 0x13) | ((r & 8) >> 1) | ((r & 4) << 1);
    const int koffb = ((MODE == 1 ? pp * 64 : 0) + 8 * h) * 2;
    const int vrow0 = (MODE == 0 ? pp * 128 : 0) + r;
    A_GLOAD(0); A_LWRITE(0);
    __syncthreads();
    for (int kt = 0; kt < ntiles; ++kt) {
        const int cur = kt & 1;
        if (kt + 1 < ntiles) A_GLOAD(kt + 1);
        if (kt * 64 <= q0w + 31) {
            const lptr Kb = lds + cur * A_KBUF + koffb, Vb = lds + A_V0 + cur * A_VBUF + (8 * h) * 2;
            f32x16 S0, S1;
#pragma unroll
            for (int i = 0; i < 16; ++i) { S0[i] = 0.f; S1[i] = 0.f; }
#pragma unroll
            for (int ks = 0; ks < NKS; ++ks) {
                const bf16x8 a0 = *(const LAS bf16x8*)(Kb + pir * KS + ks * 32), a1 = *(const LAS bf16x8*)(Kb + (32 + pir) * KS + ks * 32);
                S0 = __builtin_amdgcn_mfma_f32_32x32x16_bf16(a0, q[ks], S0, 0, 0, 0);
                S1 = __builtin_amdgcn_mfma_f32_32x32x16_bf16(a1, q[ks], S1, 0, 0, 0);
            }
            const int kb0 = kt * 64 + 8 * h;
            const bool diag = (kt * 64 + 63 > q0w);
            if (MODE == 0) {
#pragma unroll
                for (int i = 0; i < 16; ++i) { const int k0 = kb0 + 16 * (i >> 3) + (i & 7); const int d0 = qq - k0, d1 = d0 - 32;
                    const float e0 = ex2(l2g * (float)d0), e1 = ex2(l2g * (float)d1);
                    S0[i] = (d0 >= 0) ? S0[i] * e0 : 0.f; S1[i] = (d1 >= 0) ? S1[i] * e1 : 0.f; }
            } else {
                if (MODE == 1) {
                    if (q0w - (kt * 64 + 63) >= 113) {
#pragma unroll
                        for (int i = 0; i < 16; ++i) { S0[i] += b31; S1[i] += b31; }
                    } else {
                        const LAS float* lut = (const LAS float*)(lds + A_LUT);
#pragma unroll
                        for (int i = 0; i < 16; ++i) { const int k0 = kb0 + 16 * (i >> 3) + (i & 7); int d0 = qq - k0, d1 = d0 - 32;
                            d0 = d0 < 0 ? 0 : (d0 > 127 ? 127 : d0); d1 = d1 < 0 ? 0 : (d1 > 127 ? 127 : d1); S0[i] += lut[d0]; S1[i] += lut[d1]; }
                    }
                }
                if (diag) {
#pragma unroll
                    for (int i = 0; i < 16; ++i) { const int k0 = kb0 + 16 * (i >> 3) + (i & 7); if (k0 > qq) S0[i] = -INFINITY; if (k0 + 32 > qq) S1[i] = -INFINITY; }
                }
                float mx = fmaxf(S0[0], S1[0]);
#pragma unroll
                for (int i = 1; i < 16; ++i) mx = fmaxf(mx, fmaxf(S0[i], S1[i]));
                mx = fmaxf(mx, shx(mx, 32, lane));
                const float mn = fmaxf(mrun, mx), al = ex2(mrun - mn); mrun = mn;
                float ps = 0.f;
#pragma unroll
                for (int i = 0; i < 16; ++i) { S0[i] = ex2(S0[i] - mn); S1[i] = ex2(S1[i] - mn); ps += S0[i] + S1[i]; }
                lrun = lrun * al + ps;
#pragma unroll
                for (int vb = 0; vb < NVB; ++vb)
#pragma unroll
                    for (int i = 0; i < 16; ++i) O[vb][i] *= al;
            }
            bf16x8 pf[2][2];
#pragma unroll
            for (int s = 0; s < 2; ++s) {
                u32x4 t0, t1;
                t0.x = cvtpk(S0[8 * s + 0], S0[8 * s + 1]); t0.y = cvtpk(S0[8 * s + 2], S0[8 * s + 3]); t0.z = cvtpk(S0[8 * s + 4], S0[8 * s + 5]); t0.w = cvtpk(S0[8 * s + 6], S0[8 * s + 7]);
                t1.x = cvtpk(S1[8 * s + 0], S1[8 * s + 1]); t1.y = cvtpk(S1[8 * s + 2], S1[8 * s + 3]); t1.z = cvtpk(S1[8 * s + 4], S1[8 * s + 5]); t1.w = cvtpk(S1[8 * s + 6], S1[8 * s + 7]);
                pf[0][s] = __builtin_bit_cast(bf16x8, t0); pf[1][s] = __builtin_bit_cast(bf16x8, t1);
            }
#pragma unroll
            for (int vb = 0; vb < NVB; ++vb)
#pragma unroll
                for (int kb = 0; kb < 2; ++kb)
#pragma unroll
                    for (int s = 0; s < 2; ++s) {
                        const bf16x8 a = *(const LAS bf16x8*)(Vb + (vrow0 + vb * 32) * VS + (kb * 32 + 16 * s) * 2);
                        O[vb] = __builtin_amdgcn_mfma_f32_32x32x16_bf16(a, pf[kb][s], O[vb], 0, 0, 0);
                    }
        }
        if (kt + 1 < ntiles) A_LWRITE(cur ^ 1);
        __syncthreads();
    }
#undef A_GLOAD
#undef A_LWRITE
    const size_t trow = (size_t)(tok0 + qq);
    if (MODE == 0) {
        float ss = 0.f;
#pragma unroll
        for (int vb = 0; vb < NVB; ++vb)
#pragma unroll
            for (int i = 0; i < 16; ++i) ss += O[vb][i] * O[vb][i];
        ss += shx(ss, 32, lane);
        LAS float* xch = (LAS float*)(lds + A_XCH);
        if (h == 0) xch[w * 32 + r] = ss;
        __syncthreads();
        const float tot = ss + xch[(w ^ 1) * 32 + r];
        const float rs = 1.0f / sqrtf(tot * (1.f / 256.f) + EPS);
#pragma unroll
        for (int vb = 0; vb < NVB; ++vb)
#pragma unroll
            for (int g = 0; g < 4; ++g) { const size_t idx = trow * 1024 + hd * 256 + pp * 128 + vb * 32 + 8 * g + 4 * h; const u32x2 gw = *(const u32x2*)(P.RG + idx);
                u32x2 o; o.x = cvtpk(O[vb][4 * g] * rs * bflo(gw.x), O[vb][4 * g + 1] * rs * bfhi(gw.x)); o.y = cvtpk(O[vb][4 * g + 2] * rs * bflo(gw.y), O[vb][4 * g + 3] * rs * bfhi(gw.y));
                *(u32x2*)(P.RO + idx) = o; }
    } else if (MODE == 1) {
        const float lt = lrun + shx(lrun, 32, lane), il = 1.0f / lt;
        LAS float* X = (LAS float*)lds + (size_t)rg * 64 * 64;
        if (pp == 1) {
#pragma unroll
            for (int vb = 0; vb < NVB; ++vb)
#pragma unroll
                for (int i = 0; i < 16; ++i) X[(vb * 16 + i) * 64 + lane] = O[vb][i] * il;
        }
        __syncthreads();
        if (pp == 0) {
            float ss = 0.f;
#pragma unroll
            for (int vb = 0; vb < NVB; ++vb)
#pragma unroll
                for (int i = 0; i < 16; ++i) { const float v = O[vb][i] * il - P.lam * X[(vb * 16 + i) * 64 + lane]; O[vb][i] = v; ss += v * v; }
            ss += shx(ss, 32, lane);
            const float rs = P.oml / sqrtf(ss * (1.f / 128.f) + EPS);
#pragma unroll
            for (int vb = 0; vb < NVB; ++vb)
#pragma unroll
                for (int g = 0; g < 4; ++g) { const int dv = vb * 32 + 8 * g + 4 * h; const f32x4 gg = *(const f32x4*)(P.subg + dv);
                    u32x2 o; o.x = cvtpk(O[vb][4 * g] * rs * gg[0], O[vb][4 * g + 1] * rs * gg[1]); o.y = cvtpk(O[vb][4 * g + 2] * rs * gg[2], O[vb][4 * g + 3] * rs * gg[3]);
                    *(u32x2*)(P.DQ + trow * 1024 + hd * 128 + dv) = o; }
        }
    } else {
        const float lt = lrun + shx(lrun, 32, lane), il = 1.0f / lt;
#pragma unroll
        for (int vb = 0; vb < NVB; ++vb)
#pragma unroll
            for (int g = 0; g < 4; ++g) { u32x2 o; o.x = cvtpk(O[vb][4 * g] * il, O[vb][4 * g + 1] * il); o.y = cvtpk(O[vb][4 * g + 2] * il, O[vb][4 * g + 3] * il);
                *(u32x2*)(P.QMn + trow * 1024 + hd * 64 + vb * 32 + 8 * g + 4 * h) = o; }
    }
}
DI void attn_phase(lptr lds, const AttnP P, unsigned* counter, const int wv) {
    for (;;) {
        __syncthreads();
        if (tidx(wv) == 0) *(LAS int*)(lds + A_MISC) = (int)atomicAdd(counter, 1u);
        __syncthreads();
        const int idx = __builtin_amdgcn_readfirstlane(*(LAS int*)(lds + A_MISC));
        if (idx >= 2560) break;
        const int pr = 7 - idx / 320, rem = idx % 320;
        if (rem < 128) attn_unit<2>(lds, P, rem >> 4, rem & 15, pr, wv);
        else if (rem < 160) { const int e = rem - 128; attn_unit<0>(lds, P, e >> 2, e & 3, 2 * pr + 1, wv); }
        else if (rem < 224) { const int e = rem - 160; attn_unit<1>(lds, P, e >> 3, e & 7, 2 * pr + 1, wv); }
        else if (rem < 256) { const int e = rem - 224; attn_unit<0>(lds, P, e >> 2, e & 3, 2 * pr, wv); }
        else { const int e = rem - 256; attn_unit<1>(lds, P, e >> 3, e & 7, 2 * pr, wv); }
    }
}


constexpr size_t WS_BAR = 131072;
#define XB_TMO      128
#define XB_XCNT(j)  (256  + 64 * (j))
#define XB_XSUB(j)  (1280 + 64 * (j))
#define XB_XGEN(j)  (2304 + 64 * (j))
#define XB_TOP      3328
#define XB_TOPGEN   3392
#define XCD_BAR_WORDS 3456
#define XB_SPIN_CAP (1u << 18)
constexpr int LDS_XB = 143360;
DI unsigned xb_ld(unsigned* p)              { return __hip_atomic_load(p, __ATOMIC_RELAXED, __HIP_MEMORY_SCOPE_AGENT); }
DI unsigned xb_add(unsigned* p, unsigned v) { return __hip_atomic_fetch_add(p, v, __ATOMIC_RELAXED, __HIP_MEMORY_SCOPE_AGENT); }
DI unsigned xb_xcc_id() { return (unsigned)__builtin_amdgcn_s_getreg((3 << 11) | 20) & 0xFu; }
#define XB_SPIN(cond, bar) do { unsigned _sp = 0; while (cond) { __builtin_amdgcn_s_sleep(1); \
    if ((++_sp & 255u) == 0u) { if (xb_ld(&(bar)[XB_TMO])) break; if (_sp > XB_SPIN_CAP) { atomicAdd(&(bar)[XB_TMO], 1u); break; } } } } while (0)
DI void xcd_barrier_complete(unsigned* bar, unsigned x, unsigned& nloc, unsigned& nx) {
    const unsigned G = gridDim.x;
    unsigned sum, cnt, mine, sp = 0u;
    for (;;) {
        sum = 0u; cnt = 0u; mine = 0u;
#pragma unroll
        for (unsigned j = 0; j < 16; ++j) { const unsigned c = xb_ld(&bar[XB_XCNT(j)]); sum += c; cnt += (c > 0u) ? 1u : 0u; mine = (j == x) ? c : mine; }
        if (sum == G) break;
        __builtin_amdgcn_s_sleep(1);
        if ((++sp & 255u) == 0u) { if (xb_ld(&bar[XB_TMO])) break; if (sp > XB_SPIN_CAP) { atomicAdd(&bar[XB_TMO], 1u); break; } }
    }
    nloc = mine > 0u ? mine : 1u; nx = cnt > 0u ? cnt : 1u;
}
DI void xcd_barrier(unsigned* bar, lptr lds, const int wv) {
    asm volatile("s_waitcnt vmcnt(0)" ::: "memory");
    __syncthreads();
    if (tidx(wv) == 0) {
        volatile LAS unsigned* st = (volatile LAS unsigned*)(lds + LDS_XB);
        const unsigned x = xb_xcc_id();
        __builtin_amdgcn_s_waitcnt(0);
        unsigned nloc = st[0], nx = st[1];
        if (nloc == 0u) { xcd_barrier_complete(bar, x, nloc, nx); st[0] = nloc; st[1] = nx; }
        const unsigned old = xb_add(&bar[XB_XSUB(x)], 1u);
        const unsigned gen = old / nloc;
        if (old + 1u == (gen + 1u) * nloc) {
            __builtin_amdgcn_fence(__ATOMIC_RELEASE, "agent");
            asm volatile("s_waitcnt vmcnt(0)" ::: "memory");
            const unsigned og = xb_add(&bar[XB_TOP], 1u);
            const unsigned tg = og / nx;
            if (og + 1u == (tg + 1u) * nx) xb_add(&bar[XB_TOPGEN], 1u);
            else XB_SPIN(xb_ld(&bar[XB_TOPGEN]) == tg, bar);
            __builtin_amdgcn_fence(__ATOMIC_ACQUIRE, "agent");
            xb_add(&bar[XB_XGEN(x)], 1u);
            asm volatile("s_waitcnt vmcnt(0)" ::: "memory");
        } else {
            XB_SPIN(xb_ld(&bar[XB_XGEN(x)]) == gen, bar);
            __builtin_amdgcn_fence(__ATOMIC_ACQUIRE, "agent");
            asm volatile("s_waitcnt vmcnt(0)" ::: "memory");
        }
    }
    __syncthreads();
}
constexpr int N_PHASES = 39;
template <class Epi> DI void run_gemm(lptr lds, int wv, const bf16* A, const bf16* Bt, int M, int N, int K, const Epi& E) {
#ifdef DIS_GEMM
    return;
#endif
    int bx_ = (int)blockIdx.x; asm volatile("" : "+s"(bx_));
    pg8::Gemm g{A, Bt, M, N, K}; pg8::StaticOrder S; S.init(M, N, (int)gridDim.x, bx_); S.wv = wv;
    pg8::gemm_phase<Epi, pg8::StaticOrder, true, true>(lds, g, S, E);
}
__global__ void __launch_bounds__(NTHR) mega_fwd(Params p) {
    extern __shared__ __attribute__((aligned(16))) unsigned char lds_raw[];
    lptr lds = (lptr)lds_raw;
#if !MK_MULTI
    cg::grid_group grid = cg::this_grid();
#endif
    const int wv = __builtin_amdgcn_readfirstlane((int)threadIdx.x >> 6);
#if !MK_MULTI
    if (threadIdx.x == 0) { ((volatile LAS unsigned*)(lds + LDS_XB))[0] = 0u; ((volatile LAS unsigned*)(lds + LDS_XB))[1] = 0u; (void)xb_add((unsigned*)(p.ws + WS_BAR) + XB_XCNT(xb_xcc_id()), 1u); }
    __syncthreads();
#endif
    int ph = p.ph_lo; const int ph_hi = p.ph_hi;
    if (ph == 0) {
#ifndef DIS_PRO
        prologue(p, lds, wv);
#endif
        ++ph;
#if !MK_MULTI
        if (ph < ph_hi) grid.sync();
#endif
    }
    const float* xin0 = p.x; float* const outp = p.out; unsigned char* ws0 = p.ws;
    for (; ph < ph_hi; ++ph) {
        unsigned char* ws = ws0;
        asm volatile("" : "+s"(ws));
        const float* gains = (const float*)(ws + WS_GAIN);
        bf16* H = (bf16*)(ws + WS_H);
        const int hb = (ph - 1) / 19, k19 = (ph - 1) % 19;
        const size_t xoff = (size_t)hb * TH * DM;
        if (k19 == 0) norm_rows(xin0 + xoff, gains, H, TH, wv);
        else {
            const int l = (k19 - 1) / 9, k = (k19 - 1) % 9;
            const bf16* Wb = (const bf16*)(ws + WS_W) + (size_t)l * WO_END;
            if (k == 0) {
                EpiIn1 E1{ws};
                run_gemm(lds, wv, H, Wb + WO_IN1, TH, 4608, 1024, E1);
                EpiVt E2{(bf16*)(ws + WS_RVT), (bf16*)(ws + WS_DVT), nullptr, 0.f};
                run_gemm(lds, wv, Wb + WO_V, H, 2048, TH, 1024, E2);
            } else if (k == 1) {
                EpiUq Eq{(bf16*)(ws + WS_QMN), (bf16*)(ws + WS_QMP), (const float*)(ws + WS_SSQ_CQ), (const float*)(ws + WS_MCOS), (const float*)(ws + WS_MSIN), wv};
                run_gemm(lds, wv, (const bf16*)(ws + WS_CQ), Wb + WO_UQ, TH, 1536, 256, Eq);
                EpiUk Ek{(bf16*)(ws + WS_KMN), (const float*)(ws + WS_SSQ_CKV)};
                run_gemm(lds, wv, (const bf16*)(ws + WS_CKV), Wb + WO_UK, TH, 1024, 256, Ek);
                EpiVt Ev{(bf16*)(ws + WS_VMT), (bf16*)(ws + WS_VMT), (const float*)(ws + WS_SSQ_CKV), 1.f / 128.f};
                run_gemm(lds, wv, Wb + WO_UV, (const bf16*)(ws + WS_CKV), 1024, TH, 256, Ev);
            } else if (k == 2) {
#ifndef DIS_ATTN
                AttnP P{ws, (const float*)(ws + WS_SUBG) + l * 128, ((const float*)(ws + WS_LAM))[l], 0.6f * expf(-0.3f * (float)l) + 0.2f};
                attn_phase(lds, P, (unsigned*)(ws + WS_CNT) + hb * 2 + l, wv);
#endif
            } else if (k == 3) {
                bf16* G = (bf16*)(ws + WS_G); float* M32 = (float*)(ws + WS_M32); bf16* MG = (bf16*)(ws + WS_MG);
                const size_t GS = (size_t)TH * 1024;
                run_gemm(lds, wv, H, Wb + WO_G, TH, 1024, 1024, EpiAct<0>{G, 1024});
                run_gemm(lds, wv, (const bf16*)(ws + WS_RO), Wb + WO_RO, TH, 1024, 1024, EpiBranch<0>{G, M32, MG});
                run_gemm(lds, wv, H, Wb + WO_G + (size_t)1024 * 1024, TH, 1024, 1024, EpiAct<0>{G + GS, 1024});
                run_gemm(lds, wv, (const bf16*)(ws + WS_DQ), Wb + WO_DO, TH, 1024, 1024, EpiBranch<1>{G + GS, M32, MG});
                run_gemm(lds, wv, H, Wb + WO_G + (size_t)2048 * 1024, TH, 1024, 1024, EpiAct<0>{G + 2 * GS, 1024});
                run_gemm(lds, wv, (const bf16*)(ws + WS_QMN), Wb + WO_MO, TH, 1024, 1024, EpiBranch<2>{G + 2 * GS, M32, MG});
            } else if (k == 4) {
                run_gemm(lds, wv, (const bf16*)(ws + WS_MG), Wb + WO_OUT, TH, 1024, 1024, EpiY{(bf16*)(ws + WS_Y), (float*)(ws + WS_SSQ_Y)});
            } else if (k == 5) {
                resid_rows((l == 0 ? xin0 : (const float*)outp) + xoff, (const bf16*)(ws + WS_Y), (const float*)(ws + WS_SSQ_Y), gains + 2048 + l * DM, outp + xoff, gains + 4096 + l * DM, H, TH, wv);
            } else if (k == 6) {
                run_gemm(lds, wv, H, Wb + WO_UP, TH, DFF, 1024, EpiAct<1>{(bf16*)(ws + WS_U), DFF});
            } else if (k == 7) {
                run_gemm(lds, wv, (const bf16*)(ws + WS_U), Wb + WO_DOWN, TH, 1024, DFF, EpiY{(bf16*)(ws + WS_Y), (float*)(ws + WS_SSQ_Y)});
            } else {
                resid_rows(outp + xoff, (const bf16*)(ws + WS_Y), (const float*)(ws + WS_SSQ_Y), gains + 6144 + l * DM, outp + xoff, l == 0 ? gains + DM : nullptr, H, TH, wv, true);
            }
        }
#if !MK_MULTI
        if (ph + 1 < ph_hi) xcd_barrier((unsigned*)(ws + WS_BAR), lds, wv);
#endif
    }
}

extern "C" void kernel_launch(void* const* d_in, const int* in_sizes, int n_in, void* d_out, int out_size, void* d_ws, size_t ws_size, hipStream_t stream) {
    static int grid = 0;
    if (grid == 0) {
        if (n_in != 22 || ws_size < WS_END) { fprintf(stderr, "kernel_launch: unexpected inputs (n_in %d, ws %zu)\n", n_in, ws_size); grid = -1; return; }
        int dev = 0, cus = 0, per_cu = 0;
        hipGetDevice(&dev); hipDeviceGetAttribute(&cus, hipDeviceAttributeMultiprocessorCount, dev);
        if (hipFuncSetAttribute((const void*)mega_fwd, hipFuncAttributeMaxDynamicSharedMemorySize, LDS_BYTES) != hipSuccess) { fprintf(stderr, "kernel_launch: hipFuncSetAttribute failed\n"); grid = -1; return; }
        if (hipOccupancyMaxActiveBlocksPerMultiprocessor(&per_cu, (const void*)mega_fwd, NTHR, LDS_BYTES) != hipSuccess || per_cu < 1) { fprintf(stderr, "kernel_launch: occupancy query gave %d\n", per_cu); per_cu = 1; }
        (void)hipGetLastError();
        grid = cus * per_cu;
        if (grid > 256) grid = 256;
    }
    if (grid < 0) return;
    Params p{};
    const float** pf = (const float**)&p;
    for (int i = 0; i < 22; ++i) pf[i] = (const float*)d_in[i];
    p.out = (float*)d_out; p.ws = (unsigned char*)d_ws;
#if MK_MULTI
#ifdef MK_CHECK
    hipLaunchKernelGGL(chk_clear, dim3(1), dim3(128), 0, stream, (unsigned char*)d_ws);
#endif
    for (int ph = 0; ph < N_PHASES; ++ph) { p.ph_lo = ph; p.ph_hi = ph + 1; hipLaunchKernelGGL(mega_fwd, dim3(grid), dim3(NTHR), LDS_BYTES, stream, p);
#ifdef MK_CHECK
        if (ph >= 1) hipLaunchKernelGGL(chk, dim3(256), dim3(256), 0, stream, p, ph);
#endif
    }
#ifdef MK_CHECK
    hipLaunchKernelGGL(chk_report, dim3(1), dim3(64), 0, stream, (unsigned char*)d_ws, (float*)d_out);
#endif
#else
    p.ph_lo = 0; p.ph_hi = N_PHASES;
    if (hipMemsetAsync((char*)d_ws + WS_BAR, 0, XCD_BAR_WORDS * 4, stream) != hipSuccess) { fprintf(stderr, "kernel_launch: memset of the barrier words failed\n"); return; }
    void* args[] = {&p};
    hipError_t e = hipLaunchCooperativeKernel((const void*)mega_fwd, dim3(grid), dim3(NTHR), args, LDS_BYTES, stream);
    if (e != hipSuccess) fprintf(stderr, "cooperative launch failed: %s (grid %d)\n", hipGetErrorString(e), grid);
#endif
}
```

```cpp
#include <hip/hip_runtime.h>
#include <hip/hip_cooperative_groups.h>
#include <cstdio>
#include <cstdint>
namespace cg = cooperative_groups;
__device__ __forceinline__ int tidx(int wv) { int l; asm volatile("v_mbcnt_lo_u32_b32 %0, -1, 0\n\tv_mbcnt_hi_u32_b32 %0, -1, %0" : "=v"(l)); return (wv << 6) | l; }
namespace pg8 {
#define PG8_LAS __attribute__((address_space(3)))
typedef unsigned short bf16_t;
typedef short bf16x8 __attribute__((ext_vector_type(8)));
typedef float f32x4 __attribute__((ext_vector_type(4)));
typedef unsigned u32x4 __attribute__((ext_vector_type(4)));
constexpr int BM = 256, BK = 64, HALF = 128, HTB = HALF * BK * 2  , STAGE_BYTES = 8 * HTB, NXCD = 8, WGM = 8;

__host__ __device__ __forceinline__ int lds_byte(int r, int c) { const int st = (r >> 4) * 2 + (c >> 5), rr = r & 15, cc = c & 31, ob = rr * 64 + cc * 2; return st * 1024 + (ob ^ (((ob >> 9) & 1) << 5)); }
__host__ __device__ __forceinline__ void stage_rc(int b, int& R, int& C) { const int st = b / 1024, sb = b % 1024, swz = sb ^ (((sb >> 9) & 1) << 5); R = (st >> 1) * 16 + swz / 64; C = (st & 1) * 32 + (swz % 64) / 2; }
__host__ __device__ __forceinline__ int perm32(int rho) { const int n = rho >> 4, i = rho & 15; return 8 * (i >> 2) + 4 * n + (i & 3); }

struct Unit { int pm, pn; };
struct Gemm { const bf16_t* A; const bf16_t* Bt; int M, N, K; };

struct StaticOrder {
    int nM, nN, nwg, G, c, wv;
    __host__ __device__ void init(int M, int N, int G_, int c_) { nM = M / BM; nN = N / BM; nwg = nM * nN; G = G_; c = c_; }
    __host__ __device__ bool next(int i, Unit& u) const {
        const long L = (long)i * G + c; if (L >= nwg) return false;
        int wgid = (int)L; { const int q = nwg / NXCD, r = nwg % NXCD, xcd = wgid % NXCD, off = wgid / NXCD; wgid = (xcd < r ? xcd * (q + 1) : r * (q + 1) + (xcd - r) * q) + off; }
        const int nig = WGM * nN, gid = wgid / nig, fm = gid * WGM, gsz = (nM - fm) < WGM ? (nM - fm) : WGM;
        u.pm = fm + ((wgid % nig) % gsz); u.pn = (wgid % nig) / gsz; return true;
    }
    __device__ __forceinline__ void a_ready(const Unit&) const {}
    __device__ __forceinline__ void done(const Unit&) const {}
};

__device__ __forceinline__ unsigned cvt_pk_bf16(float lo, float hi) { unsigned r; asm volatile("v_cvt_pk_bf16_f32 %0, %1, %2" : "=v"(r) : "v"(lo), "v"(hi)); return r; }
template <class Epi, class Sched, bool ALIGN_EPI = false, bool SP2 = false>
__device__ __forceinline__ void gemm_phase(PG8_LAS unsigned char* lds, const Gemm g, const Sched& S, const Epi& E) {
    const int tid = tidx(S.wv), wid = __builtin_amdgcn_readfirstlane(tid >> 6), lane = tid & 63, wr = wid >> 2, wc = wid & 3, fr = lane & 15, fq = lane >> 4;
    const int K = g.K, nt = K / BK;
    unsigned voffA[2], voffB[2];
#pragma unroll
    for (int i = 0; i < 2; ++i) { int R, C; stage_rc(tid * 16 + i * 8192, R, C); const int Rb = Epi::PERM ? ((R & ~31) + perm32(R & 31)) : R;
        voffA[i] = (unsigned)(R * K + C) * 2u; voffB[i] = (unsigned)(Rb * K + C) * 2u; }
    const size_t kstep = (size_t)(BK * 2);
    const size_t hstep = (size_t)HALF * K * 2;
    const size_t tstep = 2 * hstep;
    const unsigned ldsw = (unsigned)wid * 1024u;
    const int aoff = lds_byte(wr * 64 + fr, fq * 8), boff = lds_byte(wc * 32 + fr, fq * 8);
#define PG8_SA(b, h) (((b) * 2 + (h)) * HTB)
#define PG8_SB(b, h) ((4 + (b) * 2 + (h)) * HTB)
#define PG8_STAGE(bufoff, gbase, voff) do { _Pragma("unroll") for (int _i = 0; _i < 2; ++_i) \
        __builtin_amdgcn_global_load_lds((const unsigned*)((const char*)(gbase) + (voff)[_i]), (PG8_LAS unsigned*)(lds + (bufoff) + ldsw + _i * 8192), 16, 0, 0); } while (0)
#define PG8_LDA(dst, b, h) do { _Pragma("unroll") for (int m = 0; m < 4; ++m) _Pragma("unroll") for (int k = 0; k < 2; ++k) dst[m][k] = *(const PG8_LAS bf16x8*)(lds + PG8_SA(b, h) + aoff + m * 2048 + k * 1024); } while (0)
#define PG8_LDB(dst, b, h) do { _Pragma("unroll") for (int n = 0; n < 2; ++n) _Pragma("unroll") for (int k = 0; k < 2; ++k) dst[n][k] = *(const PG8_LAS bf16x8*)(lds + PG8_SB(b, h) + boff + n * 2048 + k * 1024); } while (0)
#define PG8_MMA(ai, bj, At, Bt) do { __builtin_amdgcn_s_setprio(1); _Pragma("unroll") for (int m = 0; m < 4; ++m) _Pragma("unroll") for (int n = 0; n < 2; ++n) _Pragma("unroll") for (int k = 0; k < 2; ++k) \
        acc[ai][bj][m][n] = __builtin_amdgcn_mfma_f32_16x16x32_bf16(Bt[n][k], At[m][k], acc[ai][bj][m][n], 0, 0, 0); __builtin_amdgcn_s_setprio(0); } while (0)
#define PG8_WAIT_V(n) asm volatile("s_waitcnt vmcnt(" #n ")" ::: "memory")
#define PG8_WAIT_L(n) asm volatile("s_waitcnt lgkmcnt(" #n ")" ::: "memory")
#define PG8_BAR __builtin_amdgcn_s_barrier()
#define PG8_SCHED __builtin_amdgcn_sched_barrier(0)
    Unit cur, nxt; int ui = 0;
    if (!S.next(0, cur)) return;
    f32x4 acc[2][2][4][2];
#pragma unroll
    for (int a = 0; a < 2; ++a)
#pragma unroll
        for (int b = 0; b < 2; ++b)
#pragma unroll
            for (int m = 0; m < 4; ++m)
#pragma unroll
                for (int n = 0; n < 2; ++n) acc[a][b][m][n] = (f32x4){0.f, 0.f, 0.f, 0.f};
    bf16x8 At[4][2], B0[2][2], B1[2][2];
    const char* cA = (const char*)g.A + (size_t)cur.pm * tstep; const char* cB = (const char*)g.Bt + (size_t)cur.pn * tstep;
    S.a_ready(cur);
    if constexpr (SP2) {
        PG8_STAGE(PG8_SB(0, 0), cB, voffB); PG8_STAGE(PG8_SB(0, 1), cB + hstep, voffB); PG8_STAGE(PG8_SA(0, 0), cA, voffA); PG8_STAGE(PG8_SA(0, 1), cA + hstep, voffA);
        if (wr == 1) PG8_BAR;
        PG8_WAIT_V(2); PG8_BAR;
        PG8_STAGE(PG8_SB(1, 0), cB + kstep, voffB); PG8_STAGE(PG8_SA(1, 0), cA + kstep, voffA); PG8_STAGE(PG8_SB(1, 1), cB + hstep + kstep, voffB);
        PG8_WAIT_V(6); PG8_BAR;
    } else {
        PG8_STAGE(PG8_SB(0, 0), cB, voffB); PG8_STAGE(PG8_SA(0, 0), cA, voffA); PG8_STAGE(PG8_SB(0, 1), cB + hstep, voffB); PG8_STAGE(PG8_SA(0, 1), cA + hstep, voffA);
        if (wr == 1) PG8_BAR;
        PG8_WAIT_V(4); PG8_BAR;
        PG8_STAGE(PG8_SB(1, 0), cB + kstep, voffB); PG8_STAGE(PG8_SA(1, 0), cA + kstep, voffA); PG8_STAGE(PG8_SB(1, 1), cB + hstep + kstep, voffB);
        PG8_WAIT_V(6); PG8_BAR;
    }
    for (;;) {
        const bool has_next = S.next(ui + 1, nxt);
        const char* nA = has_next ? (const char*)g.A + (size_t)nxt.pm * tstep : cA; const char* nB = has_next ? (const char*)g.Bt + (size_t)nxt.pn * tstep : cB;
        for (int t = 0; t < nt; t += 2) {
            const bool last = (t == nt - 2);
            const char* a1 = cA + (size_t)(t + 1) * kstep;
            const char* a2 = last ? nA : cA + (size_t)(t + 2) * kstep; const char* b2 = last ? nB : cB + (size_t)(t + 2) * kstep;
            const char* a3 = a2 + kstep; const char* b3 = b2 + kstep;
            if (last && has_next) S.a_ready(nxt);
            if constexpr (SP2) {
            PG8_LDB(B0, 0, 0); PG8_LDB(B1, 0, 1); PG8_SCHED; PG8_LDA(At, 0, 0); PG8_STAGE(PG8_SA(1, 1), a1 + hstep, voffA);
            PG8_WAIT_V(8); PG8_WAIT_L(0); PG8_BAR; PG8_MMA(0, 0, At, B0); PG8_MMA(0, 1, At, B1); PG8_BAR; PG8_SCHED;
            PG8_LDA(At, 0, 1); PG8_STAGE(PG8_SB(0, 0), b2, voffB); PG8_STAGE(PG8_SB(0, 1), b2 + hstep, voffB); PG8_STAGE(PG8_SA(0, 0), a2, voffA);
            PG8_WAIT_V(8); PG8_WAIT_L(0); PG8_BAR; PG8_MMA(1, 0, At, B0); PG8_MMA(1, 1, At, B1); PG8_BAR; PG8_SCHED;
            PG8_LDB(B0, 1, 0); PG8_LDB(B1, 1, 1); PG8_SCHED; PG8_LDA(At, 1, 0); PG8_STAGE(PG8_SA(0, 1), a2 + hstep, voffA);
            PG8_WAIT_V(8); PG8_WAIT_L(0); PG8_BAR; PG8_MMA(0, 0, At, B0); PG8_MMA(0, 1, At, B1); PG8_BAR; PG8_SCHED;
            PG8_LDA(At, 1, 1); PG8_STAGE(PG8_SB(1, 0), b3, voffB); PG8_STAGE(PG8_SB(1, 1), b3 + hstep, voffB); PG8_STAGE(PG8_SA(1, 0), a3, voffA);
            PG8_WAIT_V(8); PG8_WAIT_L(0); PG8_BAR; PG8_MMA(1, 0, At, B0); PG8_MMA(1, 1, At, B1); PG8_BAR; PG8_SCHED;
            } else {
            PG8_LDB(B0, 0, 0); PG8_SCHED; PG8_LDA(At, 0, 0); PG8_STAGE(PG8_SA(1, 1), a1 + hstep, voffA);
            PG8_WAIT_L(8); PG8_BAR; PG8_WAIT_L(0); PG8_MMA(0, 0, At, B0); PG8_BAR; PG8_SCHED;
            PG8_LDB(B1, 0, 1); PG8_STAGE(PG8_SB(0, 0), b2, voffB);
            PG8_BAR; PG8_WAIT_L(0); PG8_MMA(0, 1, At, B1); PG8_BAR;
            PG8_LDA(At, 0, 1); PG8_STAGE(PG8_SA(0, 0), a2, voffA);
            PG8_BAR; PG8_WAIT_L(0); PG8_MMA(1, 0, At, B0); PG8_BAR; PG8_SCHED;
            PG8_STAGE(PG8_SB(0, 1), b2 + hstep, voffB);
            PG8_WAIT_V(6); PG8_BAR; PG8_MMA(1, 1, At, B1); PG8_BAR;
            PG8_LDB(B0, 1, 0); PG8_SCHED; PG8_LDA(At, 1, 0); PG8_STAGE(PG8_SA(0, 1), a2 + hstep, voffA);
            PG8_WAIT_L(8); PG8_BAR; PG8_WAIT_L(0); PG8_MMA(0, 0, At, B0); PG8_BAR; PG8_SCHED;
            PG8_LDB(B1, 1, 1); PG8_STAGE(PG8_SB(1, 0), b3, voffB);
            PG8_BAR; PG8_WAIT_L(0); PG8_MMA(0, 1, At, B1); PG8_BAR;
            PG8_LDA(At, 1, 1); PG8_STAGE(PG8_SA(1, 0), a3, voffA);
            PG8_BAR; PG8_WAIT_L(0); PG8_MMA(1, 0, At, B0); PG8_BAR; PG8_SCHED;
            PG8_STAGE(PG8_SB(1, 1), b3 + hstep, voffB);
            PG8_WAIT_V(6); PG8_BAR; PG8_MMA(1, 1, At, B1); PG8_BAR;
            }
        }
        if constexpr (ALIGN_EPI) { if (wr == 0) PG8_BAR; }
        if constexpr (!Epi::AFTER_DRAIN) { E(acc, cur, wr, wc, fr, fq); S.done(cur); }
        if (!has_next) break;
#pragma unroll
        for (int a = 0; a < 2; ++a)
#pragma unroll
            for (int b = 0; b < 2; ++b)
#pragma unroll
                for (int m = 0; m < 4; ++m)
#pragma unroll
                    for (int n = 0; n < 2; ++n) acc[a][b][m][n] = (f32x4){0.f, 0.f, 0.f, 0.f};
        cur = nxt; cA = nA; cB = nB; ++ui;
        if constexpr (ALIGN_EPI) { if (wr == 1) PG8_BAR; }
    }
    PG8_WAIT_V(0);
    if constexpr (!ALIGN_EPI) { if (wr == 0) PG8_BAR; }
    PG8_BAR;
    if constexpr (Epi::AFTER_DRAIN) { E.fused(acc, cur, wr, wc, fr, fq, lds, wid, lane); S.done(cur); }
#undef PG8_SA
#undef PG8_SB
#undef PG8_STAGE
#undef PG8_LDA
#undef PG8_LDB
#undef PG8_MMA
#undef PG8_WAIT_V
#undef PG8_WAIT_L
#undef PG8_BAR
#undef PG8_SCHED
}
}


#ifndef MK_MULTI
#define MK_MULTI 0
#endif
#define DI __device__ __forceinline__
#define LAS __attribute__((address_space(3)))
typedef unsigned short bf16;
typedef short bf16x8 __attribute__((ext_vector_type(8)));
typedef float f32x4 __attribute__((ext_vector_type(4)));
typedef float f32x16 __attribute__((ext_vector_type(16)));
typedef unsigned u32x4 __attribute__((ext_vector_type(4)));
typedef unsigned u32x2 __attribute__((ext_vector_type(2)));
typedef float f32x2_t __attribute__((ext_vector_type(2)));
typedef __bf16 bf16x2_t __attribute__((ext_vector_type(2)));
typedef LAS unsigned char* lptr;


constexpr int SEQ = 2048, DM = 1024, TH = 16384  , DFF = 4096, DIN = 9632;
constexpr float EPS = 1e-6f, LOG2E = 1.4426950408889634f;
constexpr float QSC_DIFF = 0.125f * LOG2E;
constexpr float QSC_MLA = 0.10206207261596575f * LOG2E;
constexpr float KSC_RET = 0.08838834764831845f;
constexpr int NTHR = 512;
constexpr int LDS_BYTES = 147456;

constexpr size_t MiB = 1u << 20;
constexpr size_t WS_CNT = 0, WS_LAM = 256, WS_BIAS = 1024, WS_GAIN = 65536;
constexpr size_t WS_SUBG = WS_GAIN + 4 * 2 * 1024 * 4;
constexpr size_t WS_RCOS = 1 * MiB, WS_RSIN = WS_RCOS + 512 * 1024, WS_MCOS = 2 * MiB, WS_MSIN = WS_MCOS + 128 * 1024;
constexpr size_t WS_W = 4 * MiB;
constexpr size_t WO_IN1 = 0, WO_V = WO_IN1 + 4608 * 1024, WO_G = WO_V + 2048 * 1024, WO_UQ = WO_G + 3072 * 1024, WO_UK = WO_UQ + 1536 * 256,
                 WO_UV = WO_UK + 1024 * 256, WO_RO = WO_UV + 1024 * 256, WO_DO = WO_RO + 1024 * 1024, WO_MO = WO_DO + 1024 * 1024, WO_OUT = WO_MO + 1024 * 1024,
                 WO_UP = WO_OUT + 1024 * 1024, WO_DOWN = WO_UP + 4096 * 1024, WO_END = WO_DOWN + 4096 * 1024;
static_assert(WS_W + 2 * WO_END * 2 <= 96 * MiB, "weights fit");
constexpr size_t WS_H = 96 * MiB;
constexpr size_t WS_RQ = 128 * MiB, WS_RK = 144 * MiB, WS_RVT = 160 * MiB, WS_RG = 192 * MiB, WS_G = 128 * MiB;
constexpr size_t WS_DQ = 224 * MiB, WS_DK = 256 * MiB, WS_DVT = 288 * MiB, WS_M32 = 256 * MiB;
constexpr size_t WS_CQ = 320 * MiB, WS_CKV = 328 * MiB  , WS_KPE = 336 * MiB, WS_SSQ_CQ = 337 * MiB, WS_SSQ_CKV = WS_SSQ_CQ + 256 * 1024;
constexpr size_t WS_QMN = 338 * MiB, WS_QMP = 370 * MiB, WS_KMN = 386 * MiB, WS_VMT = 418 * MiB, WS_RO = 450 * MiB;
constexpr size_t WS_MG = 370 * MiB, WS_Y = 402 * MiB, WS_SSQ_Y = 434 * MiB, WS_U = 128 * MiB, WS_END = 482 * MiB;

struct Params {
    const float *x, *rel_bias, *pre_mix_g, *w_in, *w_ret_o, *lq1, *lk1, *lq2, *lk2, *subln_g, *w_diff_o, *q_norm_g, *w_uq, *kv_norm_g, *w_ukv, *w_mla_o,
                *w_out, *post_mix_g, *pre_mlp_g, *w_up, *w_down, *post_mlp_g;
    float* out; unsigned char* ws; int ph_lo, ph_hi;
};

DI unsigned cvtpk(float lo, float hi) { f32x2_t v = {lo, hi}; bf16x2_t b = __builtin_convertvector(v, bf16x2_t); return __builtin_bit_cast(unsigned, b); }
DI u32x4 pack8(f32x4 a, f32x4 b) { u32x4 w; w.x = cvtpk(a[0], a[1]); w.y = cvtpk(a[2], a[3]); w.z = cvtpk(b[0], b[1]); w.w = cvtpk(b[2], b[3]); return w; }
DI float bflo(unsigned u) { return __uint_as_float(u << 16); }
DI float bfhi(unsigned u) { return __uint_as_float(u & 0xffff0000u); }
DI void unpack8(u32x4 w, f32x4& a, f32x4& b) { a = (f32x4){bflo(w.x), bfhi(w.x), bflo(w.y), bfhi(w.y)}; b = (f32x4){bflo(w.z), bfhi(w.z), bflo(w.w), bfhi(w.w)}; }
DI float ex2(float x) { return __builtin_amdgcn_exp2f(x); }
DI float sigm(float x) { return __builtin_amdgcn_rcpf(1.f + ex2(-x * LOG2E)); }
DI float shx(float v, int m, int lane) { return __int_as_float(__builtin_amdgcn_ds_bpermute((lane ^ m) << 2, __float_as_int(v))); }
DI float wave_sum(float v, int lane) {
#pragma unroll
    for (int o = 1; o < 64; o <<= 1) v += shx(v, o, lane);
    return v;
}
DI float sq4(f32x4 v) { return (v[0] * v[0] + v[1] * v[1]) + (v[2] * v[2] + v[3] * v[3]); }

DI int colmap(int map, int n, int off) {
    switch (map) {
        case 0: return off + n;
        case 1: { const int p = n & 127, bj = (n >> 7) & 1; return off + (n & ~255) + (p >> 6) * 128 + bj * 64 + (p & 63); }
        case 2: { if (n < 128) return 6400 + n; if (n >= 160) return -1; const int q = n - 128; return 6528 + 16 * ((q >> 2) & 1) + 4 * (q >> 3) + (q & 3); }
        case 3: { if (n < 1024) return (n >> 6) * 96 + (n & 63); const int q = n - 1024, hh = q >> 5, pos = q & 31; return hh * 96 + 64 + 16 * ((pos >> 2) & 1) + 4 * (pos >> 3) + (pos & 3); }
        case 4: return (n >> 6) * 128 + (n & 63);
        default: return (n >> 6) * 128 + 64 + (n & 63);
    }
}
DI void conv_item(const float* W, int ldw, int K, int kvalid, bf16* WT, int map, int off, const float* gs, LAS float* scr, int item, int nblk, int lane) {
    const int kb = item / nblk, nb = item % nblk, k0 = 64 * kb, n0 = 32 * nb;
    const int oc = colmap(map, n0 + (lane & 31), off);
#pragma unroll 8
    for (int i = 0; i < 32; ++i) { const int kk = 2 * i + (lane >> 5); float v = 0.f; if (oc >= 0 && k0 + kk < kvalid) { v = W[(size_t)(k0 + kk) * ldw + oc]; if (gs) v *= gs[k0 + kk]; } scr[kk * 33 + (lane & 31)] = v; }
    asm volatile("s_waitcnt lgkmcnt(0)" ::: "memory");
    const int c = lane & 7;
#pragma unroll
    for (int j = 0; j < 4; ++j) { const int n = (lane >> 3) + 8 * j; const LAS float* s = scr + (8 * c) * 33 + n;
        u32x4 o; o.x = cvtpk(s[0 * 33], s[1 * 33]); o.y = cvtpk(s[2 * 33], s[3 * 33]); o.z = cvtpk(s[4 * 33], s[5 * 33]); o.w = cvtpk(s[6 * 33], s[7 * 33]);
        *(u32x4*)(WT + (size_t)(n0 + n) * K + k0 + 8 * c) = o; }
    asm volatile("s_waitcnt lgkmcnt(0)" ::: "memory");
}
DI int t5_bucket(int n) {
    if (n < 16) return n;
    int large = 16 + (int)(logf((float)n / 16.f) / 2.0794415416798357f * 16.f);
    return large < 31 ? large : 31;
}
DI void prologue(const Params& p, lptr lds, int wv) {
    const int tid = tidx(wv), lane = tid & 63, wave = tid >> 6;
    const int gw = blockIdx.x * 8 + wave, NGW = gridDim.x * 8, gt = blockIdx.x * NTHR + tid, NGT = gridDim.x * NTHR;
    unsigned char* ws = p.ws;
    if (blockIdx.x == 0) {
        if (tid < 16) ((unsigned*)(ws + WS_CNT))[tid] = 0u;
        if (tid >= 64 && tid < 66) {
            const int l = tid - 64; float a = 0.f, b = 0.f;
            for (int i = 0; i < 64; ++i) { a += p.lq1[l * 64 + i] * p.lk1[l * 64 + i]; b += p.lq2[l * 64 + i] * p.lk2[l * 64 + i]; }
            const float linit = 0.8f - 0.6f * expf(-0.3f * (float)l);
            ((float*)(ws + WS_LAM))[l] = expf(a) - expf(b) + linit; ((float*)(ws + WS_LAM))[2 + l] = 1.f - linit;
        }
    }
    for (int i = gt; i < 2048; i += NGT) { float* gd = (float*)(ws + WS_GAIN); gd[i] = p.pre_mix_g[i]; gd[2048 + i] = p.post_mix_g[i]; gd[4096 + i] = p.pre_mlp_g[i]; gd[6144 + i] = p.post_mlp_g[i]; if (i < 256) ((float*)(ws + WS_SUBG))[i] = p.subln_g[i]; }
    for (int i = gt; i < 8 * 128; i += NGT) { const int hh = i >> 7, n = i & 127; ((float*)(ws + WS_BIAS))[i] = p.rel_bias[t5_bucket(n) * 8 + hh] * LOG2E; }
    for (int i = gt; i < SEQ * 64; i += NGT) { const int s = i >> 6, d = i & 63; const float inv = (float)(1.0 / pow(10000.0, (double)d / 63.0)); const float ang = (float)s * inv;
        ((float*)(ws + WS_RCOS))[i] = (float)cos((double)ang); ((float*)(ws + WS_RSIN))[i] = (float)sin((double)ang); }
    for (int i = gt; i < SEQ * 16; i += NGT) { const int s = i >> 4, d = i & 15; const float inv = (float)(1.0 / pow(10000.0, (double)(2 * d) / 32.0)); const float ang = (float)s * inv;
        ((float*)(ws + WS_MCOS))[i] = (float)cos((double)ang); ((float*)(ws + WS_MSIN))[i] = (float)sin((double)ang); }
    LAS float* scr = (LAS float*)(lds + wave * 16384);
    for (int l = 0; l < 2; ++l) {
        bf16* Wb = (bf16*)(ws + WS_W) + (size_t)l * WO_END;
        const float* win = p.w_in + (size_t)l * DM * DIN;
        for (int job = 0; job < 19; ++job) {
            const float* src = win; int ldw = DIN, K = 1024, kvalid = 4096, ns = 1024, map = 0, off = 0; const float* gs = nullptr; bf16* dst = Wb;
            switch (job) {
                case 0: ns = 512; map = 1; off = 0; dst = Wb + WO_IN1; break;
                case 1: ns = 512; map = 1; off = 512; dst = Wb + WO_IN1 + (size_t)512 * 1024; break;
                case 2: off = 2048; dst = Wb + WO_IN1 + (size_t)1024 * 1024; break;
                case 3: off = 3072; dst = Wb + WO_IN1 + (size_t)2048 * 1024; break;
                case 4: off = 4096; dst = Wb + WO_IN1 + (size_t)3072 * 1024; break;
                case 5: ns = 256; off = 6144; dst = Wb + WO_IN1 + (size_t)4096 * 1024; break;
                case 6: ns = 256; map = 2; dst = Wb + WO_IN1 + (size_t)4352 * 1024; break;
                case 7: off = 1024; dst = Wb + WO_V; break;
                case 8: off = 5120; dst = Wb + WO_V + (size_t)1024 * 1024; break;
                case 9: ns = 3072; off = 6560; dst = Wb + WO_G; break;
                case 10: src = p.w_uq + (size_t)l * 256 * 1536; ldw = 1536; K = 256; ns = 1536; map = 3; gs = p.q_norm_g + l * 256; dst = Wb + WO_UQ; break;
                case 11: src = p.w_ukv + (size_t)l * 128 * 2048; ldw = 2048; K = 256; kvalid = 128; map = 4; gs = p.kv_norm_g + l * 128; dst = Wb + WO_UK; break;
                case 12: src = p.w_ukv + (size_t)l * 128 * 2048; ldw = 2048; K = 256; kvalid = 128; map = 5; gs = p.kv_norm_g + l * 128; dst = Wb + WO_UV; break;
                case 13: src = p.w_ret_o + (size_t)l * 1024 * 1024; ldw = 1024; dst = Wb + WO_RO; break;
                case 14: src = p.w_diff_o + (size_t)l * 1024 * 1024; ldw = 1024; dst = Wb + WO_DO; break;
                case 15: src = p.w_mla_o + (size_t)l * 1024 * 1024; ldw = 1024; dst = Wb + WO_MO; break;
                case 16: src = p.w_out + (size_t)l * 1024 * 1024; ldw = 1024; dst = Wb + WO_OUT; break;
                case 17: src = p.w_up + (size_t)l * 1024 * 4096; ldw = 4096; ns = 4096; dst = Wb + WO_UP; break;
                default: src = p.w_down + (size_t)l * 4096 * 1024; ldw = 1024; K = 4096; dst = Wb + WO_DOWN; break;
            }
            const int nblk = ns / 32, items = (K / 64) * nblk;
            for (int it = gw; it < items; it += NGW) conv_item(src, ldw, K, kvalid, dst, map, off, gs, scr, it, nblk, lane);
        }
    }
}

DI void norm_rows(const float* x, const float* g, bf16* o, int rows, int wv) {
    const int tid_ = tidx(wv); const int lane = tid_ & 63, gw = blockIdx.x * 8 + (tid_ >> 6), NGW = gridDim.x * 8;
    for (int m = gw; m < rows; m += NGW) {
        const f32x4* xr = (const f32x4*)(x + (size_t)m * DM) + lane; f32x4 v[4]; float s = 0.f;
#pragma unroll
        for (int j = 0; j < 4; ++j) { v[j] = xr[64 * j]; s += sq4(v[j]); }
        const float rs = 1.0f / sqrtf(wave_sum(s, lane) * (1.f / DM) + EPS);
        u32x2* o8 = (u32x2*)(o + (size_t)m * DM) + lane;
#pragma unroll
        for (int j = 0; j < 4; ++j) { const f32x4 gg = ((const f32x4*)g)[lane + 64 * j]; u32x2 w; w.x = cvtpk(v[j][0] * rs * gg[0], v[j][1] * rs * gg[1]); w.y = cvtpk(v[j][2] * rs * gg[2], v[j][3] * rs * gg[3]); o8[64 * j] = w; }
    }
}
DI void resid_rows(const float* xin, const bf16* y, const float* ssq, const float* gpost, float* xout, const float* gnext, bf16* hout, int rows, int wv, bool ablate = false) {
    const int tid_ = tidx(wv); const int lane = tid_ & 63, gw = blockIdx.x * 8 + (tid_ >> 6), NGW = gridDim.x * 8;
    for (int m = gw; m < rows; m += NGW) {
        const float part = lane < 16 ? ssq[(size_t)m * 16 + lane] : 0.f;
        float rs = 1.0f / sqrtf(wave_sum(part, lane) * (1.f / DM) + EPS);
#ifdef ABL_MLP
        if (!gnext || gnext == (const float*)0 + 1) rs = rs; if (ablate) rs = 0.f;
#endif
        const f32x4* xr = (const f32x4*)(xin + (size_t)m * DM) + lane; const u32x2* yr = (const u32x2*)(y + (size_t)m * DM) + lane; f32x4* xo = (f32x4*)(xout + (size_t)m * DM) + lane;
        f32x4 v[4]; float s = 0.f;
#pragma unroll
        for (int j = 0; j < 4; ++j) { const f32x4 xv = xr[64 * j]; const u32x2 yw = yr[64 * j]; const f32x4 gg = ((const f32x4*)gpost)[lane + 64 * j];
            f32x4 yv = (f32x4){bflo(yw.x), bfhi(yw.x), bflo(yw.y), bfhi(yw.y)};
            v[j] = xv + yv * rs * gg; xo[64 * j] = v[j]; s += sq4(v[j]); }
        if (gnext) {
            const float rs2 = 1.0f / sqrtf(wave_sum(s, lane) * (1.f / DM) + EPS);
            u32x2* o8 = (u32x2*)(hout + (size_t)m * DM) + lane;
#pragma unroll
            for (int j = 0; j < 4; ++j) { const f32x4 gg = ((const f32x4*)gnext)[lane + 64 * j]; u32x2 w; w.x = cvtpk(v[j][0] * rs2 * gg[0], v[j][1] * rs2 * gg[1]); w.y = cvtpk(v[j][2] * rs2 * gg[2], v[j][3] * rs2 * gg[3]); o8[64 * j] = w; }
        }
    }
}

#define EPI_ARGS const f32x4 (&acc)[2][2][4][2], const pg8::Unit& u, int wr, int wc, int fr, int fq
#define FOR_AI_M _Pragma("unroll") for (int ai = 0; ai < 2; ++ai) _Pragma("unroll") for (int m = 0; m < 4; ++m)
#define FOR_BJ _Pragma("unroll") for (int bj = 0; bj < 2; ++bj)

struct EpiIn1 {
    static constexpr bool PERM = true, AFTER_DRAIN = false;
    unsigned char* ws;
    DI void operator()(EPI_ARGS) const {
        asm volatile("" : "+v"(fr), "+v"(fq));
        bf16 *RQ = (bf16*)(ws + WS_RQ), *RK = (bf16*)(ws + WS_RK), *RG = (bf16*)(ws + WS_RG), *DQ = (bf16*)(ws + WS_DQ), *DK = (bf16*)(ws + WS_DK), *CQ = (bf16*)(ws + WS_CQ), *CKV = (bf16*)(ws + WS_CKV), *KPE = (bf16*)(ws + WS_KPE);
        float *SSQ_CQ = (float*)(ws + WS_SSQ_CQ), *SSQ_CKV = (float*)(ws + WS_SSQ_CKV);
        const float *rcos = (const float*)(ws + WS_RCOS), *rsin = (const float*)(ws + WS_RSIN), *mcos = (const float*)(ws + WS_MCOS), *msin = (const float*)(ws + WS_MSIN);
        const int pn = u.pn, row0 = u.pm * 256 + wr * 64 + fr, c8 = wc * 32 + 8 * fq;
        if (pn < 4) {
            bf16* dst = pn < 2 ? RQ : RK; const int head = 2 * (pn & 1) + (wc >> 1), d0 = c8 & 63;
            const float l2g = log2f(1.f - ex2(-5.f - (float)head)), l2s = pn < 2 ? l2g : -l2g, sc0 = pn < 2 ? 1.f : KSC_RET;
            FOR_AI_M { const int t = row0 + ai * 128 + m * 16, s = t & (SEQ - 1); const float sc = sc0 * ex2(l2s * (float)(s & 63));
                const f32x4 c0 = *(const f32x4*)(rcos + s * 64 + d0), c1 = *(const f32x4*)(rcos + s * 64 + d0 + 4), s0 = *(const f32x4*)(rsin + s * 64 + d0), s1 = *(const f32x4*)(rsin + s * 64 + d0 + 4);
                const f32x4 x1a = acc[ai][0][m][0], x1b = acc[ai][0][m][1], x2a = acc[ai][1][m][0], x2b = acc[ai][1][m][1];
                bf16* o = dst + (size_t)t * 512 + head * 128 + d0;
                *(u32x4*)o = pack8((x1a * c0 - x2a * s0) * sc, (x1b * c1 - x2b * s1) * sc);
                *(u32x4*)(o + 64) = pack8((x2a * c0 + x1a * s0) * sc, (x2b * c1 + x1b * s1) * sc); asm volatile("" ::: "memory"); }
        } else if (pn < 16) {
            const int seg = (pn - 4) >> 2; bf16* dst = seg == 0 ? RG : (seg == 1 ? DQ : DK); const int colb = ((pn - 4) & 3) * 256 + c8;
            FOR_AI_M { const int t = row0 + ai * 128 + m * 16;
                FOR_BJ { f32x4 v0 = acc[ai][bj][m][0], v1 = acc[ai][bj][m][1];
                    if (seg == 0) {
#pragma unroll
                        for (int i = 0; i < 4; ++i) { v0[i] = v0[i] * sigm(v0[i]); v1[i] = v1[i] * sigm(v1[i]); } }
                    else if (seg == 1) { v0 = v0 * QSC_DIFF; v1 = v1 * QSC_DIFF; }
                    *(u32x4*)(dst + (size_t)t * 1024 + colb + bj * 128) = pack8(v0, v1); } }
        } else if (pn == 16) {
            FOR_AI_M { const int t = row0 + ai * 128 + m * 16; float ss = 0.f;
                FOR_BJ { const f32x4 v0 = acc[ai][bj][m][0], v1 = acc[ai][bj][m][1]; ss += sq4(v0) + sq4(v1); *(u32x4*)(CQ + (size_t)t * 256 + c8 + bj * 128) = pack8(v0, v1); }
                ss += shx(ss, 16, fq * 16 + fr); ss += shx(ss, 32, fq * 16 + fr);
                if (fq == 0) SSQ_CQ[(size_t)t * 4 + wc] = ss; }
        } else {
            FOR_AI_M { const int t = row0 + ai * 128 + m * 16, s = t & (SEQ - 1);
                const f32x4 v0 = acc[ai][0][m][0], v1 = acc[ai][0][m][1]; float ss = sq4(v0) + sq4(v1);
                *(u32x4*)(CKV + (size_t)t * 256 + c8) = pack8(v0, v1); *(u32x4*)(CKV + (size_t)t * 256 + 128 + c8) = pack8(acc[ai][1][m][0], acc[ai][1][m][1]);
                ss += shx(ss, 16, fq * 16 + fr); ss += shx(ss, 32, fq * 16 + fr);
                if (fq == 0) SSQ_CKV[(size_t)t * 4 + wc] = ss;
                if (wc == 0) { const f32x4 x1 = acc[ai][1][m][0], x2 = acc[ai][1][m][1]; const f32x4 c = *(const f32x4*)(mcos + s * 16 + 4 * fq), sn = *(const f32x4*)(msin + s * 16 + 4 * fq);
                    const f32x4 o1 = x1 * c - x2 * sn, o2 = x2 * c + x1 * sn; u32x2 w1, w2; w1.x = cvtpk(o1[0], o1[1]); w1.y = cvtpk(o1[2], o1[3]); w2.x = cvtpk(o2[0], o2[1]); w2.y = cvtpk(o2[2], o2[3]);
                    *(u32x2*)(KPE + (size_t)t * 32 + 4 * fq) = w1; *(u32x2*)(KPE + (size_t)t * 32 + 16 + 4 * fq) = w2; } }
        }
    }
};
struct EpiVt {
    static constexpr bool PERM = true, AFTER_DRAIN = false;
    bf16 *T0, *T1; const float* ssq; float inv_n;
    DI void operator()(EPI_ARGS) const {
        asm volatile("" : "+v"(fr), "+v"(fq));
        const int b = u.pn >> 3, s0 = (u.pn & 7) * 256 + wc * 32 + 8 * fq;
        float rs[2][8];
        FOR_BJ {
#pragma unroll
            for (int k = 0; k < 8; ++k) { rs[bj][k] = 1.f; if (ssq) { const f32x4 q = *(const f32x4*)(ssq + (size_t)(b * SEQ + s0 + bj * 128 + k) * 4); rs[bj][k] = 1.0f / sqrtf(((q[0] + q[1]) + (q[2] + q[3])) * inv_n + EPS); } } }
        FOR_AI_M { const int R = u.pm * 256 + ai * 128 + wr * 64 + m * 16 + fr;
            bf16* rowp = (R < 1024 ? T0 + (size_t)(b * 1024 + R) * SEQ : T1 + (size_t)(b * 1024 + R - 1024) * SEQ) + s0;
            FOR_BJ { f32x4 v0 = acc[ai][bj][m][0], v1 = acc[ai][bj][m][1];
#pragma unroll
                for (int i = 0; i < 4; ++i) { v0[i] *= rs[bj][i]; v1[i] *= rs[bj][4 + i]; }
                *(u32x4*)(rowp + bj * 128) = pack8(v0, v1); } }
    }
};
struct EpiUq {
    static constexpr bool PERM = true, AFTER_DRAIN = false;
    bf16 *QMn, *QMp; const float *ssq, *mcos, *msin; int wv;
    DI void operator()(EPI_ARGS) const {
        { const int t_ = tidx(wv); fr = t_ & 15; fq = (t_ >> 4) & 3; }
        const int pn = u.pn, row0 = u.pm * 256 + wr * 64 + fr, c8 = wc * 32 + 8 * fq;
        FOR_AI_M { const int t = row0 + ai * 128 + m * 16, s = t & (SEQ - 1);
            const f32x4 q = *(const f32x4*)(ssq + (size_t)t * 4); const float rs = QSC_MLA / sqrtf(((q[0] + q[1]) + (q[2] + q[3])) * (1.f / 256.f) + EPS);
            if (pn < 4) { FOR_BJ { *(u32x4*)(QMn + (size_t)t * 1024 + pn * 256 + bj * 128 + c8) = pack8(acc[ai][bj][m][0] * rs, acc[ai][bj][m][1] * rs); } }
            else { const f32x4 c = *(const f32x4*)(mcos + s * 16 + 4 * fq), sn = *(const f32x4*)(msin + s * 16 + 4 * fq);
                FOR_BJ { const int hh = (pn - 4) * 8 + bj * 4 + wc; const f32x4 x1 = acc[ai][bj][m][0] * rs, x2 = acc[ai][bj][m][1] * rs;
                    const f32x4 o1 = x1 * c - x2 * sn, o2 = x2 * c + x1 * sn; u32x2 w1, w2; w1.x = cvtpk(o1[0], o1[1]); w1.y = cvtpk(o1[2], o1[3]); w2.x = cvtpk(o2[0], o2[1]); w2.y = cvtpk(o2[2], o2[3]);
                    *(u32x2*)(QMp + (size_t)t * 512 + hh * 32 + 4 * fq) = w1; *(u32x2*)(QMp + (size_t)t * 512 + hh * 32 + 16 + 4 * fq) = w2; } }
            asm volatile("" ::: "memory");
        }
    }
};
struct EpiUk {
    static constexpr bool PERM = true, AFTER_DRAIN = false;
    bf16* KMn; const float* ssq;
    DI void operator()(EPI_ARGS) const {
        asm volatile("" : "+v"(fr), "+v"(fq));
        const int row0 = u.pm * 256 + wr * 64 + fr, c8 = wc * 32 + 8 * fq;
        FOR_AI_M { const int t = row0 + ai * 128 + m * 16;
            const f32x4 q = *(const f32x4*)(ssq + (size_t)t * 4); const float rs = 1.0f / sqrtf(((q[0] + q[1]) + (q[2] + q[3])) * (1.f / 128.f) + EPS);
            FOR_BJ { *(u32x4*)(KMn + (size_t)t * 1024 + u.pn * 256 + bj * 128 + c8) = pack8(acc[ai][bj][m][0] * rs, acc[ai][bj][m][1] * rs); } }
    }
};
template <int ACT  > struct EpiAct {
    static constexpr bool PERM = true, AFTER_DRAIN = false;
    bf16* O; int ldc;
    DI void operator()(EPI_ARGS) const {
        asm volatile("" : "+v"(fr), "+v"(fq));
        const int row0 = u.pm * 256 + wr * 64 + fr, c8 = u.pn * 256 + wc * 32 + 8 * fq;
        FOR_AI_M { const int t = row0 + ai * 128 + m * 16;
            FOR_BJ { f32x4 v0 = acc[ai][bj][m][0], v1 = acc[ai][bj][m][1];
#pragma unroll
                for (int i = 0; i < 4; ++i) { if (ACT == 0) { v0[i] = sigm(v0[i]); v1[i] = sigm(v1[i]); } else { const float a = fmaxf(v0[i], 0.f), b = fmaxf(v1[i], 0.f); v0[i] = a * a; v1[i] = b * b; } }
                *(u32x4*)(O + (size_t)t * ldc + c8 + bj * 128) = pack8(v0, v1); } }
    }
};
template <int I> struct EpiBranch {
    static constexpr bool PERM = true, AFTER_DRAIN = false;
    const bf16* G; float* M32; bf16* MG;
    DI void operator()(EPI_ARGS) const {
        asm volatile("" : "+v"(fr), "+v"(fq));
        const int row0 = u.pm * 256 + wr * 64 + fr, c8 = u.pn * 256 + wc * 32 + 8 * fq;
        FOR_AI_M { const int t = row0 + ai * 128 + m * 16;
            FOR_BJ { const size_t idx = (size_t)t * 1024 + c8 + bj * 128; f32x4 g0, g1; unpack8(*(const u32x4*)(G + idx), g0, g1);
                f32x4 v0 = acc[ai][bj][m][0] * g0, v1 = acc[ai][bj][m][1] * g1;
#ifdef ABL_BRANCH
                if (I == ABL_BRANCH) { v0 = v0 * 0.f; v1 = v1 * 0.f; }
#endif
                if (I > 0) { v0 = v0 + *(const f32x4*)(M32 + idx); v1 = v1 + *(const f32x4*)(M32 + idx + 4); }
                if (I < 2) { *(f32x4*)(M32 + idx) = v0; *(f32x4*)(M32 + idx + 4) = v1; } else *(u32x4*)(MG + idx) = pack8(v0, v1); } }
    }
};
struct EpiY {
    static constexpr bool PERM = true, AFTER_DRAIN = false;
    bf16* Y; float* SSQ;
    DI void operator()(EPI_ARGS) const {
        asm volatile("" : "+v"(fr), "+v"(fq));
        const int row0 = u.pm * 256 + wr * 64 + fr, c8 = u.pn * 256 + wc * 32 + 8 * fq;
        FOR_AI_M { const int t = row0 + ai * 128 + m * 16; float ss = 0.f;
            FOR_BJ { const f32x4 v0 = acc[ai][bj][m][0], v1 = acc[ai][bj][m][1]; ss += sq4(v0) + sq4(v1); *(u32x4*)(Y + (size_t)t * 1024 + c8 + bj * 128) = pack8(v0, v1); }
            ss += shx(ss, 16, fq * 16 + fr); ss += shx(ss, 32, fq * 16 + fr);
            if (fq == 0) SSQ[(size_t)t * 16 + u.pn * 4 + wc] = ss; }
    }
};

template <int MODE> struct AC;
template <> struct AC<0> { static constexpr int DQK = 128, KW = 128, DVW = 128, VTR = 256, QR = 128; };
template <> struct AC<1> { static constexpr int DQK = 64, KW = 128, DVW = 128, VTR = 128, QR = 128; };
template <> struct AC<2> { static constexpr int DQK = 96, KW = 96, DVW = 64, VTR = 64, QR = 256; };
constexpr int A_KBUF = 17408, A_VBUF = 36864, A_V0 = 2 * A_KBUF, A_MISC = 2 * A_KBUF + 2 * A_VBUF;
constexpr int A_LUT = A_MISC + 64, A_XCH = A_MISC + 1024;
static_assert(A_XCH + 2048 <= LDS_BYTES, "attention LDS map");
struct AttnP { unsigned char* ws; int l; };
struct AttnPtrs { const bf16 *RQ, *RK, *RVt, *RG; bf16* RO; bf16* DQ; const bf16 *DK, *DVt; bf16* QMn; const bf16 *QMp, *KMn, *KPE, *VMt; const float *biasl, *subg; float lam, oml; };

#pragma float_control(push)
#pragma float_control(precise, off)
template <int MODE> DI void attn_unit(lptr lds, const AttnP PP, const int b, const int hd, const int qb, const int wv) {
    using C = AC<MODE>;
    unsigned char* const ws = PP.ws;
    const AttnPtrs P{(const bf16*)(ws + WS_RQ), (const bf16*)(ws + WS_RK), (const bf16*)(ws + WS_RVT), (const bf16*)(ws + WS_RG), (bf16*)(ws + WS_RO), (bf16*)(ws + WS_DQ),
                     (const bf16*)(ws + WS_DK), (const bf16*)(ws + WS_DVT), (bf16*)(ws + WS_QMN), (const bf16*)(ws + WS_QMP), (const bf16*)(ws + WS_KMN), (const bf16*)(ws + WS_KPE),
                     (const bf16*)(ws + WS_VMT), (const float*)(ws + WS_BIAS), (const float*)(ws + WS_SUBG) + PP.l * 128, 0.f, 0.f};
    constexpr int NKS = C::DQK / 16, NVB = C::DVW / 32, KS = (C::KW + 8) * 2, VS = 144, KCH = C::KW / 8, NKC = 64 * KCH, NVR = C::VTR / 64;
    const int tid = tidx(wv), w = __builtin_amdgcn_readfirstlane(tid >> 6), lane = tid & 63, r = lane & 31, h = lane >> 5;
    const int rg = MODE == 2 ? w : (w >> 1), pp = MODE == 2 ? 0 : (w & 1);
    const int q0 = qb * C::QR, q0w = q0 + rg * 32, tok0 = b * SEQ, qq = q0w + r;
    const int ntiles = (q0 + C::QR) / 64;
    const bf16* Kg; const bf16* Vg;
    if (MODE == 0) { Kg = P.RK + (size_t)tok0 * 512 + hd * 128; Vg = P.RVt + (size_t)(b * 4 + hd) * 256 * SEQ; }
    else if (MODE == 1) { Kg = P.DK + (size_t)tok0 * 1024 + hd * 128; Vg = P.DVt + (size_t)(b * 8 + hd) * 128 * SEQ; }
    else { Kg = P.KMn + (size_t)tok0 * 1024 + hd * 64; Vg = P.VMt + (size_t)(b * 16 + hd) * 64 * SEQ; }
    const bf16* Kpe = P.KPE + (size_t)tok0 * 32;
    bf16x8 q[NKS];
    { const size_t t = (size_t)(tok0 + qq);
#pragma unroll
        for (int ks = 0; ks < NKS; ++ks) {
            const bf16* src;
            if (MODE == 0) src = P.RQ + t * 512 + hd * 128 + ks * 16 + 8 * h;
            else if (MODE == 1) src = P.DQ + t * 1024 + hd * 128 + pp * 64 + ks * 16 + 8 * h;
            else src = ks < 4 ? P.QMn + t * 1024 + hd * 64 + ks * 16 + 8 * h : P.QMp + t * 512 + hd * 32 + (ks - 4) * 16 + 8 * h;
            q[ks] = *(const bf16x8*)src; } }
    if (MODE == 1) { if (tid < 128) ((LAS float*)(lds + A_LUT))[tid] = P.biasl[hd * 128 + tid]; }
    u32x4 kreg[2], vreg[NVR];
#define A_GLOAD(kt) do { \
    _Pragma("unroll") for (int i_ = 0; i_ < 2; ++i_) { const int id_ = tid + 512 * i_; if (id_ < NKC) { const int row_ = id_ / KCH, cc_ = id_ % KCH; const size_t kr_ = (size_t)((kt) * 64 + row_); \
        const bf16* s_; if (MODE == 2) s_ = cc_ < 8 ? Kg + kr_ * 1024 + cc_ * 8 : Kpe + kr_ * 32 + (cc_ - 8) * 8; else s_ = Kg + kr_ * (MODE == 0 ? 512 : 1024) + cc_ * 8; kreg[i_] = *(const u32x4*)s_; } } \
    _Pragma("unroll") for (int i_ = 0; i_ < NVR; ++i_) { const int id_ = tid + 512 * i_, row_ = id_ >> 3, cc_ = id_ & 7; vreg[i_] = *(const u32x4*)(Vg + (size_t)row_ * SEQ + (kt) * 64 + cc_ * 8); } } while (0)
#define A_LWRITE(buf) do { \
    _Pragma("unroll") for (int i_ = 0; i_ < 2; ++i_) { const int id_ = tid + 512 * i_; if (id_ < NKC) { const int row_ = id_ / KCH, cc_ = id_ % KCH; *(LAS u32x4*)(lds + (buf) * A_KBUF + row_ * KS + cc_ * 16) = kreg[i_]; } } \
    _Pragma("unroll") for (int i_ = 0; i_ < NVR; ++i_) { const int id_ = tid + 512 * i_, row_ = id_ >> 3, cc_ = id_ & 7; *(LAS u32x4*)(lds + A_V0 + (buf) * A_VBUF + row_ * VS + cc_ * 16) = vreg[i_]; } } while (0)
    f32x16 O[NVB];
#pragma unroll
    for (int vb = 0; vb < NVB; ++vb)
#pragma unroll
        for (int i = 0; i < 16; ++i) O[vb][i] = 0.f;
    float mrun = -INFINITY, lrun = 0.f;
    const float l2g = MODE == 0 ? log2f(1.f - ex2(-5.f - (float)hd)) : 0.f;
    const float b31 = MODE == 1 ? P.biasl[hd * 128 + 127] : 0.f;
    const int pir = (r & 0x13) | ((r & 8) >> 1) | ((r & 4) << 1);
    const int koffb = ((MODE == 1 ? pp * 64 : 0) + 8 * h) * 2;
    const int vrow0 = (MODE == 0 ? pp * 128 : 0) + r;
    A_GLOAD(0); A_LWRITE(0);
    __syncthreads();
    for (int kt = 0; kt < ntiles; ++kt) {
        const int cur = kt & 1;
        if (kt + 1 < ntiles) A_GLOAD(kt + 1);
        if (kt * 64 <= q0w + 31) {
            const lptr Kb = lds + cur * A_KBUF + koffb, Vb = lds + A_V0 + cur * A_VBUF + (8 * h) * 2;
            f32x16 S0, S1;
#pragma unroll
            for (int i = 0; i < 16; ++i) { S0[i] = 0.f; S1[i] = 0.f; }
#pragma unroll
            for (int ks = 0; ks < NKS; ++ks) {
                const bf16x8 a0 = *(const LAS bf16x8*)(Kb + pir * KS + ks * 32), a1 = *(const LAS bf16x8*)(Kb + (32 + pir) * KS + ks * 32);
                S0 = __builtin_amdgcn_mfma_f32_32x32x16_bf16(a0, q[ks], S0, 0, 0, 0);
                S1 = __builtin_amdgcn_mfma_f32_32x32x16_bf16(a1, q[ks], S1, 0, 0, 0);
            }
            const int kb0 = kt * 64 + 8 * h;
            const bool diag = (kt * 64 + 63 > q0w);
            if (MODE == 0) {
                const float cs = ex2(l2g * (float)(64 * ((q0w >> 6) - kt)));
                if (diag) {
#pragma unroll
                    for (int i = 0; i < 16; ++i) { const int k0 = kb0 + 16 * (i >> 3) + (i & 7); S0[i] = (k0 <= qq) ? S0[i] * cs : 0.f; S1[i] = (k0 + 32 <= qq) ? S1[i] * cs : 0.f; }
                } else {
#pragma unroll
                    for (int i = 0; i < 16; ++i) { S0[i] *= cs; S1[i] *= cs; }
                }
            } else {
                float boff = 0.f;
                if (MODE == 1) {
                    if (q0w - (kt * 64 + 63) >= 113) boff = b31;
                    else {
                        const LAS float* lut = (const LAS float*)(lds + A_LUT);
#pragma unroll
                        for (int i = 0; i < 16; ++i) { const int k0 = kb0 + 16 * (i >> 3) + (i & 7); int d0 = qq - k0, d1 = d0 - 32;
                            d0 = d0 < 0 ? 0 : (d0 > 127 ? 127 : d0); d1 = d1 < 0 ? 0 : (d1 > 127 ? 127 : d1); S0[i] += lut[d0]; S1[i] += lut[d1]; }
                    }
                }
                if (diag) {
#pragma unroll
                    for (int i = 0; i < 16; ++i) { const int k0 = kb0 + 16 * (i >> 3) + (i & 7); if (k0 > qq) S0[i] = -INFINITY; if (k0 + 32 > qq) S1[i] = -INFINITY; }
                }
                float mx = fmaxf(S0[0], S1[0]);
#pragma unroll
                for (int i = 1; i < 16; ++i) mx = fmaxf(mx, fmaxf(S0[i], S1[i]));
                mx = fmaxf(mx, shx(mx, 32, lane)) + boff;
                if (__builtin_amdgcn_ballot_w64(mx - mrun > 8.f) != 0ull) {
                    const float mn = fmaxf(mrun, mx), al = ex2(mrun - mn); mrun = mn; lrun *= al;
#pragma unroll
                    for (int vb = 0; vb < NVB; ++vb)
#pragma unroll
                        for (int i = 0; i < 16; ++i) O[vb][i] *= al;
                }
                const float nmo = boff - mrun;
                const f32x2_t nm2 = {nmo, nmo}; f32x2_t ps2 = {0.f, 0.f};
#pragma unroll
                for (int i = 0; i < 8; ++i) {
                    f32x2_t a = (f32x2_t){S0[2 * i], S0[2 * i + 1]} + nm2, c = (f32x2_t){S1[2 * i], S1[2 * i + 1]} + nm2;
                    a.x = ex2(a.x); a.y = ex2(a.y); c.x = ex2(c.x); c.y = ex2(c.y); ps2 += a; ps2 += c;
                    S0[2 * i] = a.x; S0[2 * i + 1] = a.y; S1[2 * i] = c.x; S1[2 * i + 1] = c.y; }
                lrun += ps2.x + ps2.y;
            }
            bf16x8 pf[2][2];
#pragma unroll
            for (int s = 0; s < 2; ++s) {
                u32x4 t0, t1;
                t0.x = cvtpk(S0[8 * s + 0], S0[8 * s + 1]); t0.y = cvtpk(S0[8 * s + 2], S0[8 * s + 3]); t0.z = cvtpk(S0[8 * s + 4], S0[8 * s + 5]); t0.w = cvtpk(S0[8 * s + 6], S0[8 * s + 7]);
                t1.x = cvtpk(S1[8 * s + 0], S1[8 * s + 1]); t1.y = cvtpk(S1[8 * s + 2], S1[8 * s + 3]); t1.z = cvtpk(S1[8 * s + 4], S1[8 * s + 5]); t1.w = cvtpk(S1[8 * s + 6], S1[8 * s + 7]);
                pf[0][s] = __builtin_bit_cast(bf16x8, t0); pf[1][s] = __builtin_bit_cast(bf16x8, t1);
            }
#pragma unroll
            for (int vb = 0; vb < NVB; ++vb)
#pragma unroll
                for (int kb = 0; kb < 2; ++kb)
#pragma unroll
                    for (int s = 0; s < 2; ++s) {
                        const bf16x8 a = *(const LAS bf16x8*)(Vb + (vrow0 + vb * 32) * VS + (kb * 32 + 16 * s) * 2);
                        O[vb] = __builtin_amdgcn_mfma_f32_32x32x16_bf16(a, pf[kb][s], O[vb], 0, 0, 0);
                    }
        }
        if (kt + 1 < ntiles) A_LWRITE(cur ^ 1);
        __syncthreads();
    }
#undef A_GLOAD
#undef A_LWRITE
    const size_t trow = (size_t)(tok0 + qq);
    if (MODE == 0) {
        float ss = 0.f;
#pragma unroll
        for (int vb = 0; vb < NVB; ++vb)
#pragma unroll
            for (int i = 0; i < 16; ++i) ss += O[vb][i] * O[vb][i];
        ss += shx(ss, 32, lane);
        LAS float* xch = (LAS float*)(lds + A_XCH);
        if (h == 0) xch[w * 32 + r] = ss;
        __syncthreads();
        const float tot = ss + xch[(w ^ 1) * 32 + r];
        const float rs = 1.0f / sqrtf(tot * (1.f / 256.f) + EPS);
#pragma unroll
        for (int vb = 0; vb < NVB; ++vb)
#pragma unroll
            for (int g = 0; g < 4; ++g) { const size_t idx = trow * 1024 + hd * 256 + pp * 128 + vb * 32 + 8 * g + 4 * h; const u32x2 gw = *(const u32x2*)(P.RG + idx);
                u32x2 o; o.x = cvtpk(O[vb][4 * g] * rs * bflo(gw.x), O[vb][4 * g + 1] * rs * bfhi(gw.x)); o.y = cvtpk(O[vb][4 * g + 2] * rs * bflo(gw.y), O[vb][4 * g + 3] * rs * bfhi(gw.y));
                *(u32x2*)(P.RO + idx) = o; }
    } else if (MODE == 1) {
        const float lt = lrun + shx(lrun, 32, lane), il = 1.0f / lt;
        LAS float* X = (LAS float*)lds + (size_t)rg * 64 * 64;
        if (pp == 1) {
#pragma unroll
            for (int vb = 0; vb < NVB; ++vb)
#pragma unroll
                for (int i = 0; i < 16; ++i) X[(vb * 16 + i) * 64 + lane] = O[vb][i] * il;
        }
        __syncthreads();
        if (pp == 0) {
            const float lam = ((const float*)(ws + WS_LAM))[PP.l], oml = ((const float*)(ws + WS_LAM))[2 + PP.l];
            float ss = 0.f;
#pragma unroll
            for (int vb = 0; vb < NVB; ++vb)
#pragma unroll
                for (int i = 0; i < 16; ++i) { const float v = O[vb][i] * il - lam * X[(vb * 16 + i) * 64 + lane]; O[vb][i] = v; ss += v * v; }
            ss += shx(ss, 32, lane);
            const float rs = oml / sqrtf(ss * (1.f / 128.f) + EPS);
#pragma unroll
            for (int vb = 0; vb < NVB; ++vb)
#pragma unroll
                for (int g = 0; g < 4; ++g) { const int dv = vb * 32 + 8 * g + 4 * h; const f32x4 gg = *(const f32x4*)(P.subg + dv);
                    u32x2 o; o.x = cvtpk(O[vb][4 * g] * rs * gg[0], O[vb][4 * g + 1] * rs * gg[1]); o.y = cvtpk(O[vb][4 * g + 2] * rs * gg[2], O[vb][4 * g + 3] * rs * gg[3]);
                    *(u32x2*)(P.DQ + trow * 1024 + hd * 128 + dv) = o; }
        }
    } else {
        const float lt = lrun + shx(lrun, 32, lane), il = 1.0f / lt;
#pragma unroll
        for (int vb = 0; vb < NVB; ++vb)
#pragma unroll
            for (int g = 0; g < 4; ++g) { u32x2 o; o.x = cvtpk(O[vb][4 * g] * il, O[vb][4 * g + 1] * il); o.y = cvtpk(O[vb][4 * g + 2] * il, O[vb][4 * g + 3] * il);
                *(u32x2*)(P.QMn + trow * 1024 + hd * 64 + vb * 32 + 8 * g + 4 * h) = o; }
    }
}
#pragma float_control(pop)
DI void attn_phase(lptr lds, const AttnP P, unsigned* counter, const int wv) {
    for (;;) {
        __syncthreads();
        if (tidx(wv) == 0) *(LAS int*)(lds + A_MISC) = (int)atomicAdd(counter, 1u);
        __syncthreads();
        const int idx = __builtin_amdgcn_readfirstlane(*(LAS int*)(lds + A_MISC));
        if (idx >= 2560) break;
        const int pr = 7 - idx / 320, rem = idx % 320;
        if (rem < 128) attn_unit<2>(lds, P, rem >> 4, rem & 15, pr, wv);
        else if (rem < 160) { const int e = rem - 128; attn_unit<0>(lds, P, e >> 2, e & 3, 2 * pr + 1, wv); }
        else if (rem < 224) { const int e = rem - 160; attn_unit<1>(lds, P, e >> 3, e & 7, 2 * pr + 1, wv); }
        else if (rem < 256) { const int e = rem - 224; attn_unit<0>(lds, P, e >> 2, e & 3, 2 * pr, wv); }
        else { const int e = rem - 256; attn_unit<1>(lds, P, e >> 3, e & 7, 2 * pr, wv); }
    }
}


constexpr size_t WS_BAR = 131072;
#define XB_TMO      128
#define XB_XCNT(j)  (256  + 64 * (j))
#define XB_XSUB(j)  (1280 + 64 * (j))
#define XB_XGEN(j)  (2304 + 64 * (j))
#define XB_TOP      3328
#define XB_TOPGEN   3392
#define XCD_BAR_WORDS 3456
#define XB_SPIN_CAP (1u << 18)
constexpr int LDS_XB = 143360;
DI unsigned xb_ld(unsigned* p)              { return __hip_atomic_load(p, __ATOMIC_RELAXED, __HIP_MEMORY_SCOPE_AGENT); }
DI unsigned xb_add(unsigned* p, unsigned v) { return __hip_atomic_fetch_add(p, v, __ATOMIC_RELAXED, __HIP_MEMORY_SCOPE_AGENT); }
DI unsigned xb_xcc_id() { return (unsigned)__builtin_amdgcn_s_getreg((3 << 11) | 20) & 0xFu; }
#define XB_SPIN(cond, bar) do { unsigned _sp = 0; while (cond) { __builtin_amdgcn_s_sleep(1); \
    if ((++_sp & 255u) == 0u) { if (xb_ld(&(bar)[XB_TMO])) break; if (_sp > XB_SPIN_CAP) { atomicAdd(&(bar)[XB_TMO], 1u); break; } } } } while (0)
DI void xcd_barrier_complete(unsigned* bar, unsigned x, unsigned& nloc, unsigned& nx) {
    const unsigned G = gridDim.x;
    unsigned sum, cnt, mine, sp = 0u;
    for (;;) {
        sum = 0u; cnt = 0u; mine = 0u;
#pragma unroll
        for (unsigned j = 0; j < 16; ++j) { const unsigned c = xb_ld(&bar[XB_XCNT(j)]); sum += c; cnt += (c > 0u) ? 1u : 0u; mine = (j == x) ? c : mine; }
        if (sum == G) break;
        __builtin_amdgcn_s_sleep(1);
        if ((++sp & 255u) == 0u) { if (xb_ld(&bar[XB_TMO])) break; if (sp > XB_SPIN_CAP) { atomicAdd(&bar[XB_TMO], 1u); break; } }
    }
    nloc = mine > 0u ? mine : 1u; nx = cnt > 0u ? cnt : 1u;
}
DI void xcd_barrier(unsigned* bar, lptr lds, const int wv) {
    asm volatile("s_waitcnt vmcnt(0)" ::: "memory");
    __syncthreads();
    if (tidx(wv) == 0) {
        volatile LAS unsigned* st = (volatile LAS unsigned*)(lds + LDS_XB);
        const unsigned x = xb_xcc_id();
        __builtin_amdgcn_s_waitcnt(0);
        unsigned nloc = st[0], nx = st[1];
        if (nloc == 0u) { xcd_barrier_complete(bar, x, nloc, nx); st[0] = nloc; st[1] = nx; }
        const unsigned old = xb_add(&bar[XB_XSUB(x)], 1u);
        const unsigned gen = old / nloc;
        if (old + 1u == (gen + 1u) * nloc) {
            __builtin_amdgcn_fence(__ATOMIC_RELEASE, "agent");
            asm volatile("s_waitcnt vmcnt(0)" ::: "memory");
            const unsigned og = xb_add(&bar[XB_TOP], 1u);
            const unsigned tg = og / nx;
            if (og + 1u == (tg + 1u) * nx) xb_add(&bar[XB_TOPGEN], 1u);
            else XB_SPIN(xb_ld(&bar[XB_TOPGEN]) == tg, bar);
            __builtin_amdgcn_fence(__ATOMIC_ACQUIRE, "agent");
            xb_add(&bar[XB_XGEN(x)], 1u);
            asm volatile("s_waitcnt vmcnt(0)" ::: "memory");
        } else {
            XB_SPIN(xb_ld(&bar[XB_XGEN(x)]) == gen, bar);
            __builtin_amdgcn_fence(__ATOMIC_ACQUIRE, "agent");
            asm volatile("s_waitcnt vmcnt(0)" ::: "memory");
        }
    }
    __syncthreads();
}
constexpr int N_PHASES = 39;
template <class Epi> DI void run_gemm(lptr lds, int wv, const bf16* A, const bf16* Bt, int M, int N, int K, const Epi& E) {
#ifdef DIS_GEMM
    return;
#endif
    int bx_ = (int)blockIdx.x; asm volatile("" : "+s"(bx_));
    pg8::Gemm g{A, Bt, M, N, K}; pg8::StaticOrder S; S.init(M, N, (int)gridDim.x, bx_); S.wv = wv;
    pg8::gemm_phase<Epi, pg8::StaticOrder, true, true>(lds, g, S, E);
}
__global__ void __launch_bounds__(NTHR) mega_fwd(Params p) {
    extern __shared__ __attribute__((aligned(16))) unsigned char lds_raw[];
    lptr lds = (lptr)lds_raw;
#if !MK_MULTI
    cg::grid_group grid = cg::this_grid();
#endif
    const int wv = __builtin_amdgcn_readfirstlane((int)threadIdx.x >> 6);
#if !MK_MULTI
    if (threadIdx.x == 0) { ((volatile LAS unsigned*)(lds + LDS_XB))[0] = 0u; ((volatile LAS unsigned*)(lds + LDS_XB))[1] = 0u; (void)xb_add((unsigned*)(p.ws + WS_BAR) + XB_XCNT(xb_xcc_id()), 1u); }
    __syncthreads();
#endif
    int ph = p.ph_lo; const int ph_hi = p.ph_hi;
    if (ph == 0) {
#ifndef DIS_PRO
        prologue(p, lds, wv);
#endif
        ++ph;
#if !MK_MULTI
        if (ph < ph_hi) grid.sync();
#endif
    }
    const float* xin0 = p.x; float* const outp = p.out; unsigned char* ws0 = p.ws;
    for (; ph < ph_hi; ++ph) {
        unsigned char* ws = ws0;
        asm volatile("" : "+s"(ws));
#ifdef MK_TS
        if (blockIdx.x == 0 && tidx(wv) == 0) ((unsigned long long*)(ws + 262144))[ph] = __builtin_amdgcn_s_memrealtime();
#endif
        const float* gains = (const float*)(ws + WS_GAIN);
        bf16* H = (bf16*)(ws + WS_H);
        const int hb = (ph - 1) / 19, k19 = (ph - 1) % 19;
        const size_t xoff = (size_t)hb * TH * DM;
        if (k19 == 0) norm_rows(xin0 + xoff, gains, H, TH, wv);
        else {
            const int l = (k19 - 1) / 9, k = (k19 - 1) % 9;
            const bf16* Wb = (const bf16*)(ws + WS_W) + (size_t)l * WO_END;
            if (k == 0) {
                EpiIn1 E1{ws};
                run_gemm(lds, wv, H, Wb + WO_IN1, TH, 4608, 1024, E1);
                EpiVt E2{(bf16*)(ws + WS_RVT), (bf16*)(ws + WS_DVT), nullptr, 0.f};
                run_gemm(lds, wv, Wb + WO_V, H, 2048, TH, 1024, E2);
            } else if (k == 1) {
                EpiUq Eq{(bf16*)(ws + WS_QMN), (bf16*)(ws + WS_QMP), (const float*)(ws + WS_SSQ_CQ), (const float*)(ws + WS_MCOS), (const float*)(ws + WS_MSIN), wv};
                run_gemm(lds, wv, (const bf16*)(ws + WS_CQ), Wb + WO_UQ, TH, 1536, 256, Eq);
                EpiUk Ek{(bf16*)(ws + WS_KMN), (const float*)(ws + WS_SSQ_CKV)};
                run_gemm(lds, wv, (const bf16*)(ws + WS_CKV), Wb + WO_UK, TH, 1024, 256, Ek);
                EpiVt Ev{(bf16*)(ws + WS_VMT), (bf16*)(ws + WS_VMT), (const float*)(ws + WS_SSQ_CKV), 1.f / 128.f};
                run_gemm(lds, wv, Wb + WO_UV, (const bf16*)(ws + WS_CKV), 1024, TH, 256, Ev);
            } else if (k == 2) {
#ifndef DIS_ATTN
                AttnP P{ws, l};
                attn_phase(lds, P, (unsigned*)(ws + WS_CNT) + hb * 2 + l, wv);
#endif
            } else if (k == 3) {
                bf16* G = (bf16*)(ws + WS_G); float* M32 = (float*)(ws + WS_M32); bf16* MG = (bf16*)(ws + WS_MG);
                const size_t GS = (size_t)TH * 1024;
                run_gemm(lds, wv, H, Wb + WO_G, TH, 1024, 1024, EpiAct<0>{G, 1024});
                run_gemm(lds, wv, (const bf16*)(ws + WS_RO), Wb + WO_RO, TH, 1024, 1024, EpiBranch<0>{G, M32, MG});
                run_gemm(lds, wv, H, Wb + WO_G + (size_t)1024 * 1024, TH, 1024, 1024, EpiAct<0>{G + GS, 1024});
                run_gemm(lds, wv, (const bf16*)(ws + WS_DQ), Wb + WO_DO, TH, 1024, 1024, EpiBranch<1>{G + GS, M32, MG});
                run_gemm(lds, wv, H, Wb + WO_G + (size_t)2048 * 1024, TH, 1024, 1024, EpiAct<0>{G + 2 * GS, 1024});
                run_gemm(lds, wv, (const bf16*)(ws + WS_QMN), Wb + WO_MO, TH, 1024, 1024, EpiBranch<2>{G + 2 * GS, M32, MG});
            } else if (k == 4) {
                run_gemm(lds, wv, (const bf16*)(ws + WS_MG), Wb + WO_OUT, TH, 1024, 1024, EpiY{(bf16*)(ws + WS_Y), (float*)(ws + WS_SSQ_Y)});
            } else if (k == 5) {
                resid_rows((l == 0 ? xin0 : (const float*)outp) + xoff, (const bf16*)(ws + WS_Y), (const float*)(ws + WS_SSQ_Y), gains + 2048 + l * DM, outp + xoff, gains + 4096 + l * DM, H, TH, wv);
            } else if (k == 6) {
                run_gemm(lds, wv, H, Wb + WO_UP, TH, DFF, 1024, EpiAct<1>{(bf16*)(ws + WS_U), DFF});
            } else if (k == 7) {
                run_gemm(lds, wv, (const bf16*)(ws + WS_U), Wb + WO_DOWN, TH, 1024, DFF, EpiY{(bf16*)(ws + WS_Y), (float*)(ws + WS_SSQ_Y)});
            } else {
                resid_rows(outp + xoff, (const bf16*)(ws + WS_Y), (const float*)(ws + WS_SSQ_Y), gains + 6144 + l * DM, outp + xoff, l == 0 ? gains + DM : nullptr, H, TH, wv, true);
            }
        }
#if !MK_MULTI
        if (ph + 1 < ph_hi) xcd_barrier((unsigned*)(ws + WS_BAR), lds, wv);
#endif
    }
#ifdef MK_TS
    if (blockIdx.x == 0 && tidx(wv) == 0) {
        unsigned long long* ts = (unsigned long long*)(ws0 + 262144); ts[N_PHASES] = __builtin_amdgcn_s_memrealtime();
        unsigned long long sum = 0;
        for (int q = 1; q < N_PHASES; ++q) { const int k19 = (q - 1) % 19; const int k = k19 == 0 ? 9 : (k19 - 1) % 9; if (MK_TS == k || (MK_TS == 10 && (k == 6 || k == 7)) || (MK_TS == 11 && (k == 5 || k == 8 || k == 9))) sum += ts[q + 1] - ts[q]; }
        outp[0] = (float)sum * (0.01f / 32.f);
    }
#endif
}

extern "C" void kernel_launch(void* const* d_in, const int* in_sizes, int n_in, void* d_out, int out_size, void* d_ws, size_t ws_size, hipStream_t stream) {
    static int grid = 0;
    if (grid == 0) {
        if (n_in != 22 || ws_size < WS_END) { fprintf(stderr, "kernel_launch: unexpected inputs (n_in %d, ws %zu)\n", n_in, ws_size); grid = -1; return; }
        int dev = 0, cus = 0, per_cu = 0;
        hipGetDevice(&dev); hipDeviceGetAttribute(&cus, hipDeviceAttributeMultiprocessorCount, dev);
        if (hipFuncSetAttribute((const void*)mega_fwd, hipFuncAttributeMaxDynamicSharedMemorySize, LDS_BYTES) != hipSuccess) { fprintf(stderr, "kernel_launch: hipFuncSetAttribute failed\n"); grid = -1; return; }
        if (hipOccupancyMaxActiveBlocksPerMultiprocessor(&per_cu, (const void*)mega_fwd, NTHR, LDS_BYTES) != hipSuccess || per_cu < 1) { fprintf(stderr, "kernel_launch: occupancy query gave %d\n", per_cu); per_cu = 1; }
        (void)hipGetLastError();
        grid = cus * per_cu;
        if (grid > 256) grid = 256;
    }
    if (grid < 0) return;
    Params p{};
    const float** pf = (const float**)&p;
    for (int i = 0; i < 22; ++i) pf[i] = (const float*)d_in[i];
    p.out = (float*)d_out; p.ws = (unsigned char*)d_ws;
#if MK_MULTI
#ifdef MK_CHECK
    hipLaunchKernelGGL(chk_clear, dim3(1), dim3(128), 0, stream, (unsigned char*)d_ws);
#endif
    for (int ph = 0; ph < N_PHASES; ++ph) { p.ph_lo = ph; p.ph_hi = ph + 1; hipLaunchKernelGGL(mega_fwd, dim3(grid), dim3(NTHR), LDS_BYTES, stream, p);
#ifdef MK_CHECK
        if (ph >= 1) hipLaunchKernelGGL(chk, dim3(256), dim3(256), 0, stream, p, ph);
#endif
    }
#ifdef MK_CHECK
    hipLaunchKernelGGL(chk_report, dim3(1), dim3(64), 0, stream, (unsigned char*)d_ws, (float*)d_out);
#endif
#else
    p.ph_lo = 0; p.ph_hi = N_PHASES;
    if (hipMemsetAsync((char*)d_ws + WS_BAR, 0, XCD_BAR_WORDS * 4, stream) != hipSuccess) { fprintf(stderr, "kernel_launch: memset of the barrier words failed\n"); return; }
    void* args[] = {&p};
    hipError_t e = hipLaunchCooperativeKernel((const void*)mega_fwd, dim3(grid), dim3(NTHR), args, LDS_BYTES, stream);
    if (e != hipSuccess) fprintf(stderr, "cooperative launch failed: %s (grid %d)\n", hipGetErrorString(e), grid);
#endif
}
```

```cpp
#include <hip/hip_runtime.h>
#include <hip/hip_cooperative_groups.h>
#include <cstdio>
#include <cstdint>
namespace cg = cooperative_groups;
__device__ __forceinline__ int tidx(int wv) { int l; asm volatile("v_mbcnt_lo_u32_b32 %0, -1, 0\n\tv_mbcnt_hi_u32_b32 %0, -1, %0" : "=v"(l)); return (wv << 6) | l; }
namespace pg8 {
#define PG8_LAS __attribute__((address_space(3)))
typedef unsigned short bf16_t;
typedef short bf16x8 __attribute__((ext_vector_type(8)));
typedef float f32x4 __attribute__((ext_vector_type(4)));
typedef unsigned u32x4 __attribute__((ext_vector_type(4)));
constexpr int BM = 256, BK = 64, HALF = 128, HTB = HALF * BK * 2  , STAGE_BYTES = 8 * HTB, NXCD = 8, WGM = 8;

__host__ __device__ __forceinline__ int lds_byte(int r, int c) { const int st = (r >> 4) * 2 + (c >> 5), rr = r & 15, cc = c & 31, ob = rr * 64 + cc * 2; return st * 1024 + (ob ^ (((ob >> 9) & 1) << 5)); }
__host__ __device__ __forceinline__ void stage_rc(int b, int& R, int& C) { const int st = b / 1024, sb = b % 1024, swz = sb ^ (((sb >> 9) & 1) << 5); R = (st >> 1) * 16 + swz / 64; C = (st & 1) * 32 + (swz % 64) / 2; }
__host__ __device__ __forceinline__ int perm32(int rho) { const int n = rho >> 4, i = rho & 15; return 8 * (i >> 2) + 4 * n + (i & 3); }

struct Unit { int pm, pn; };
struct Gemm { const bf16_t* A; const bf16_t* Bt; int M, N, K; };

struct StaticOrder {
    int nM, nN, nwg, G, c, wv;
    __host__ __device__ void init(int M, int N, int G_, int c_) { nM = M / BM; nN = N / BM; nwg = nM * nN; G = G_; c = c_; }
    __host__ __device__ bool next(int i, Unit& u) const {
        const long L = (long)i * G + c; if (L >= nwg) return false;
        int wgid = (int)L; { const int q = nwg / NXCD, r = nwg % NXCD, xcd = wgid % NXCD, off = wgid / NXCD; wgid = (xcd < r ? xcd * (q + 1) : r * (q + 1) + (xcd - r) * q) + off; }
        const int nig = WGM * nN, gid = wgid / nig, fm = gid * WGM, gsz = (nM - fm) < WGM ? (nM - fm) : WGM;
        u.pm = fm + ((wgid % nig) % gsz); u.pn = (wgid % nig) / gsz; return true;
    }
    __device__ __forceinline__ void a_ready(const Unit&) const {}
    __device__ __forceinline__ void done(const Unit&) const {}
};

__device__ __forceinline__ unsigned cvt_pk_bf16(float lo, float hi) { unsigned r; asm volatile("v_cvt_pk_bf16_f32 %0, %1, %2" : "=v"(r) : "v"(lo), "v"(hi)); return r; }
template <class Epi, class Sched, bool ALIGN_EPI = false, bool SP2 = false>
__device__ __forceinline__ void gemm_phase(PG8_LAS unsigned char* lds, const Gemm g, const Sched& S, const Epi& E) {
    const int tid = tidx(S.wv), wid = __builtin_amdgcn_readfirstlane(tid >> 6), lane = tid & 63, wr = wid >> 2, wc = wid & 3, fr = lane & 15, fq = lane >> 4;
    const int K = g.K, nt = K / BK;
    unsigned voffA[2], voffB[2];
#pragma unroll
    for (int i = 0; i < 2; ++i) { int R, C; stage_rc(tid * 16 + i * 8192, R, C); const int Rb = Epi::PERM ? ((R & ~31) + perm32(R & 31)) : R;
        voffA[i] = (unsigned)(R * K + C) * 2u; voffB[i] = (unsigned)(Rb * K + C) * 2u; }
    const size_t kstep = (size_t)(BK * 2);
    const size_t hstep = (size_t)HALF * K * 2;
    const size_t tstep = 2 * hstep;
    const unsigned ldsw = (unsigned)wid * 1024u;
    const int aoff = lds_byte(wr * 64 + fr, fq * 8), boff = lds_byte(wc * 32 + fr, fq * 8);
#define PG8_SA(b, h) (((b) * 2 + (h)) * HTB)
#define PG8_SB(b, h) ((4 + (b) * 2 + (h)) * HTB)
#define PG8_STAGE(bufoff, gbase, voff) do { _Pragma("unroll") for (int _i = 0; _i < 2; ++_i) \
        __builtin_amdgcn_global_load_lds((const unsigned*)((const char*)(gbase) + (voff)[_i]), (PG8_LAS unsigned*)(lds + (bufoff) + ldsw + _i * 8192), 16, 0, 0); } while (0)
#define PG8_LDA(dst, b, h) do { _Pragma("unroll") for (int m = 0; m < 4; ++m) _Pragma("unroll") for (int k = 0; k < 2; ++k) dst[m][k] = *(const PG8_LAS bf16x8*)(lds + PG8_SA(b, h) + aoff + m * 2048 + k * 1024); } while (0)
#define PG8_LDB(dst, b, h) do { _Pragma("unroll") for (int n = 0; n < 2; ++n) _Pragma("unroll") for (int k = 0; k < 2; ++k) dst[n][k] = *(const PG8_LAS bf16x8*)(lds + PG8_SB(b, h) + boff + n * 2048 + k * 1024); } while (0)
#define PG8_MMA(ai, bj, At, Bt) do { __builtin_amdgcn_s_setprio(1); _Pragma("unroll") for (int m = 0; m < 4; ++m) _Pragma("unroll") for (int n = 0; n < 2; ++n) _Pragma("unroll") for (int k = 0; k < 2; ++k) \
        acc[ai][bj][m][n] = __builtin_amdgcn_mfma_f32_16x16x32_bf16(Bt[n][k], At[m][k], acc[ai][bj][m][n], 0, 0, 0); __builtin_amdgcn_s_setprio(0); } while (0)
#define PG8_WAIT_V(n) asm volatile("s_waitcnt vmcnt(" #n ")" ::: "memory")
#define PG8_WAIT_L(n) asm volatile("s_waitcnt lgkmcnt(" #n ")" ::: "memory")
#define PG8_BAR __builtin_amdgcn_s_barrier()
#define PG8_SCHED __builtin_amdgcn_sched_barrier(0)
    Unit cur, nxt; int ui = 0;
    if (!S.next(0, cur)) return;
    f32x4 acc[2][2][4][2];
#pragma unroll
    for (int a = 0; a < 2; ++a)
#pragma unroll
        for (int b = 0; b < 2; ++b)
#pragma unroll
            for (int m = 0; m < 4; ++m)
#pragma unroll
                for (int n = 0; n < 2; ++n) acc[a][b][m][n] = (f32x4){0.f, 0.f, 0.f, 0.f};
    bf16x8 At[4][2], B0[2][2], B1[2][2];
    const char* cA = (const char*)g.A + (size_t)cur.pm * tstep; const char* cB = (const char*)g.Bt + (size_t)cur.pn * tstep;
    S.a_ready(cur);
    if constexpr (SP2) {
        PG8_STAGE(PG8_SB(0, 0), cB, voffB); PG8_STAGE(PG8_SB(0, 1), cB + hstep, voffB); PG8_STAGE(PG8_SA(0, 0), cA, voffA); PG8_STAGE(PG8_SA(0, 1), cA + hstep, voffA);
        if (wr == 1) PG8_BAR;
        PG8_WAIT_V(2); PG8_BAR;
        PG8_STAGE(PG8_SB(1, 0), cB + kstep, voffB); PG8_STAGE(PG8_SA(1, 0), cA + kstep, voffA); PG8_STAGE(PG8_SB(1, 1), cB + hstep + kstep, voffB);
        PG8_WAIT_V(6); PG8_BAR;
    } else {
        PG8_STAGE(PG8_SB(0, 0), cB, voffB); PG8_STAGE(PG8_SA(0, 0), cA, voffA); PG8_STAGE(PG8_SB(0, 1), cB + hstep, voffB); PG8_STAGE(PG8_SA(0, 1), cA + hstep, voffA);
        if (wr == 1) PG8_BAR;
        PG8_WAIT_V(4); PG8_BAR;
        PG8_STAGE(PG8_SB(1, 0), cB + kstep, voffB); PG8_STAGE(PG8_SA(1, 0), cA + kstep, voffA); PG8_STAGE(PG8_SB(1, 1), cB + hstep + kstep, voffB);
        PG8_WAIT_V(6); PG8_BAR;
    }
    for (;;) {
        const bool has_next = S.next(ui + 1, nxt);
        const char* nA = has_next ? (const char*)g.A + (size_t)nxt.pm * tstep : cA; const char* nB = has_next ? (const char*)g.Bt + (size_t)nxt.pn * tstep : cB;
        for (int t = 0; t < nt; t += 2) {
            const bool last = (t == nt - 2);
            const char* a1 = cA + (size_t)(t + 1) * kstep;
            const char* a2 = last ? nA : cA + (size_t)(t + 2) * kstep; const char* b2 = last ? nB : cB + (size_t)(t + 2) * kstep;
            const char* a3 = a2 + kstep; const char* b3 = b2 + kstep;
            if (last && has_next) S.a_ready(nxt);
            if constexpr (SP2) {
            PG8_LDB(B0, 0, 0); PG8_LDB(B1, 0, 1); PG8_SCHED; PG8_LDA(At, 0, 0); PG8_STAGE(PG8_SA(1, 1), a1 + hstep, voffA);
            PG8_WAIT_V(8); PG8_WAIT_L(0); PG8_BAR; PG8_MMA(0, 0, At, B0); PG8_MMA(0, 1, At, B1); PG8_BAR; PG8_SCHED;
            PG8_LDA(At, 0, 1); PG8_STAGE(PG8_SB(0, 0), b2, voffB); PG8_STAGE(PG8_SB(0, 1), b2 + hstep, voffB); PG8_STAGE(PG8_SA(0, 0), a2, voffA);
            PG8_WAIT_V(8); PG8_WAIT_L(0); PG8_BAR; PG8_MMA(1, 0, At, B0); PG8_MMA(1, 1, At, B1); PG8_BAR; PG8_SCHED;
            PG8_LDB(B0, 1, 0); PG8_LDB(B1, 1, 1); PG8_SCHED; PG8_LDA(At, 1, 0); PG8_STAGE(PG8_SA(0, 1), a2 + hstep, voffA);
            PG8_WAIT_V(8); PG8_WAIT_L(0); PG8_BAR; PG8_MMA(0, 0, At, B0); PG8_MMA(0, 1, At, B1); PG8_BAR; PG8_SCHED;
            PG8_LDA(At, 1, 1); PG8_STAGE(PG8_SB(1, 0), b3, voffB); PG8_STAGE(PG8_SB(1, 1), b3 + hstep, voffB); PG8_STAGE(PG8_SA(1, 0), a3, voffA);
            PG8_WAIT_V(8); PG8_WAIT_L(0); PG8_BAR; PG8_MMA(1, 0, At, B0); PG8_MMA(1, 1, At, B1); PG8_BAR; PG8_SCHED;
            } else {
            PG8_LDB(B0, 0, 0); PG8_SCHED; PG8_LDA(At, 0, 0); PG8_STAGE(PG8_SA(1, 1), a1 + hstep, voffA);
            PG8_WAIT_L(8); PG8_BAR; PG8_WAIT_L(0); PG8_MMA(0, 0, At, B0); PG8_BAR; PG8_SCHED;
            PG8_LDB(B1, 0, 1); PG8_STAGE(PG8_SB(0, 0), b2, voffB);
            PG8_BAR; PG8_WAIT_L(0); PG8_MMA(0, 1, At, B1); PG8_BAR;
            PG8_LDA(At, 0, 1); PG8_STAGE(PG8_SA(0, 0), a2, voffA);
            PG8_BAR; PG8_WAIT_L(0); PG8_MMA(1, 0, At, B0); PG8_BAR; PG8_SCHED;
            PG8_STAGE(PG8_SB(0, 1), b2 + hstep, voffB);
            PG8_WAIT_V(6); PG8_BAR; PG8_MMA(1, 1, At, B1); PG8_BAR;
            PG8_LDB(B0, 1, 0); PG8_SCHED; PG8_LDA(At, 1, 0); PG8_STAGE(PG8_SA(0, 1), a2 + hstep, voffA);
            PG8_WAIT_L(8); PG8_BAR; PG8_WAIT_L(0); PG8_MMA(0, 0, At, B0); PG8_BAR; PG8_SCHED;
            PG8_LDB(B1, 1, 1); PG8_STAGE(PG8_SB(1, 0), b3, voffB);
            PG8_BAR; PG8_WAIT_L(0); PG8_MMA(0, 1, At, B1); PG8_BAR;
            PG8_LDA(At, 1, 1); PG8_STAGE(PG8_SA(1, 0), a3, voffA);
            PG8_BAR; PG8_WAIT_L(0); PG8_MMA(1, 0, At, B0); PG8_BAR; PG8_SCHED;
            PG8_STAGE(PG8_SB(1, 1), b3 + hstep, voffB);
            PG8_WAIT_V(6); PG8_BAR; PG8_MMA(1, 1, At, B1); PG8_BAR;
            }
        }
        if constexpr (ALIGN_EPI) { if (wr == 0) PG8_BAR; }
        if constexpr (!Epi::AFTER_DRAIN) { E(acc, cur, wr, wc, fr, fq); S.done(cur); }
        if (!has_next) break;
#pragma unroll
        for (int a = 0; a < 2; ++a)
#pragma unroll
            for (int b = 0; b < 2; ++b)
#pragma unroll
                for (int m = 0; m < 4; ++m)
#pragma unroll
                    for (int n = 0; n < 2; ++n) acc[a][b][m][n] = (f32x4){0.f, 0.f, 0.f, 0.f};
        cur = nxt; cA = nA; cB = nB; ++ui;
        if constexpr (ALIGN_EPI) { if (wr == 1) PG8_BAR; }
    }
    PG8_WAIT_V(0);
    if constexpr (!ALIGN_EPI) { if (wr == 0) PG8_BAR; }
    PG8_BAR;
    if constexpr (Epi::AFTER_DRAIN) { E.fused(acc, cur, wr, wc, fr, fq, lds, wid, lane); S.done(cur); }
#undef PG8_SA
#undef PG8_SB
#undef PG8_STAGE
#undef PG8_LDA
#undef PG8_LDB
#undef PG8_MMA
#undef PG8_WAIT_V
#undef PG8_WAIT_L
#undef PG8_BAR
#undef PG8_SCHED
}
}


#ifndef MK_MULTI
#define MK_MULTI 0
#endif
#define DI __device__ __forceinline__
#define LAS __attribute__((address_space(3)))
typedef unsigned short bf16;
typedef short bf16x8 __attribute__((ext_vector_type(8)));
typedef float f32x4 __attribute__((ext_vector_type(4)));
typedef float f32x16 __attribute__((ext_vector_type(16)));
typedef unsigned u32x4 __attribute__((ext_vector_type(4)));
typedef unsigned u32x2 __attribute__((ext_vector_type(2)));
typedef float f32x2_t __attribute__((ext_vector_type(2)));
typedef __bf16 bf16x2_t __attribute__((ext_vector_type(2)));
typedef LAS unsigned char* lptr;


constexpr int SEQ = 2048, DM = 1024, TH = 16384  , DFF = 4096, DIN = 9632;
constexpr float EPS = 1e-6f, LOG2E = 1.4426950408889634f;
constexpr float QSC_DIFF = 0.125f * LOG2E;
constexpr float QSC_MLA = 0.10206207261596575f * LOG2E;
constexpr float KSC_RET = 0.08838834764831845f;
constexpr int NTHR = 512;
constexpr int LDS_BYTES = 147456;

constexpr size_t MiB = 1u << 20;
constexpr size_t WS_CNT = 0, WS_LAM = 256, WS_BIAS = 1024, WS_GAIN = 65536;
constexpr size_t WS_SUBG = WS_GAIN + 4 * 2 * 1024 * 4;
constexpr size_t WS_RCOS = 1 * MiB, WS_RSIN = WS_RCOS + 512 * 1024, WS_MCOS = 2 * MiB, WS_MSIN = WS_MCOS + 128 * 1024;
constexpr size_t WS_W = 4 * MiB;
constexpr size_t WO_IN1 = 0, WO_V = WO_IN1 + 4608 * 1024, WO_G = WO_V + 2048 * 1024, WO_UQ = WO_G + 3072 * 1024, WO_UK = WO_UQ + 1536 * 256,
                 WO_UV = WO_UK + 1024 * 256, WO_RO = WO_UV + 1024 * 256, WO_DO = WO_RO + 1024 * 1024, WO_MO = WO_DO + 1024 * 1024, WO_OUT = WO_MO + 1024 * 1024,
                 WO_UP = WO_OUT + 1024 * 1024, WO_DOWN = WO_UP + 4096 * 1024, WO_END = WO_DOWN + 4096 * 1024;
static_assert(WS_W + 2 * WO_END * 2 <= 96 * MiB, "weights fit");
constexpr size_t WS_H = 96 * MiB;
constexpr size_t WS_RQ = 128 * MiB, WS_RK = 144 * MiB, WS_RVT = 160 * MiB, WS_RG = 192 * MiB, WS_G = 128 * MiB;
constexpr size_t WS_DQ = 224 * MiB, WS_DK = 256 * MiB, WS_DVT = 288 * MiB, WS_M32 = 256 * MiB;
constexpr size_t WS_CQ = 320 * MiB, WS_CKV = 328 * MiB  , WS_KPE = 336 * MiB, WS_SSQ_CQ = 337 * MiB, WS_SSQ_CKV = WS_SSQ_CQ + 256 * 1024;
constexpr size_t WS_QMN = 338 * MiB, WS_QMP = 370 * MiB, WS_KMN = 386 * MiB, WS_VMT = 418 * MiB, WS_RO = 450 * MiB;
constexpr size_t WS_MG = 370 * MiB, WS_Y = 402 * MiB, WS_SSQ_Y = 434 * MiB, WS_U = 128 * MiB, WS_END = 482 * MiB;

struct Params {
    const float *x, *rel_bias, *pre_mix_g, *w_in, *w_ret_o, *lq1, *lk1, *lq2, *lk2, *subln_g, *w_diff_o, *q_norm_g, *w_uq, *kv_norm_g, *w_ukv, *w_mla_o,
                *w_out, *post_mix_g, *pre_mlp_g, *w_up, *w_down, *post_mlp_g;
    float* out; unsigned char* ws; int ph_lo, ph_hi;
};

DI unsigned cvtpk(float lo, float hi) { f32x2_t v = {lo, hi}; bf16x2_t b = __builtin_convertvector(v, bf16x2_t); return __builtin_bit_cast(unsigned, b); }
DI u32x4 pack8(f32x4 a, f32x4 b) { u32x4 w; w.x = cvtpk(a[0], a[1]); w.y = cvtpk(a[2], a[3]); w.z = cvtpk(b[0], b[1]); w.w = cvtpk(b[2], b[3]); return w; }
DI float bflo(unsigned u) { return __uint_as_float(u << 16); }
DI float bfhi(unsigned u) { return __uint_as_float(u & 0xffff0000u); }
DI void unpack8(u32x4 w, f32x4& a, f32x4& b) { a = (f32x4){bflo(w.x), bfhi(w.x), bflo(w.y), bfhi(w.y)}; b = (f32x4){bflo(w.z), bfhi(w.z), bflo(w.w), bfhi(w.w)}; }
DI float ex2(float x) { return __builtin_amdgcn_exp2f(x); }
DI float sigm(float x) { return __builtin_amdgcn_rcpf(1.f + ex2(-x * LOG2E)); }
DI float shx(float v, int m, int lane) { return __int_as_float(__builtin_amdgcn_ds_bpermute((lane ^ m) << 2, __float_as_int(v))); }
DI float wave_sum(float v, int lane) {
#pragma unroll
    for (int o = 1; o < 64; o <<= 1) v += shx(v, o, lane);
    return v;
}
DI float sq4(f32x4 v) { return (v[0] * v[0] + v[1] * v[1]) + (v[2] * v[2] + v[3] * v[3]); }

DI int colmap(int map, int n, int off) {
    switch (map) {
        case 0: return off + n;
        case 1: { const int p = n & 127, bj = (n >> 7) & 1; return off + (n & ~255) + (p >> 6) * 128 + bj * 64 + (p & 63); }
        case 2: { if (n < 128) return 6400 + n; if (n >= 160) return -1; const int q = n - 128; return 6528 + 16 * ((q >> 2) & 1) + 4 * (q >> 3) + (q & 3); }
        case 3: { if (n < 1024) return (n >> 6) * 96 + (n & 63); const int q = n - 1024, hh = q >> 5, pos = q & 31; return hh * 96 + 64 + 16 * ((pos >> 2) & 1) + 4 * (pos >> 3) + (pos & 3); }
        case 4: return (n >> 6) * 128 + (n & 63);
        default: return (n >> 6) * 128 + 64 + (n & 63);
    }
}
DI void conv_item(const float* W, int ldw, int K, int kvalid, bf16* WT, int map, int off, const float* gs, LAS float* scr, int item, int nblk, int lane) {
    const int kb = item / nblk, nb = item % nblk, k0 = 64 * kb, n0 = 32 * nb;
    const int oc = colmap(map, n0 + (lane & 31), off);
#pragma unroll 8
    for (int i = 0; i < 32; ++i) { const int kk = 2 * i + (lane >> 5); float v = 0.f; if (oc >= 0 && k0 + kk < kvalid) { v = W[(size_t)(k0 + kk) * ldw + oc]; if (gs) v *= gs[k0 + kk]; } scr[kk * 33 + (lane & 31)] = v; }
    asm volatile("s_waitcnt lgkmcnt(0)" ::: "memory");
    const int c = lane & 7;
#pragma unroll
    for (int j = 0; j < 4; ++j) { const int n = (lane >> 3) + 8 * j; const LAS float* s = scr + (8 * c) * 33 + n;
        u32x4 o; o.x = cvtpk(s[0 * 33], s[1 * 33]); o.y = cvtpk(s[2 * 33], s[3 * 33]); o.z = cvtpk(s[4 * 33], s[5 * 33]); o.w = cvtpk(s[6 * 33], s[7 * 33]);
        *(u32x4*)(WT + (size_t)(n0 + n) * K + k0 + 8 * c) = o; }
    asm volatile("s_waitcnt lgkmcnt(0)" ::: "memory");
}
DI int t5_bucket(int n) {
    if (n < 16) return n;
    int large = 16 + (int)(logf((float)n / 16.f) / 2.0794415416798357f * 16.f);
    return large < 31 ? large : 31;
}
DI void prologue(const Params& p, lptr lds, int wv) {
    const int tid = tidx(wv), lane = tid & 63, wave = tid >> 6;
    const int gw = blockIdx.x * 8 + wave, NGW = gridDim.x * 8, gt = blockIdx.x * NTHR + tid, NGT = gridDim.x * NTHR;
    unsigned char* ws = p.ws;
    if (blockIdx.x == 0) {
        if (tid < 16) ((unsigned*)(ws + WS_CNT))[tid] = 0u;
        if (tid >= 64 && tid < 66) {
            const int l = tid - 64; float a = 0.f, b = 0.f;
            for (int i = 0; i < 64; ++i) { a += p.lq1[l * 64 + i] * p.lk1[l * 64 + i]; b += p.lq2[l * 64 + i] * p.lk2[l * 64 + i]; }
            const float linit = 0.8f - 0.6f * expf(-0.3f * (float)l);
            ((float*)(ws + WS_LAM))[l] = expf(a) - expf(b) + linit; ((float*)(ws + WS_LAM))[2 + l] = 1.f - linit;
        }
    }
    for (int i = gt; i < 2048; i += NGT) { float* gd = (float*)(ws + WS_GAIN); gd[i] = p.pre_mix_g[i]; gd[2048 + i] = p.post_mix_g[i]; gd[4096 + i] = p.pre_mlp_g[i]; gd[6144 + i] = p.post_mlp_g[i]; if (i < 256) ((float*)(ws + WS_SUBG))[i] = p.subln_g[i]; }
    for (int i = gt; i < 8 * 128; i += NGT) { const int hh = i >> 7, n = i & 127; ((float*)(ws + WS_BIAS))[i] = p.rel_bias[t5_bucket(n) * 8 + hh] * LOG2E; }
    for (int i = gt; i < SEQ * 64; i += NGT) { const int s = i >> 6, d = i & 63; const float inv = (float)(1.0 / pow(10000.0, (double)d / 63.0)); const float ang = (float)s * inv;
        ((float*)(ws + WS_RCOS))[i] = (float)cos((double)ang); ((float*)(ws + WS_RSIN))[i] = (float)sin((double)ang); }
    for (int i = gt; i < SEQ * 16; i += NGT) { const int s = i >> 4, d = i & 15; const float inv = (float)(1.0 / pow(10000.0, (double)(2 * d) / 32.0)); const float ang = (float)s * inv;
        ((float*)(ws + WS_MCOS))[i] = (float)cos((double)ang); ((float*)(ws + WS_MSIN))[i] = (float)sin((double)ang); }
    LAS float* scr = (LAS float*)(lds + wave * 16384);
    for (int l = 0; l < 2; ++l) {
        bf16* Wb = (bf16*)(ws + WS_W) + (size_t)l * WO_END;
        const float* win = p.w_in + (size_t)l * DM * DIN;
        for (int job = 0; job < 19; ++job) {
            const float* src = win; int ldw = DIN, K = 1024, kvalid = 4096, ns = 1024, map = 0, off = 0; const float* gs = nullptr; bf16* dst = Wb;
            switch (job) {
                case 0: ns = 512; map = 1; off = 0; dst = Wb + WO_IN1; break;
                case 1: ns = 512; map = 1; off = 512; dst = Wb + WO_IN1 + (size_t)512 * 1024; break;
                case 2: off = 2048; dst = Wb + WO_IN1 + (size_t)1024 * 1024; break;
                case 3: off = 3072; dst = Wb + WO_IN1 + (size_t)2048 * 1024; break;
                case 4: off = 4096; dst = Wb + WO_IN1 + (size_t)3072 * 1024; break;
                case 5: ns = 256; off = 6144; dst = Wb + WO_IN1 + (size_t)4096 * 1024; break;
                case 6: ns = 256; map = 2; dst = Wb + WO_IN1 + (size_t)4352 * 1024; break;
                case 7: off = 1024; dst = Wb + WO_V; break;
                case 8: off = 5120; dst = Wb + WO_V + (size_t)1024 * 1024; break;
                case 9: ns = 3072; off = 6560; dst = Wb + WO_G; break;
                case 10: src = p.w_uq + (size_t)l * 256 * 1536; ldw = 1536; K = 256; ns = 1536; map = 3; gs = p.q_norm_g + l * 256; dst = Wb + WO_UQ; break;
                case 11: src = p.w_ukv + (size_t)l * 128 * 2048; ldw = 2048; K = 256; kvalid = 128; map = 4; gs = p.kv_norm_g + l * 128; dst = Wb + WO_UK; break;
                case 12: src = p.w_ukv + (size_t)l * 128 * 2048; ldw = 2048; K = 256; kvalid = 128; map = 5; gs = p.kv_norm_g + l * 128; dst = Wb + WO_UV; break;
                case 13: src = p.w_ret_o + (size_t)l * 1024 * 1024; ldw = 1024; dst = Wb + WO_RO; break;
                case 14: src = p.w_diff_o + (size_t)l * 1024 * 1024; ldw = 1024; dst = Wb + WO_DO; break;
                case 15: src = p.w_mla_o + (size_t)l * 1024 * 1024; ldw = 1024; dst = Wb + WO_MO; break;
                case 16: src = p.w_out + (size_t)l * 1024 * 1024; ldw = 1024; dst = Wb + WO_OUT; break;
                case 17: src = p.w_up + (size_t)l * 1024 * 4096; ldw = 4096; ns = 4096; dst = Wb + WO_UP; break;
                default: src = p.w_down + (size_t)l * 4096 * 1024; ldw = 1024; K = 4096; dst = Wb + WO_DOWN; break;
            }
            const int nblk = ns / 32, items = (K / 64) * nblk;
            for (int it = gw; it < items; it += NGW) conv_item(src, ldw, K, kvalid, dst, map, off, gs, scr, it, nblk, lane);
        }
    }
}

DI void norm_rows(const float* x, const float* g, bf16* o, int rows, int wv) {
    const int tid_ = tidx(wv); const int lane = tid_ & 63, gw = blockIdx.x * 8 + (tid_ >> 6), NGW = gridDim.x * 8;
    for (int m = gw; m < rows; m += NGW) {
        const f32x4* xr = (const f32x4*)(x + (size_t)m * DM) + lane; f32x4 v[4]; float s = 0.f;
#pragma unroll
        for (int j = 0; j < 4; ++j) { v[j] = xr[64 * j]; s += sq4(v[j]); }
        const float rs = 1.0f / sqrtf(wave_sum(s, lane) * (1.f / DM) + EPS);
        u32x2* o8 = (u32x2*)(o + (size_t)m * DM) + lane;
#pragma unroll
        for (int j = 0; j < 4; ++j) { const f32x4 gg = ((const f32x4*)g)[lane + 64 * j]; u32x2 w; w.x = cvtpk(v[j][0] * rs * gg[0], v[j][1] * rs * gg[1]); w.y = cvtpk(v[j][2] * rs * gg[2], v[j][3] * rs * gg[3]); o8[64 * j] = w; }
    }
}
DI void resid_rows(const float* xin, const bf16* y, const float* ssq, const float* gpost, float* xout, const float* gnext, bf16* hout, int rows, int wv, bool ablate = false) {
    const int tid_ = tidx(wv); const int lane = tid_ & 63, gw = blockIdx.x * 8 + (tid_ >> 6), NGW = gridDim.x * 8;
    for (int m = gw; m < rows; m += NGW) {
        const float part = lane < 16 ? ssq[(size_t)m * 16 + lane] : 0.f;
        float rs = 1.0f / sqrtf(wave_sum(part, lane) * (1.f / DM) + EPS);
#ifdef ABL_MLP
        if (!gnext || gnext == (const float*)0 + 1) rs = rs; if (ablate) rs = 0.f;
#endif
        const f32x4* xr = (const f32x4*)(xin + (size_t)m * DM) + lane; const u32x2* yr = (const u32x2*)(y + (size_t)m * DM) + lane; f32x4* xo = (f32x4*)(xout + (size_t)m * DM) + lane;
        f32x4 v[4]; float s = 0.f;
#pragma unroll
        for (int j = 0; j < 4; ++j) { const f32x4 xv = xr[64 * j]; const u32x2 yw = yr[64 * j]; const f32x4 gg = ((const f32x4*)gpost)[lane + 64 * j];
            f32x4 yv = (f32x4){bflo(yw.x), bfhi(yw.x), bflo(yw.y), bfhi(yw.y)};
            v[j] = xv + yv * rs * gg; xo[64 * j] = v[j]; s += sq4(v[j]); }
        if (gnext) {
            const float rs2 = 1.0f / sqrtf(wave_sum(s, lane) * (1.f / DM) + EPS);
            u32x2* o8 = (u32x2*)(hout + (size_t)m * DM) + lane;
#pragma unroll
            for (int j = 0; j < 4; ++j) { const f32x4 gg = ((const f32x4*)gnext)[lane + 64 * j]; u32x2 w; w.x = cvtpk(v[j][0] * rs2 * gg[0], v[j][1] * rs2 * gg[1]); w.y = cvtpk(v[j][2] * rs2 * gg[2], v[j][3] * rs2 * gg[3]); o8[64 * j] = w; }
        }
    }
}

#define EPI_ARGS const f32x4 (&acc)[2][2][4][2], const pg8::Unit& u, int wr, int wc, int fr, int fq
#define FOR_AI_M _Pragma("unroll") for (int ai = 0; ai < 2; ++ai) _Pragma("unroll") for (int m = 0; m < 4; ++m)
#define FOR_BJ _Pragma("unroll") for (int bj = 0; bj < 2; ++bj)

struct EpiIn1 {
    static constexpr bool PERM = true, AFTER_DRAIN = false;
    unsigned char* ws;
    DI void operator()(EPI_ARGS) const {
        asm volatile("" : "+v"(fr), "+v"(fq));
        bf16 *RQ = (bf16*)(ws + WS_RQ), *RK = (bf16*)(ws + WS_RK), *RG = (bf16*)(ws + WS_RG), *DQ = (bf16*)(ws + WS_DQ), *DK = (bf16*)(ws + WS_DK), *CQ = (bf16*)(ws + WS_CQ), *CKV = (bf16*)(ws + WS_CKV), *KPE = (bf16*)(ws + WS_KPE);
        float *SSQ_CQ = (float*)(ws + WS_SSQ_CQ), *SSQ_CKV = (float*)(ws + WS_SSQ_CKV);
        const float *rcos = (const float*)(ws + WS_RCOS), *rsin = (const float*)(ws + WS_RSIN), *mcos = (const float*)(ws + WS_MCOS), *msin = (const float*)(ws + WS_MSIN);
        const int pn = u.pn, row0 = u.pm * 256 + wr * 64 + fr, c8 = wc * 32 + 8 * fq;
        if (pn < 4) {
            bf16* dst = pn < 2 ? RQ : RK; const int head = 2 * (pn & 1) + (wc >> 1), d0 = c8 & 63;
            const float l2g = log2f(1.f - ex2(-5.f - (float)head)), l2s = pn < 2 ? l2g : -l2g, sc0 = pn < 2 ? 1.f : KSC_RET;
            FOR_AI_M { const int t = row0 + ai * 128 + m * 16, s = t & (SEQ - 1); const float sc = sc0 * ex2(l2s * (float)(s & 63));
                const f32x4 c0 = *(const f32x4*)(rcos + s * 64 + d0), c1 = *(const f32x4*)(rcos + s * 64 + d0 + 4), s0 = *(const f32x4*)(rsin + s * 64 + d0), s1 = *(const f32x4*)(rsin + s * 64 + d0 + 4);
                const f32x4 x1a = acc[ai][0][m][0], x1b = acc[ai][0][m][1], x2a = acc[ai][1][m][0], x2b = acc[ai][1][m][1];
                bf16* o = dst + (size_t)t * 512 + head * 128 + d0;
                *(u32x4*)o = pack8((x1a * c0 - x2a * s0) * sc, (x1b * c1 - x2b * s1) * sc);
                *(u32x4*)(o + 64) = pack8((x2a * c0 + x1a * s0) * sc, (x2b * c1 + x1b * s1) * sc); asm volatile("" ::: "memory"); }
        } else if (pn < 16) {
            const int seg = (pn - 4) >> 2; bf16* dst = seg == 0 ? RG : (seg == 1 ? DQ : DK); const int colb = ((pn - 4) & 3) * 256 + c8;
            FOR_AI_M { const int t = row0 + ai * 128 + m * 16;
                FOR_BJ { f32x4 v0 = acc[ai][bj][m][0], v1 = acc[ai][bj][m][1];
                    if (seg == 0) {
#pragma unroll
                        for (int i = 0; i < 4; ++i) { v0[i] = v0[i] * sigm(v0[i]); v1[i] = v1[i] * sigm(v1[i]); } }
                    else if (seg == 1) { v0 = v0 * QSC_DIFF; v1 = v1 * QSC_DIFF; }
                    *(u32x4*)(dst + (size_t)t * 1024 + colb + bj * 128) = pack8(v0, v1); } }
        } else if (pn == 16) {
            FOR_AI_M { const int t = row0 + ai * 128 + m * 16; float ss = 0.f;
                FOR_BJ { const f32x4 v0 = acc[ai][bj][m][0], v1 = acc[ai][bj][m][1]; ss += sq4(v0) + sq4(v1); *(u32x4*)(CQ + (size_t)t * 256 + c8 + bj * 128) = pack8(v0, v1); }
                ss += shx(ss, 16, fq * 16 + fr); ss += shx(ss, 32, fq * 16 + fr);
                if (fq == 0) SSQ_CQ[(size_t)t * 4 + wc] = ss; }
        } else {
            FOR_AI_M { const int t = row0 + ai * 128 + m * 16, s = t & (SEQ - 1);
                const f32x4 v0 = acc[ai][0][m][0], v1 = acc[ai][0][m][1]; float ss = sq4(v0) + sq4(v1);
                *(u32x4*)(CKV + (size_t)t * 256 + c8) = pack8(v0, v1); *(u32x4*)(CKV + (size_t)t * 256 + 128 + c8) = pack8(acc[ai][1][m][0], acc[ai][1][m][1]);
                ss += shx(ss, 16, fq * 16 + fr); ss += shx(ss, 32, fq * 16 + fr);
                if (fq == 0) SSQ_CKV[(size_t)t * 4 + wc] = ss;
                if (wc == 0) { const f32x4 x1 = acc[ai][1][m][0], x2 = acc[ai][1][m][1]; const f32x4 c = *(const f32x4*)(mcos + s * 16 + 4 * fq), sn = *(const f32x4*)(msin + s * 16 + 4 * fq);
                    const f32x4 o1 = x1 * c - x2 * sn, o2 = x2 * c + x1 * sn; u32x2 w1, w2; w1.x = cvtpk(o1[0], o1[1]); w1.y = cvtpk(o1[2], o1[3]); w2.x = cvtpk(o2[0], o2[1]); w2.y = cvtpk(o2[2], o2[3]);
                    *(u32x2*)(KPE + (size_t)t * 32 + 4 * fq) = w1; *(u32x2*)(KPE + (size_t)t * 32 + 16 + 4 * fq) = w2; } }
        }
    }
};
struct EpiVt {
    static constexpr bool PERM = true, AFTER_DRAIN = false;
    bf16 *T0, *T1; const float* ssq; float inv_n;
    DI void operator()(EPI_ARGS) const {
        asm volatile("" : "+v"(fr), "+v"(fq));
        const int b = u.pn >> 3, s0 = (u.pn & 7) * 256 + wc * 32 + 8 * fq;
        float rs[2][8];
        FOR_BJ {
#pragma unroll
            for (int k = 0; k < 8; ++k) { rs[bj][k] = 1.f; if (ssq) { const f32x4 q = *(const f32x4*)(ssq + (size_t)(b * SEQ + s0 + bj * 128 + k) * 4); rs[bj][k] = 1.0f / sqrtf(((q[0] + q[1]) + (q[2] + q[3])) * inv_n + EPS); } } }
        FOR_AI_M { const int R = u.pm * 256 + ai * 128 + wr * 64 + m * 16 + fr;
            bf16* rowp = (R < 1024 ? T0 + (size_t)(b * 1024 + R) * SEQ : T1 + (size_t)(b * 1024 + R - 1024) * SEQ) + s0;
            FOR_BJ { f32x4 v0 = acc[ai][bj][m][0], v1 = acc[ai][bj][m][1];
#pragma unroll
                for (int i = 0; i < 4; ++i) { v0[i] *= rs[bj][i]; v1[i] *= rs[bj][4 + i]; }
                *(u32x4*)(rowp + bj * 128) = pack8(v0, v1); } }
    }
};
struct EpiUq {
    static constexpr bool PERM = true, AFTER_DRAIN = false;
    bf16 *QMn, *QMp; const float *ssq, *mcos, *msin; int wv;
    DI void operator()(EPI_ARGS) const {
        { const int t_ = tidx(wv); fr = t_ & 15; fq = (t_ >> 4) & 3; }
        const int pn = u.pn, row0 = u.pm * 256 + wr * 64 + fr, c8 = wc * 32 + 8 * fq;
        FOR_AI_M { const int t = row0 + ai * 128 + m * 16, s = t & (SEQ - 1);
            const f32x4 q = *(const f32x4*)(ssq + (size_t)t * 4); const float rs = QSC_MLA / sqrtf(((q[0] + q[1]) + (q[2] + q[3])) * (1.f / 256.f) + EPS);
            if (pn < 4) { FOR_BJ { *(u32x4*)(QMn + (size_t)t * 1024 + pn * 256 + bj * 128 + c8) = pack8(acc[ai][bj][m][0] * rs, acc[ai][bj][m][1] * rs); } }
            else { const f32x4 c = *(const f32x4*)(mcos + s * 16 + 4 * fq), sn = *(const f32x4*)(msin + s * 16 + 4 * fq);
                FOR_BJ { const int hh = (pn - 4) * 8 + bj * 4 + wc; const f32x4 x1 = acc[ai][bj][m][0] * rs, x2 = acc[ai][bj][m][1] * rs;
                    const f32x4 o1 = x1 * c - x2 * sn, o2 = x2 * c + x1 * sn; u32x2 w1, w2; w1.x = cvtpk(o1[0], o1[1]); w1.y = cvtpk(o1[2], o1[3]); w2.x = cvtpk(o2[0], o2[1]); w2.y = cvtpk(o2[2], o2[3]);
                    *(u32x2*)(QMp + (size_t)t * 512 + hh * 32 + 4 * fq) = w1; *(u32x2*)(QMp + (size_t)t * 512 + hh * 32 + 16 + 4 * fq) = w2; } }
            asm volatile("" ::: "memory");
        }
    }
};
struct EpiUk {
    static constexpr bool PERM = true, AFTER_DRAIN = false;
    bf16* KMn; const float* ssq;
    DI void operator()(EPI_ARGS) const {
        asm volatile("" : "+v"(fr), "+v"(fq));
        const int row0 = u.pm * 256 + wr * 64 + fr, c8 = wc * 32 + 8 * fq;
        FOR_AI_M { const int t = row0 + ai * 128 + m * 16;
            const f32x4 q = *(const f32x4*)(ssq + (size_t)t * 4); const float rs = 1.0f / sqrtf(((q[0] + q[1]) + (q[2] + q[3])) * (1.f / 128.f) + EPS);
            FOR_BJ { *(u32x4*)(KMn + (size_t)t * 1024 + u.pn * 256 + bj * 128 + c8) = pack8(acc[ai][bj][m][0] * rs, acc[ai][bj][m][1] * rs); } }
    }
};
template <int ACT  > struct EpiAct {
    static constexpr bool PERM = true, AFTER_DRAIN = false;
    bf16* O; int ldc;
    DI void operator()(EPI_ARGS) const {
        asm volatile("" : "+v"(fr), "+v"(fq));
        const int row0 = u.pm * 256 + wr * 64 + fr, c8 = u.pn * 256 + wc * 32 + 8 * fq;
        FOR_AI_M { const int t = row0 + ai * 128 + m * 16;
            FOR_BJ { f32x4 v0 = acc[ai][bj][m][0], v1 = acc[ai][bj][m][1];
#pragma unroll
                for (int i = 0; i < 4; ++i) { if (ACT == 0) { v0[i] = sigm(v0[i]); v1[i] = sigm(v1[i]); } else { const float a = fmaxf(v0[i], 0.f), b = fmaxf(v1[i], 0.f); v0[i] = a * a; v1[i] = b * b; } }
                *(u32x4*)(O + (size_t)t * ldc + c8 + bj * 128) = pack8(v0, v1); } }
    }
};
template <int I> struct EpiBranch {
    static constexpr bool PERM = true, AFTER_DRAIN = false;
    const bf16* G; float* M32; bf16* MG;
    DI void operator()(EPI_ARGS) const {
        asm volatile("" : "+v"(fr), "+v"(fq));
        const int row0 = u.pm * 256 + wr * 64 + fr, c8 = u.pn * 256 + wc * 32 + 8 * fq;
        FOR_AI_M { const int t = row0 + ai * 128 + m * 16;
            FOR_BJ { const size_t idx = (size_t)t * 1024 + c8 + bj * 128; f32x4 g0, g1; unpack8(*(const u32x4*)(G + idx), g0, g1);
                f32x4 v0 = acc[ai][bj][m][0] * g0, v1 = acc[ai][bj][m][1] * g1;
#ifdef ABL_BRANCH
                if (I == ABL_BRANCH) { v0 = v0 * 0.f; v1 = v1 * 0.f; }
#endif
                if (I > 0) { v0 = v0 + *(const f32x4*)(M32 + idx); v1 = v1 + *(const f32x4*)(M32 + idx + 4); }
                if (I < 2) { *(f32x4*)(M32 + idx) = v0; *(f32x4*)(M32 + idx + 4) = v1; } else *(u32x4*)(MG + idx) = pack8(v0, v1); } }
    }
};
struct EpiY {
    static constexpr bool PERM = true, AFTER_DRAIN = false;
    bf16* Y; float* SSQ;
    DI void operator()(EPI_ARGS) const {
        asm volatile("" : "+v"(fr), "+v"(fq));
        const int row0 = u.pm * 256 + wr * 64 + fr, c8 = u.pn * 256 + wc * 32 + 8 * fq;
        FOR_AI_M { const int t = row0 + ai * 128 + m * 16; float ss = 0.f;
            FOR_BJ { const f32x4 v0 = acc[ai][bj][m][0], v1 = acc[ai][bj][m][1]; ss += sq4(v0) + sq4(v1); *(u32x4*)(Y + (size_t)t * 1024 + c8 + bj * 128) = pack8(v0, v1); }
            ss += shx(ss, 16, fq * 16 + fr); ss += shx(ss, 32, fq * 16 + fr);
            if (fq == 0) SSQ[(size_t)t * 16 + u.pn * 4 + wc] = ss; }
    }
};

template <int MODE> struct AC;
template <> struct AC<0> { static constexpr int DQK = 128, KW = 128, DVW = 128, VTR = 256, QR = 128; };
template <> struct AC<1> { static constexpr int DQK = 64, KW = 128, DVW = 128, VTR = 128, QR = 128; };
template <> struct AC<2> { static constexpr int DQK = 96, KW = 96, DVW = 64, VTR = 64, QR = 256; };
constexpr int A_KBUF = 17408, A_VBUF = 36864, A_V0 = 2 * A_KBUF, A_MISC = 2 * A_KBUF + 2 * A_VBUF;
constexpr int A_LUT = A_MISC + 64, A_XCH = A_MISC + 1024;
static_assert(A_XCH + 2048 <= LDS_BYTES, "attention LDS map");
struct AttnP { unsigned char* ws; int l; };
struct AttnPtrs { const bf16 *RQ, *RK, *RVt, *RG; bf16* RO; bf16* DQ; const bf16 *DK, *DVt; bf16* QMn; const bf16 *QMp, *KMn, *KPE, *VMt; const float *biasl, *subg; float lam, oml; };

#pragma float_control(push)
#pragma float_control(precise, off)
template <int MODE> DI void attn_unit(lptr lds, const AttnP PP, const int b, const int hd, const int qb, const int wv) {
    using C = AC<MODE>;
    unsigned char* const ws = PP.ws;
    const AttnPtrs P{(const bf16*)(ws + WS_RQ), (const bf16*)(ws + WS_RK), (const bf16*)(ws + WS_RVT), (const bf16*)(ws + WS_RG), (bf16*)(ws + WS_RO), (bf16*)(ws + WS_DQ),
                     (const bf16*)(ws + WS_DK), (const bf16*)(ws + WS_DVT), (bf16*)(ws + WS_QMN), (const bf16*)(ws + WS_QMP), (const bf16*)(ws + WS_KMN), (const bf16*)(ws + WS_KPE),
                     (const bf16*)(ws + WS_VMT), (const float*)(ws + WS_BIAS), (const float*)(ws + WS_SUBG) + PP.l * 128, 0.f, 0.f};
    constexpr int NKS = C::DQK / 16, NVB = C::DVW / 32, KS = (C::KW + 8) * 2, VS = 144, KCH = C::KW / 8, NKC = 64 * KCH, NVR = C::VTR / 64;
    const int tid = tidx(wv), w = __builtin_amdgcn_readfirstlane(tid >> 6), lane = tid & 63, r = lane & 31, h = lane >> 5;
    const int rg = MODE == 2 ? w : (w >> 1), pp = MODE == 2 ? 0 : (w & 1);
    const int q0 = qb * C::QR, q0w = q0 + rg * 32, tok0 = b * SEQ, qq = q0w + r;
    const int ntiles = (q0 + C::QR) / 64;
    const bf16* Kg; const bf16* Vg;
    if (MODE == 0) { Kg = P.RK + (size_t)tok0 * 512 + hd * 128; Vg = P.RVt + (size_t)(b * 4 + hd) * 256 * SEQ; }
    else if (MODE == 1) { Kg = P.DK + (size_t)tok0 * 1024 + hd * 128; Vg = P.DVt + (size_t)(b * 8 + hd) * 128 * SEQ; }
    else { Kg = P.KMn + (size_t)tok0 * 1024 + hd * 64; Vg = P.VMt + (size_t)(b * 16 + hd) * 64 * SEQ; }
    const bf16* Kpe = P.KPE + (size_t)tok0 * 32;
    bf16x8 q[NKS];
    { const size_t t = (size_t)(tok0 + qq);
#pragma unroll
        for (int ks = 0; ks < NKS; ++ks) {
            const bf16* src;
            if (MODE == 0) src = P.RQ + t * 512 + hd * 128 + ks * 16 + 8 * h;
            else if (MODE == 1) src = P.DQ + t * 1024 + hd * 128 + pp * 64 + ks * 16 + 8 * h;
            else src = ks < 4 ? P.QMn + t * 1024 + hd * 64 + ks * 16 + 8 * h : P.QMp + t * 512 + hd * 32 + (ks - 4) * 16 + 8 * h;
            q[ks] = *(const bf16x8*)src; } }
    if (MODE == 1) { if (tid < 128) ((LAS float*)(lds + A_LUT))[tid] = P.biasl[hd * 128 + tid]; }
    u32x4 kreg[2], vreg[NVR];
#define A_GLOAD(kt) do { \
    _Pragma("unroll") for (int i_ = 0; i_ < 2; ++i_) { const int id_ = tid + 512 * i_; if (id_ < NKC) { const int row_ = id_ / KCH, cc_ = id_ % KCH; const size_t kr_ = (size_t)((kt) * 64 + row_); \
        const bf16* s_; if (MODE == 2) s_ = cc_ < 8 ? Kg + kr_ * 1024 + cc_ * 8 : Kpe + kr_ * 32 + (cc_ - 8) * 8; else s_ = Kg + kr_ * (MODE == 0 ? 512 : 1024) + cc_ * 8; kreg[i_] = *(const u32x4*)s_; } } \
    _Pragma("unroll") for (int i_ = 0; i_ < NVR; ++i_) { const int id_ = tid + 512 * i_, row_ = id_ >> 3, cc_ = id_ & 7; vreg[i_] = *(const u32x4*)(Vg + (size_t)row_ * SEQ + (kt) * 64 + cc_ * 8); } } while (0)
#define A_LWRITE(buf) do { \
    _Pragma("unroll") for (int i_ = 0; i_ < 2; ++i_) { const int id_ = tid + 512 * i_; if (id_ < NKC) { const int row_ = id_ / KCH, cc_ = id_ % KCH; *(LAS u32x4*)(lds + (buf) * A_KBUF + row_ * KS + cc_ * 16) = kreg[i_]; } } \
    _Pragma("unroll") for (int i_ = 0; i_ < NVR; ++i_) { const int id_ = tid + 512 * i_, row_ = id_ >> 3, cc_ = id_ & 7; *(LAS u32x4*)(lds + A_V0 + (buf) * A_VBUF + row_ * VS + cc_ * 16) = vreg[i_]; } } while (0)
    f32x16 O[NVB];
#pragma unroll
    for (int vb = 0; vb < NVB; ++vb)
#pragma unroll
        for (int i = 0; i < 16; ++i) O[vb][i] = 0.f;
    float mrun = -INFINITY, lrun = 0.f;
    const float l2g = MODE == 0 ? log2f(1.f - ex2(-5.f - (float)hd)) : 0.f;
    const float b31 = MODE == 1 ? P.biasl[hd * 128 + 127] : 0.f;
    const int pir = (r & 0x13) | ((r & 8) >> 1) | ((r & 4) << 1);
    const int koffb = ((MODE == 1 ? pp * 64 : 0) + 8 * h) * 2;
    const int vrow0 = (MODE == 0 ? pp * 128 : 0) + r;
    A_GLOAD(0); A_LWRITE(0);
    __syncthreads();
    for (int kt = 0; kt < ntiles; ++kt) {
        const int cur = kt & 1;
        if (kt + 1 < ntiles) A_GLOAD(kt + 1);
        if (kt * 64 <= q0w + 31) {
            const lptr Kb = lds + cur * A_KBUF + koffb, Vb = lds + A_V0 + cur * A_VBUF + (8 * h) * 2;
            f32x16 S0, S1;
#pragma unroll
            for (int i = 0; i < 16; ++i) { S0[i] = 0.f; S1[i] = 0.f; }
            {
                constexpr int CH = NKS > 6 ? 4 : NKS;
#pragma unroll
                for (int c0 = 0; c0 < NKS; c0 += CH) {
                    bf16x8 kf0[CH], kf1[CH];
#pragma unroll
                    for (int j = 0; j < CH; ++j) { kf0[j] = *(const LAS bf16x8*)(Kb + pir * KS + (c0 + j) * 32); kf1[j] = *(const LAS bf16x8*)(Kb + (32 + pir) * KS + (c0 + j) * 32); }
                    __builtin_amdgcn_sched_barrier(0);
                    __builtin_amdgcn_s_setprio(1);
#pragma unroll
                    for (int j = 0; j < CH; ++j) {
                        S0 = __builtin_amdgcn_mfma_f32_32x32x16_bf16(kf0[j], q[c0 + j], S0, 0, 0, 0);
                        S1 = __builtin_amdgcn_mfma_f32_32x32x16_bf16(kf1[j], q[c0 + j], S1, 0, 0, 0);
                    }
                    __builtin_amdgcn_s_setprio(0);
                    __builtin_amdgcn_sched_barrier(0);
                }
            }
            const int kb0 = kt * 64 + 8 * h;
            const bool diag = (kt * 64 + 63 > q0w);
            if (MODE == 0) {
                const float cs = ex2(l2g * (float)(64 * ((q0w >> 6) - kt)));
                if (diag) {
#pragma unroll
                    for (int i = 0; i < 16; ++i) { const int k0 = kb0 + 16 * (i >> 3) + (i & 7); S0[i] = (k0 <= qq) ? S0[i] * cs : 0.f; S1[i] = (k0 + 32 <= qq) ? S1[i] * cs : 0.f; }
                } else {
#pragma unroll
                    for (int i = 0; i < 16; ++i) { S0[i] *= cs; S1[i] *= cs; }
                }
            } else {
                float boff = 0.f;
                if (MODE == 1) {
                    if (q0w - (kt * 64 + 63) >= 113) boff = b31;
                    else {
                        const LAS float* lut = (const LAS float*)(lds + A_LUT);
#pragma unroll
                        for (int i = 0; i < 16; ++i) { const int k0 = kb0 + 16 * (i >> 3) + (i & 7); int d0 = qq - k0, d1 = d0 - 32;
                            d0 = d0 < 0 ? 0 : (d0 > 127 ? 127 : d0); d1 = d1 < 0 ? 0 : (d1 > 127 ? 127 : d1); S0[i] += lut[d0]; S1[i] += lut[d1]; }
                    }
                }
                if (diag) {
#pragma unroll
                    for (int i = 0; i < 16; ++i) { const int k0 = kb0 + 16 * (i >> 3) + (i & 7); if (k0 > qq) S0[i] = -INFINITY; if (k0 + 32 > qq) S1[i] = -INFINITY; }
                }
                float mx = fmaxf(S0[0], S1[0]);
#pragma unroll
                for (int i = 1; i < 16; ++i) mx = fmaxf(mx, fmaxf(S0[i], S1[i]));
                mx = fmaxf(mx, shx(mx, 32, lane)) + boff;
                if (__builtin_amdgcn_ballot_w64(mx - mrun > 8.f) != 0ull) {
                    const float mn = fmaxf(mrun, mx), al = ex2(mrun - mn); mrun = mn; lrun *= al;
#pragma unroll
                    for (int vb = 0; vb < NVB; ++vb)
#pragma unroll
                        for (int i = 0; i < 16; ++i) O[vb][i] *= al;
                }
                const float nmo = boff - mrun;
                const f32x2_t nm2 = {nmo, nmo}; f32x2_t ps2 = {0.f, 0.f};
#pragma unroll
                for (int i = 0; i < 8; ++i) {
                    f32x2_t a = (f32x2_t){S0[2 * i], S0[2 * i + 1]} + nm2, c = (f32x2_t){S1[2 * i], S1[2 * i + 1]} + nm2;
                    a.x = ex2(a.x); a.y = ex2(a.y); c.x = ex2(c.x); c.y = ex2(c.y); ps2 += a; ps2 += c;
                    S0[2 * i] = a.x; S0[2 * i + 1] = a.y; S1[2 * i] = c.x; S1[2 * i + 1] = c.y; }
                lrun += ps2.x + ps2.y;
            }
            bf16x8 pf[2][2];
#pragma unroll
            for (int s = 0; s < 2; ++s) {
                u32x4 t0, t1;
                t0.x = cvtpk(S0[8 * s + 0], S0[8 * s + 1]); t0.y = cvtpk(S0[8 * s + 2], S0[8 * s + 3]); t0.z = cvtpk(S0[8 * s + 4], S0[8 * s + 5]); t0.w = cvtpk(S0[8 * s + 6], S0[8 * s + 7]);
                t1.x = cvtpk(S1[8 * s + 0], S1[8 * s + 1]); t1.y = cvtpk(S1[8 * s + 2], S1[8 * s + 3]); t1.z = cvtpk(S1[8 * s + 4], S1[8 * s + 5]); t1.w = cvtpk(S1[8 * s + 6], S1[8 * s + 7]);
                pf[0][s] = __builtin_bit_cast(bf16x8, t0); pf[1][s] = __builtin_bit_cast(bf16x8, t1);
            }
#pragma unroll
            for (int vb = 0; vb < NVB; vb += 2) {
                bf16x8 vf[2][4];
#pragma unroll
                for (int u = 0; u < 2; ++u)
#pragma unroll
                    for (int j = 0; j < 4; ++j) vf[u][j] = *(const LAS bf16x8*)(Vb + (vrow0 + (vb + u) * 32) * VS + ((j >> 1) * 32 + 16 * (j & 1)) * 2);
                __builtin_amdgcn_sched_barrier(0);
                __builtin_amdgcn_s_setprio(1);
#pragma unroll
                for (int j = 0; j < 4; ++j) {
                    O[vb] = __builtin_amdgcn_mfma_f32_32x32x16_bf16(vf[0][j], pf[j >> 1][j & 1], O[vb], 0, 0, 0);
                    O[vb + 1] = __builtin_amdgcn_mfma_f32_32x32x16_bf16(vf[1][j], pf[j >> 1][j & 1], O[vb + 1], 0, 0, 0);
                }
                __builtin_amdgcn_s_setprio(0);
                __builtin_amdgcn_sched_barrier(0);
            }
        }
        if (kt + 1 < ntiles) A_LWRITE(cur ^ 1);
        __syncthreads();
    }
#undef A_GLOAD
#undef A_LWRITE
    const size_t trow = (size_t)(tok0 + qq);
    if (MODE == 0) {
        float ss = 0.f;
#pragma unroll
        for (int vb = 0; vb < NVB; ++vb)
#pragma unroll
            for (int i = 0; i < 16; ++i) ss += O[vb][i] * O[vb][i];
        ss += shx(ss, 32, lane);
        LAS float* xch = (LAS float*)(lds + A_XCH);
        if (h == 0) xch[w * 32 + r] = ss;
        __syncthreads();
        const float tot = ss + xch[(w ^ 1) * 32 + r];
        const float rs = 1.0f / sqrtf(tot * (1.f / 256.f) + EPS);
#pragma unroll
        for (int vb = 0; vb < NVB; ++vb)
#pragma unroll
            for (int g = 0; g < 4; ++g) { const size_t idx = trow * 1024 + hd * 256 + pp * 128 + vb * 32 + 8 * g + 4 * h; const u32x2 gw = *(const u32x2*)(P.RG + idx);
                u32x2 o; o.x = cvtpk(O[vb][4 * g] * rs * bflo(gw.x), O[vb][4 * g + 1] * rs * bfhi(gw.x)); o.y = cvtpk(O[vb][4 * g + 2] * rs * bflo(gw.y), O[vb][4 * g + 3] * rs * bfhi(gw.y));
                *(u32x2*)(P.RO + idx) = o; }
    } else if (MODE == 1) {
        const float lt = lrun + shx(lrun, 32, lane), il = 1.0f / lt;
        LAS float* X = (LAS float*)lds + (size_t)rg * 64 * 64;
        if (pp == 1) {
#pragma unroll
            for (int vb = 0; vb < NVB; ++vb)
#pragma unroll
                for (int i = 0; i < 16; ++i) X[(vb * 16 + i) * 64 + lane] = O[vb][i] * il;
        }
        __syncthreads();
        if (pp == 0) {
            const float lam = ((const float*)(ws + WS_LAM))[PP.l], oml = ((const float*)(ws + WS_LAM))[2 + PP.l];
            float ss = 0.f;
#pragma unroll
            for (int vb = 0; vb < NVB; ++vb)
#pragma unroll
                for (int i = 0; i < 16; ++i) { const float v = O[vb][i] * il - lam * X[(vb * 16 + i) * 64 + lane]; O[vb][i] = v; ss += v * v; }
            ss += shx(ss, 32, lane);
            const float rs = oml / sqrtf(ss * (1.f / 128.f) + EPS);
#pragma unroll
            for (int vb = 0; vb < NVB; ++vb)
#pragma unroll
                for (int g = 0; g < 4; ++g) { const int dv = vb * 32 + 8 * g + 4 * h; const f32x4 gg = *(const f32x4*)(P.subg + dv);
                    u32x2 o; o.x = cvtpk(O[vb][4 * g] * rs * gg[0], O[vb][4 * g + 1] * rs * gg[1]); o.y = cvtpk(O[vb][4 * g + 2] * rs * gg[2], O[vb][4 * g + 3] * rs * gg[3]);
                    *(u32x2*)(P.DQ + trow * 1024 + hd * 128 + dv) = o; }
        }
    } else {
        const float lt = lrun + shx(lrun, 32, lane), il = 1.0f / lt;
#pragma unroll
        for (int vb = 0; vb < NVB; ++vb)
#pragma unroll
            for (int g = 0; g < 4; ++g) { u32x2 o; o.x = cvtpk(O[vb][4 * g] * il, O[vb][4 * g + 1] * il); o.y = cvtpk(O[vb][4 * g + 2] * il, O[vb][4 * g + 3] * il);
                *(u32x2*)(P.QMn + trow * 1024 + hd * 64 + vb * 32 + 8 * g + 4 * h) = o; }
    }
}
#pragma float_control(pop)
DI void attn_phase(lptr lds, const AttnP P, unsigned* counter, const int wv) {
    for (;;) {
        __syncthreads();
        if (tidx(wv) == 0) *(LAS int*)(lds + A_MISC) = (int)atomicAdd(counter, 1u);
        __syncthreads();
        const int idx = __builtin_amdgcn_readfirstlane(*(LAS int*)(lds + A_MISC));
        if (idx >= 2560) break;
        const int pr = 7 - idx / 320, rem = idx % 320;
        if (rem < 128) attn_unit<2>(lds, P, rem >> 4, rem & 15, pr, wv);
        else if (rem < 160) { const int e = rem - 128; attn_unit<0>(lds, P, e >> 2, e & 3, 2 * pr + 1, wv); }
        else if (rem < 224) { const int e = rem - 160; attn_unit<1>(lds, P, e >> 3, e & 7, 2 * pr + 1, wv); }
        else if (rem < 256) { const int e = rem - 224; attn_unit<0>(lds, P, e >> 2, e & 3, 2 * pr, wv); }
        else { const int e = rem - 256; attn_unit<1>(lds, P, e >> 3, e & 7, 2 * pr, wv); }
    }
}


constexpr size_t WS_BAR = 131072;
#define XB_TMO      128
#define XB_XCNT(j)  (256  + 64 * (j))
#define XB_XSUB(j)  (1280 + 64 * (j))
#define XB_XGEN(j)  (2304 + 64 * (j))
#define XB_TOP      3328
#define XB_TOPGEN   3392
#define XCD_BAR_WORDS 3456
#define XB_SPIN_CAP (1u << 18)
constexpr int LDS_XB = 143360;
DI unsigned xb_ld(unsigned* p)              { return __hip_atomic_load(p, __ATOMIC_RELAXED, __HIP_MEMORY_SCOPE_AGENT); }
DI unsigned xb_add(unsigned* p, unsigned v) { return __hip_atomic_fetch_add(p, v, __ATOMIC_RELAXED, __HIP_MEMORY_SCOPE_AGENT); }
DI unsigned xb_xcc_id() { return (unsigned)__builtin_amdgcn_s_getreg((3 << 11) | 20) & 0xFu; }
#define XB_SPIN(cond, bar) do { unsigned _sp = 0; while (cond) { __builtin_amdgcn_s_sleep(1); \
    if ((++_sp & 255u) == 0u) { if (xb_ld(&(bar)[XB_TMO])) break; if (_sp > XB_SPIN_CAP) { atomicAdd(&(bar)[XB_TMO], 1u); break; } } } } while (0)
DI void xcd_barrier_complete(unsigned* bar, unsigned x, unsigned& nloc, unsigned& nx) {
    const unsigned G = gridDim.x;
    unsigned sum, cnt, mine, sp = 0u;
    for (;;) {
        sum = 0u; cnt = 0u; mine = 0u;
#pragma unroll
        for (unsigned j = 0; j < 16; ++j) { const unsigned c = xb_ld(&bar[XB_XCNT(j)]); sum += c; cnt += (c > 0u) ? 1u : 0u; mine = (j == x) ? c : mine; }
        if (sum == G) break;
        __builtin_amdgcn_s_sleep(1);
        if ((++sp & 255u) == 0u) { if (xb_ld(&bar[XB_TMO])) break; if (sp > XB_SPIN_CAP) { atomicAdd(&bar[XB_TMO], 1u); break; } }
    }
    nloc = mine > 0u ? mine : 1u; nx = cnt > 0u ? cnt : 1u;
}
DI void xcd_barrier(unsigned* bar, lptr lds, const int wv) {
    asm volatile("s_waitcnt vmcnt(0)" ::: "memory");
    __syncthreads();
    if (tidx(wv) == 0) {
        volatile LAS unsigned* st = (volatile LAS unsigned*)(lds + LDS_XB);
        const unsigned x = xb_xcc_id();
        __builtin_amdgcn_s_waitcnt(0);
        unsigned nloc = st[0], nx = st[1];
        if (nloc == 0u) { xcd_barrier_complete(bar, x, nloc, nx); st[0] = nloc; st[1] = nx; }
        const unsigned old = xb_add(&bar[XB_XSUB(x)], 1u);
        const unsigned gen = old / nloc;
        if (old + 1u == (gen + 1u) * nloc) {
            __builtin_amdgcn_fence(__ATOMIC_RELEASE, "agent");
            asm volatile("s_waitcnt vmcnt(0)" ::: "memory");
            const unsigned og = xb_add(&bar[XB_TOP], 1u);
            const unsigned tg = og / nx;
            if (og + 1u == (tg + 1u) * nx) xb_add(&bar[XB_TOPGEN], 1u);
            else XB_SPIN(xb_ld(&bar[XB_TOPGEN]) == tg, bar);
            __builtin_amdgcn_fence(__ATOMIC_ACQUIRE, "agent");
            xb_add(&bar[XB_XGEN(x)], 1u);
            asm volatile("s_waitcnt vmcnt(0)" ::: "memory");
        } else {
            XB_SPIN(xb_ld(&bar[XB_XGEN(x)]) == gen, bar);
            __builtin_amdgcn_fence(__ATOMIC_ACQUIRE, "agent");
            asm volatile("s_waitcnt vmcnt(0)" ::: "memory");
        }
    }
    __syncthreads();
}
constexpr int N_PHASES = 39;
template <class Epi> DI void run_gemm(lptr lds, int wv, const bf16* A, const bf16* Bt, int M, int N, int K, const Epi& E) {
#ifdef DIS_GEMM
    return;
#endif
    int bx_ = (int)blockIdx.x; asm volatile("" : "+s"(bx_));
    pg8::Gemm g{A, Bt, M, N, K}; pg8::StaticOrder S; S.init(M, N, (int)gridDim.x, bx_); S.wv = wv;
    pg8::gemm_phase<Epi, pg8::StaticOrder, true, true>(lds, g, S, E);
}
__global__ void __launch_bounds__(NTHR) mega_fwd(Params p) {
    extern __shared__ __attribute__((aligned(16))) unsigned char lds_raw[];
    lptr lds = (lptr)lds_raw;
#if !MK_MULTI
    cg::grid_group grid = cg::this_grid();
#endif
    const int wv = __builtin_amdgcn_readfirstlane((int)threadIdx.x >> 6);
#if !MK_MULTI
    if (threadIdx.x == 0) { ((volatile LAS unsigned*)(lds + LDS_XB))[0] = 0u; ((volatile LAS unsigned*)(lds + LDS_XB))[1] = 0u; (void)xb_add((unsigned*)(p.ws + WS_BAR) + XB_XCNT(xb_xcc_id()), 1u); }
    __syncthreads();
#endif
    int ph = p.ph_lo; const int ph_hi = p.ph_hi;
    if (ph == 0) {
#ifndef DIS_PRO
        prologue(p, lds, wv);
#endif
        ++ph;
#if !MK_MULTI
        if (ph < ph_hi) grid.sync();
#endif
    }
    const float* xin0 = p.x; float* const outp = p.out; unsigned char* ws0 = p.ws;
    for (; ph < ph_hi; ++ph) {
        size_t z_ = 0; asm volatile("" : "+s"(z_));
        unsigned char* ws = ws0 + z_;
#ifdef MK_TS
        if (blockIdx.x == 0 && tidx(wv) == 0) ((unsigned long long*)(ws + 262144))[ph] = __builtin_amdgcn_s_memrealtime();
#endif
        const float* gains = (const float*)(ws + WS_GAIN);
        bf16* H = (bf16*)(ws + WS_H);
        const int hb = (ph - 1) / 19, k19 = (ph - 1) % 19;
        const size_t xoff = (size_t)hb * TH * DM;
        if (k19 == 0) norm_rows(xin0 + xoff, gains, H, TH, wv);
        else {
            const int l = (k19 - 1) / 9, k = (k19 - 1) % 9;
            const bf16* Wb = (const bf16*)(ws + WS_W) + (size_t)l * WO_END;
            if (k == 0) {
                EpiIn1 E1{ws};
                run_gemm(lds, wv, H, Wb + WO_IN1, TH, 4608, 1024, E1);
                EpiVt E2{(bf16*)(ws + WS_RVT), (bf16*)(ws + WS_DVT), nullptr, 0.f};
                run_gemm(lds, wv, Wb + WO_V, H, 2048, TH, 1024, E2);
            } else if (k == 1) {
                EpiUq Eq{(bf16*)(ws + WS_QMN), (bf16*)(ws + WS_QMP), (const float*)(ws + WS_SSQ_CQ), (const float*)(ws + WS_MCOS), (const float*)(ws + WS_MSIN), wv};
                run_gemm(lds, wv, (const bf16*)(ws + WS_CQ), Wb + WO_UQ, TH, 1536, 256, Eq);
                EpiUk Ek{(bf16*)(ws + WS_KMN), (const float*)(ws + WS_SSQ_CKV)};
                run_gemm(lds, wv, (const bf16*)(ws + WS_CKV), Wb + WO_UK, TH, 1024, 256, Ek);
                EpiVt Ev{(bf16*)(ws + WS_VMT), (bf16*)(ws + WS_VMT), (const float*)(ws + WS_SSQ_CKV), 1.f / 128.f};
                run_gemm(lds, wv, Wb + WO_UV, (const bf16*)(ws + WS_CKV), 1024, TH, 256, Ev);
            } else if (k == 2) {
#ifndef DIS_ATTN
                AttnP P{ws, l};
                attn_phase(lds, P, (unsigned*)(ws + WS_CNT) + hb * 2 + l, wv);
#endif
            } else if (k == 3) {
                bf16* G = (bf16*)(ws + WS_G); float* M32 = (float*)(ws + WS_M32); bf16* MG = (bf16*)(ws + WS_MG);
                const size_t GS = (size_t)TH * 1024;
                run_gemm(lds, wv, H, Wb + WO_G, TH, 1024, 1024, EpiAct<0>{G, 1024});
                run_gemm(lds, wv, (const bf16*)(ws + WS_RO), Wb + WO_RO, TH, 1024, 1024, EpiBranch<0>{G, M32, MG});
                run_gemm(lds, wv, H, Wb + WO_G + (size_t)1024 * 1024, TH, 1024, 1024, EpiAct<0>{G + GS, 1024});
                run_gemm(lds, wv, (const bf16*)(ws + WS_DQ), Wb + WO_DO, TH, 1024, 1024, EpiBranch<1>{G + GS, M32, MG});
                run_gemm(lds, wv, H, Wb + WO_G + (size_t)2048 * 1024, TH, 1024, 1024, EpiAct<0>{G + 2 * GS, 1024});
                run_gemm(lds, wv, (const bf16*)(ws + WS_QMN), Wb + WO_MO, TH, 1024, 1024, EpiBranch<2>{G + 2 * GS, M32, MG});
            } else if (k == 4) {
                run_gemm(lds, wv, (const bf16*)(ws + WS_MG), Wb + WO_OUT, TH, 1024, 1024, EpiY{(bf16*)(ws + WS_Y), (float*)(ws + WS_SSQ_Y)});
            } else if (k == 5) {
                resid_rows((l == 0 ? xin0 : (const float*)outp) + xoff, (const bf16*)(ws + WS_Y), (const float*)(ws + WS_SSQ_Y), gains + 2048 + l * DM, outp + xoff, gains + 4096 + l * DM, H, TH, wv);
            } else if (k == 6) {
                run_gemm(lds, wv, H, Wb + WO_UP, TH, DFF, 1024, EpiAct<1>{(bf16*)(ws + WS_U), DFF});
            } else if (k == 7) {
                run_gemm(lds, wv, (const bf16*)(ws + WS_U), Wb + WO_DOWN, TH, 1024, DFF, EpiY{(bf16*)(ws + WS_Y), (float*)(ws + WS_SSQ_Y)});
            } else {
                resid_rows(outp + xoff, (const bf16*)(ws + WS_Y), (const float*)(ws + WS_SSQ_Y), gains + 6144 + l * DM, outp + xoff, l == 0 ? gains + DM : nullptr, H, TH, wv, true);
            }
        }
#if !MK_MULTI
        if (ph + 1 < ph_hi) xcd_barrier((unsigned*)(ws + WS_BAR), lds, wv);
#endif
    }
#ifdef MK_TS
    if (blockIdx.x == 0 && tidx(wv) == 0) {
        unsigned long long* ts = (unsigned long long*)(ws0 + 262144); ts[N_PHASES] = __builtin_amdgcn_s_memrealtime();
        unsigned long long sum = 0;
        for (int q = 1; q < N_PHASES; ++q) { const int k19 = (q - 1) % 19; const int k = k19 == 0 ? 9 : (k19 - 1) % 9; if (MK_TS == k || (MK_TS == 10 && (k == 6 || k == 7)) || (MK_TS == 11 && (k == 5 || k == 8 || k == 9))) sum += ts[q + 1] - ts[q]; }
        outp[0] = (float)sum * (0.01f / 32.f);
    }
#endif
}

extern "C" void kernel_launch(void* const* d_in, const int* in_sizes, int n_in, void* d_out, int out_size, void* d_ws, size_t ws_size, hipStream_t stream) {
    static int grid = 0;
    if (grid == 0) {
        if (n_in != 22 || ws_size < WS_END) { fprintf(stderr, "kernel_launch: unexpected inputs (n_in %d, ws %zu)\n", n_in, ws_size); grid = -1; return; }
        int dev = 0, cus = 0, per_cu = 0;
        hipGetDevice(&dev); hipDeviceGetAttribute(&cus, hipDeviceAttributeMultiprocessorCount, dev);
        if (hipFuncSetAttribute((const void*)mega_fwd, hipFuncAttributeMaxDynamicSharedMemorySize, LDS_BYTES) != hipSuccess) { fprintf(stderr, "kernel_launch: hipFuncSetAttribute failed\n"); grid = -1; return; }
        if (hipOccupancyMaxActiveBlocksPerMultiprocessor(&per_cu, (const void*)mega_fwd, NTHR, LDS_BYTES) != hipSuccess || per_cu < 1) { fprintf(stderr, "kernel_launch: occupancy query gave %d\n", per_cu); per_cu = 1; }
        (void)hipGetLastError();
        grid = cus * per_cu;
        if (grid > 256) grid = 256;
    }
    if (grid < 0) return;
    Params p{};
    const float** pf = (const float**)&p;
    for (int i = 0; i < 22; ++i) pf[i] = (const float*)d_in[i];
    p.out = (float*)d_out; p.ws = (unsigned char*)d_ws;
#if MK_MULTI
#ifdef MK_CHECK
    hipLaunchKernelGGL(chk_clear, dim3(1), dim3(128), 0, stream, (unsigned char*)d_ws);
#endif
    for (int ph = 0; ph < N_PHASES; ++ph) { p.ph_lo = ph; p.ph_hi = ph + 1; hipLaunchKernelGGL(mega_fwd, dim3(grid), dim3(NTHR), LDS_BYTES, stream, p);
#ifdef MK_CHECK
        if (ph >= 1) hipLaunchKernelGGL(chk, dim3(256), dim3(256), 0, stream, p, ph);
#endif
    }
#ifdef MK_CHECK
    hipLaunchKernelGGL(chk_report, dim3(1), dim3(64), 0, stream, (unsigned char*)d_ws, (float*)d_out);
#endif
#else
    p.ph_lo = 0; p.ph_hi = N_PHASES;
    if (hipMemsetAsync((char*)d_ws + WS_BAR, 0, XCD_BAR_WORDS * 4, stream) != hipSuccess) { fprintf(stderr, "kernel_launch: memset of the barrier words failed\n"); return; }
    void* args[] = {&p};
    hipError_t e = hipLaunchCooperativeKernel((const void*)mega_fwd, dim3(grid), dim3(NTHR), args, LDS_BYTES, stream);
    if (e != hipSuccess) fprintf(stderr, "cooperative launch failed: %s (grid %d)\n", hipGetErrorString(e), grid);
#endif
}
```

```cpp
#include <hip/hip_runtime.h>
#include <hip/hip_cooperative_groups.h>
#include <cstdio>
#include <cstdint>
namespace cg = cooperative_groups;
__device__ __forceinline__ int tidx(int wv) { int l; asm volatile("v_mbcnt_lo_u32_b32 %0, -1, 0\n\tv_mbcnt_hi_u32_b32 %0, -1, %0" : "=v"(l)); return (wv << 6) | l; }
namespace pg8 {
#define PG8_LAS __attribute__((address_space(3)))
typedef unsigned short bf16_t;
typedef short bf16x8 __attribute__((ext_vector_type(8)));
typedef float f32x4 __attribute__((ext_vector_type(4)));
typedef unsigned u32x4 __attribute__((ext_vector_type(4)));
constexpr int BM = 256, BK = 64, HALF = 128, HTB = HALF * BK * 2  , STAGE_BYTES = 8 * HTB, NXCD = 8, WGM = 8;

__host__ __device__ __forceinline__ int lds_byte(int r, int c) { const int st = (r >> 4) * 2 + (c >> 5), rr = r & 15, cc = c & 31, ob = rr * 64 + cc * 2; return st * 1024 + (ob ^ (((ob >> 9) & 1) << 5)); }
__host__ __device__ __forceinline__ void stage_rc(int b, int& R, int& C) { const int st = b / 1024, sb = b % 1024, swz = sb ^ (((sb >> 9) & 1) << 5); R = (st >> 1) * 16 + swz / 64; C = (st & 1) * 32 + (swz % 64) / 2; }
__host__ __device__ __forceinline__ int perm32(int rho) { const int n = rho >> 4, i = rho & 15; return 8 * (i >> 2) + 4 * n + (i & 3); }

struct Unit { int pm, pn; };
struct Gemm { const bf16_t* A; const bf16_t* Bt; int M, N, K; };

struct StaticOrder {
    int nM, nN, nwg, G, c, wv;
    __host__ __device__ void init(int M, int N, int G_, int c_) { nM = M / BM; nN = N / BM; nwg = nM * nN; G = G_; c = c_; }
    __host__ __device__ bool next(int i, Unit& u) const {
        const long L = (long)i * G + c; if (L >= nwg) return false;
        int wgid = (int)L; { const int q = nwg / NXCD, r = nwg % NXCD, xcd = wgid % NXCD, off = wgid / NXCD; wgid = (xcd < r ? xcd * (q + 1) : r * (q + 1) + (xcd - r) * q) + off; }
        const int nig = WGM * nN, gid = wgid / nig, fm = gid * WGM, gsz = (nM - fm) < WGM ? (nM - fm) : WGM;
        u.pm = fm + ((wgid % nig) % gsz); u.pn = (wgid % nig) / gsz; return true;
    }
    __device__ __forceinline__ void a_ready(const Unit&) const {}
    __device__ __forceinline__ void done(const Unit&) const {}
};

__device__ __forceinline__ unsigned cvt_pk_bf16(float lo, float hi) { unsigned r; asm volatile("v_cvt_pk_bf16_f32 %0, %1, %2" : "=v"(r) : "v"(lo), "v"(hi)); return r; }
template <class Epi, class Sched, bool ALIGN_EPI = false, bool SP2 = false>
__device__ __forceinline__ void gemm_phase(PG8_LAS unsigned char* lds, const Gemm g, const Sched& S, const Epi& E) {
    const int tid = tidx(S.wv), wid = __builtin_amdgcn_readfirstlane(tid >> 6), lane = tid & 63, wr = wid >> 2, wc = wid & 3, fr = lane & 15, fq = lane >> 4;
    const int K = g.K, nt = K / BK;
    unsigned voffA[2], voffB[2];
#pragma unroll
    for (int i = 0; i < 2; ++i) { int R, C; stage_rc(tid * 16 + i * 8192, R, C); const int Rb = Epi::PERM ? ((R & ~31) + perm32(R & 31)) : R;
        voffA[i] = (unsigned)(R * K + C) * 2u; voffB[i] = (unsigned)(Rb * K + C) * 2u; }
    const size_t kstep = (size_t)(BK * 2);
    const size_t hstep = (size_t)HALF * K * 2;
    const size_t tstep = 2 * hstep;
    const unsigned ldsw = (unsigned)wid * 1024u;
    const int aoff = lds_byte(wr * 64 + fr, fq * 8), boff = lds_byte(wc * 32 + fr, fq * 8);
#define PG8_SA(b, h) (((b) * 2 + (h)) * HTB)
#define PG8_SB(b, h) ((4 + (b) * 2 + (h)) * HTB)
#define PG8_STAGE(bufoff, gbase, voff) do { _Pragma("unroll") for (int _i = 0; _i < 2; ++_i) \
        __builtin_amdgcn_global_load_lds((const unsigned*)((const char*)(gbase) + (voff)[_i]), (PG8_LAS unsigned*)(lds + (bufoff) + ldsw + _i * 8192), 16, 0, 0); } while (0)
#define PG8_LDA(dst, b, h) do { _Pragma("unroll") for (int m = 0; m < 4; ++m) _Pragma("unroll") for (int k = 0; k < 2; ++k) dst[m][k] = *(const PG8_LAS bf16x8*)(lds + PG8_SA(b, h) + aoff + m * 2048 + k * 1024); } while (0)
#define PG8_LDB(dst, b, h) do { _Pragma("unroll") for (int n = 0; n < 2; ++n) _Pragma("unroll") for (int k = 0; k < 2; ++k) dst[n][k] = *(const PG8_LAS bf16x8*)(lds + PG8_SB(b, h) + boff + n * 2048 + k * 1024); } while (0)
#define PG8_MMA(ai, bj, At, Bt) do { __builtin_amdgcn_s_setprio(1); _Pragma("unroll") for (int m = 0; m < 4; ++m) _Pragma("unroll") for (int n = 0; n < 2; ++n) _Pragma("unroll") for (int k = 0; k < 2; ++k) \
        acc[ai][bj][m][n] = __builtin_amdgcn_mfma_f32_16x16x32_bf16(Bt[n][k], At[m][k], acc[ai][bj][m][n], 0, 0, 0); __builtin_amdgcn_s_setprio(0); } while (0)
#define PG8_WAIT_V(n) asm volatile("s_waitcnt vmcnt(" #n ")" ::: "memory")
#define PG8_WAIT_L(n) asm volatile("s_waitcnt lgkmcnt(" #n ")" ::: "memory")
#define PG8_BAR __builtin_amdgcn_s_barrier()
#define PG8_SCHED __builtin_amdgcn_sched_barrier(0)
    Unit cur, nxt; int ui = 0;
    if (!S.next(0, cur)) return;
    f32x4 acc[2][2][4][2];
#pragma unroll
    for (int a = 0; a < 2; ++a)
#pragma unroll
        for (int b = 0; b < 2; ++b)
#pragma unroll
            for (int m = 0; m < 4; ++m)
#pragma unroll
                for (int n = 0; n < 2; ++n) acc[a][b][m][n] = (f32x4){0.f, 0.f, 0.f, 0.f};
    bf16x8 At[4][2], B0[2][2], B1[2][2];
    const char* cA = (const char*)g.A + (size_t)cur.pm * tstep; const char* cB = (const char*)g.Bt + (size_t)cur.pn * tstep;
    S.a_ready(cur);
    if constexpr (SP2) {
        PG8_STAGE(PG8_SB(0, 0), cB, voffB); PG8_STAGE(PG8_SB(0, 1), cB + hstep, voffB); PG8_STAGE(PG8_SA(0, 0), cA, voffA); PG8_STAGE(PG8_SA(0, 1), cA + hstep, voffA);
        if (wr == 1) PG8_BAR;
        PG8_WAIT_V(2); PG8_BAR;
        PG8_STAGE(PG8_SB(1, 0), cB + kstep, voffB); PG8_STAGE(PG8_SA(1, 0), cA + kstep, voffA); PG8_STAGE(PG8_SB(1, 1), cB + hstep + kstep, voffB);
        PG8_WAIT_V(6); PG8_BAR;
    } else {
        PG8_STAGE(PG8_SB(0, 0), cB, voffB); PG8_STAGE(PG8_SA(0, 0), cA, voffA); PG8_STAGE(PG8_SB(0, 1), cB + hstep, voffB); PG8_STAGE(PG8_SA(0, 1), cA + hstep, voffA);
        if (wr == 1) PG8_BAR;
        PG8_WAIT_V(4); PG8_BAR;
        PG8_STAGE(PG8_SB(1, 0), cB + kstep, voffB); PG8_STAGE(PG8_SA(1, 0), cA + kstep, voffA); PG8_STAGE(PG8_SB(1, 1), cB + hstep + kstep, voffB);
        PG8_WAIT_V(6); PG8_BAR;
    }
    for (;;) {
        const bool has_next = S.next(ui + 1, nxt);
        const char* nA = has_next ? (const char*)g.A + (size_t)nxt.pm * tstep : cA; const char* nB = has_next ? (const char*)g.Bt + (size_t)nxt.pn * tstep : cB;
        for (int t = 0; t < nt; t += 2) {
            const bool last = (t == nt - 2);
            const char* a1 = cA + (size_t)(t + 1) * kstep;
            const char* a2 = last ? nA : cA + (size_t)(t + 2) * kstep; const char* b2 = last ? nB : cB + (size_t)(t + 2) * kstep;
            const char* a3 = a2 + kstep; const char* b3 = b2 + kstep;
            if (last && has_next) S.a_ready(nxt);
            if constexpr (SP2) {
            PG8_LDB(B0, 0, 0); PG8_LDB(B1, 0, 1); PG8_SCHED; PG8_LDA(At, 0, 0); PG8_STAGE(PG8_SA(1, 1), a1 + hstep, voffA);
            PG8_WAIT_V(8); PG8_WAIT_L(0); PG8_BAR; PG8_MMA(0, 0, At, B0); PG8_MMA(0, 1, At, B1); PG8_BAR; PG8_SCHED;
            PG8_LDA(At, 0, 1); PG8_STAGE(PG8_SB(0, 0), b2, voffB); PG8_STAGE(PG8_SB(0, 1), b2 + hstep, voffB); PG8_STAGE(PG8_SA(0, 0), a2, voffA);
            PG8_WAIT_V(8); PG8_WAIT_L(0); PG8_BAR; PG8_MMA(1, 0, At, B0); PG8_MMA(1, 1, At, B1); PG8_BAR; PG8_SCHED;
            PG8_LDB(B0, 1, 0); PG8_LDB(B1, 1, 1); PG8_SCHED; PG8_LDA(At, 1, 0); PG8_STAGE(PG8_SA(0, 1), a2 + hstep, voffA);
            PG8_WAIT_V(8); PG8_WAIT_L(0); PG8_BAR; PG8_MMA(0, 0, At, B0); PG8_MMA(0, 1, At, B1); PG8_BAR; PG8_SCHED;
            PG8_LDA(At, 1, 1); PG8_STAGE(PG8_SB(1, 0), b3, voffB); PG8_STAGE(PG8_SB(1, 1), b3 + hstep, voffB); PG8_STAGE(PG8_SA(1, 0), a3, voffA);
            PG8_WAIT_V(8); PG8_WAIT_L(0); PG8_BAR; PG8_MMA(1, 0, At, B0); PG8_MMA(1, 1, At, B1); PG8_BAR; PG8_SCHED;
            } else {
            PG8_LDB(B0, 0, 0); PG8_SCHED; PG8_LDA(At, 0, 0); PG8_STAGE(PG8_SA(1, 1), a1 + hstep, voffA);
            PG8_WAIT_L(8); PG8_BAR; PG8_WAIT_L(0); PG8_MMA(0, 0, At, B0); PG8_BAR; PG8_SCHED;
            PG8_LDB(B1, 0, 1); PG8_STAGE(PG8_SB(0, 0), b2, voffB);
            PG8_BAR; PG8_WAIT_L(0); PG8_MMA(0, 1, At, B1); PG8_BAR;
            PG8_LDA(At, 0, 1); PG8_STAGE(PG8_SA(0, 0), a2, voffA);
            PG8_BAR; PG8_WAIT_L(0); PG8_MMA(1, 0, At, B0); PG8_BAR; PG8_SCHED;
            PG8_STAGE(PG8_SB(0, 1), b2 + hstep, voffB);
            PG8_WAIT_V(6); PG8_BAR; PG8_MMA(1, 1, At, B1); PG8_BAR;
            PG8_LDB(B0, 1, 0); PG8_SCHED; PG8_LDA(At, 1, 0); PG8_STAGE(PG8_SA(0, 1), a2 + hstep, voffA);
            PG8_WAIT_L(8); PG8_BAR; PG8_WAIT_L(0); PG8_MMA(0, 0, At, B0); PG8_BAR; PG8_SCHED;
            PG8_LDB(B1, 1, 1); PG8_STAGE(PG8_SB(1, 0), b3, voffB);
            PG8_BAR; PG8_WAIT_L(0); PG8_MMA(0, 1, At, B1); PG8_BAR;
            PG8_LDA(At, 1, 1); PG8_STAGE(PG8_SA(1, 0), a3, voffA);
            PG8_BAR; PG8_WAIT_L(0); PG8_MMA(1, 0, At, B0); PG8_BAR; PG8_SCHED;
            PG8_STAGE(PG8_SB(1, 1), b3 + hstep, voffB);
            PG8_WAIT_V(6); PG8_BAR; PG8_MMA(1, 1, At, B1); PG8_BAR;
            }
        }
        if constexpr (ALIGN_EPI) { if (wr == 0) PG8_BAR; }
        if constexpr (!Epi::AFTER_DRAIN) { E(acc, cur, wr, wc, fr, fq); S.done(cur); }
        if (!has_next) break;
#pragma unroll
        for (int a = 0; a < 2; ++a)
#pragma unroll
            for (int b = 0; b < 2; ++b)
#pragma unroll
                for (int m = 0; m < 4; ++m)
#pragma unroll
                    for (int n = 0; n < 2; ++n) acc[a][b][m][n] = (f32x4){0.f, 0.f, 0.f, 0.f};
        cur = nxt; cA = nA; cB = nB; ++ui;
        if constexpr (ALIGN_EPI) { if (wr == 1) PG8_BAR; }
    }
    PG8_WAIT_V(0);
    if constexpr (!ALIGN_EPI) { if (wr == 0) PG8_BAR; }
    PG8_BAR;
    if constexpr (Epi::AFTER_DRAIN) { E.fused(acc, cur, wr, wc, fr, fq, lds, wid, lane); S.done(cur); }
#undef PG8_SA
#undef PG8_SB
#undef PG8_STAGE
#undef PG8_LDA
#undef PG8_LDB
#undef PG8_MMA
#undef PG8_WAIT_V
#undef PG8_WAIT_L
#undef PG8_BAR
#undef PG8_SCHED
}
}


#ifndef MK_MULTI
#define MK_MULTI 0
#endif
#define DI __device__ __forceinline__
#define LAS __attribute__((address_space(3)))
typedef unsigned short bf16;
typedef short bf16x8 __attribute__((ext_vector_type(8)));
typedef float f32x4 __attribute__((ext_vector_type(4)));
typedef float f32x16 __attribute__((ext_vector_type(16)));
typedef unsigned u32x4 __attribute__((ext_vector_type(4)));
typedef unsigned u32x2 __attribute__((ext_vector_type(2)));
typedef float f32x2_t __attribute__((ext_vector_type(2)));
typedef __bf16 bf16x2_t __attribute__((ext_vector_type(2)));
typedef LAS unsigned char* lptr;


constexpr int SEQ = 2048, DM = 1024, TH = 16384  , DFF = 4096, DIN = 9632;
constexpr float EPS = 1e-6f, LOG2E = 1.4426950408889634f;
constexpr float QSC_DIFF = 0.125f * LOG2E;
constexpr float QSC_MLA = 0.10206207261596575f * LOG2E;
constexpr float KSC_RET = 0.08838834764831845f;
constexpr int NTHR = 512;
constexpr int LDS_BYTES = 147456;

constexpr size_t MiB = 1u << 20;
constexpr size_t WS_CNT = 0, WS_LAM = 256, WS_BIAS = 1024, WS_GAIN = 65536;
constexpr size_t WS_SUBG = WS_GAIN + 4 * 2 * 1024 * 4;
constexpr size_t WS_RCOS = 1 * MiB, WS_RSIN = WS_RCOS + 512 * 1024, WS_MCOS = 2 * MiB, WS_MSIN = WS_MCOS + 128 * 1024;
constexpr size_t WS_W = 4 * MiB;
constexpr size_t WO_IN1 = 0, WO_V = WO_IN1 + 4608 * 1024, WO_G = WO_V + 2048 * 1024, WO_UQ = WO_G + 3072 * 1024, WO_UK = WO_UQ + 1536 * 256,
                 WO_UV = WO_UK + 1024 * 256, WO_RO = WO_UV + 1024 * 256, WO_DO = WO_RO + 1024 * 1024, WO_MO = WO_DO + 1024 * 1024, WO_OUT = WO_MO + 1024 * 1024,
                 WO_UP = WO_OUT + 1024 * 1024, WO_DOWN = WO_UP + 4096 * 1024, WO_END = WO_DOWN + 4096 * 1024;
static_assert(WS_W + 2 * WO_END * 2 <= 96 * MiB, "weights fit");
constexpr size_t WS_H = 96 * MiB;
constexpr size_t WS_RQ = 128 * MiB, WS_RK = 144 * MiB, WS_RVT = 160 * MiB, WS_RG = 192 * MiB, WS_G = 128 * MiB;
constexpr size_t WS_DQ = 224 * MiB, WS_DK = 256 * MiB, WS_DVT = 288 * MiB, WS_M32 = 256 * MiB;
constexpr size_t WS_CQ = 320 * MiB, WS_CKV = 328 * MiB  , WS_KPE = 336 * MiB, WS_SSQ_CQ = 337 * MiB, WS_SSQ_CKV = WS_SSQ_CQ + 256 * 1024;
constexpr size_t WS_QMN = 338 * MiB, WS_QMP = 370 * MiB, WS_KMN = 386 * MiB, WS_VMT = 418 * MiB, WS_RO = 450 * MiB;
constexpr size_t WS_MG = 370 * MiB, WS_Y = 402 * MiB, WS_SSQ_Y = 434 * MiB, WS_U = 128 * MiB, WS_END = 482 * MiB;

struct Params {
    const float *x, *rel_bias, *pre_mix_g, *w_in, *w_ret_o, *lq1, *lk1, *lq2, *lk2, *subln_g, *w_diff_o, *q_norm_g, *w_uq, *kv_norm_g, *w_ukv, *w_mla_o,
                *w_out, *post_mix_g, *pre_mlp_g, *w_up, *w_down, *post_mlp_g;
    float* out; unsigned char* ws; int ph_lo, ph_hi;
};

DI unsigned cvtpk(float lo, float hi) { f32x2_t v = {lo, hi}; bf16x2_t b = __builtin_convertvector(v, bf16x2_t); return __builtin_bit_cast(unsigned, b); }
DI u32x4 pack8(f32x4 a, f32x4 b) { u32x4 w; w.x = cvtpk(a[0], a[1]); w.y = cvtpk(a[2], a[3]); w.z = cvtpk(b[0], b[1]); w.w = cvtpk(b[2], b[3]); return w; }
DI float bflo(unsigned u) { return __uint_as_float(u << 16); }
DI float bfhi(unsigned u) { return __uint_as_float(u & 0xffff0000u); }
DI void unpack8(u32x4 w, f32x4& a, f32x4& b) { a = (f32x4){bflo(w.x), bfhi(w.x), bflo(w.y), bfhi(w.y)}; b = (f32x4){bflo(w.z), bfhi(w.z), bflo(w.w), bfhi(w.w)}; }
DI float ex2(float x) { return __builtin_amdgcn_exp2f(x); }
DI float sigm(float x) { return __builtin_amdgcn_rcpf(1.f + ex2(-x * LOG2E)); }
DI float shx(float v, int m, int lane) { return __int_as_float(__builtin_amdgcn_ds_bpermute((lane ^ m) << 2, __float_as_int(v))); }
DI float wave_sum(float v, int lane) {
#pragma unroll
    for (int o = 1; o < 64; o <<= 1) v += shx(v, o, lane);
    return v;
}
DI float sq4(f32x4 v) { return (v[0] * v[0] + v[1] * v[1]) + (v[2] * v[2] + v[3] * v[3]); }

DI int colmap(int map, int n, int off) {
    switch (map) {
        case 0: return off + n;
        case 1: { const int p = n & 127, bj = (n >> 7) & 1; return off + (n & ~255) + (p >> 6) * 128 + bj * 64 + (p & 63); }
        case 2: { if (n < 128) return 6400 + n; if (n >= 160) return -1; const int q = n - 128; return 6528 + 16 * ((q >> 2) & 1) + 4 * (q >> 3) + (q & 3); }
        case 3: { if (n < 1024) return (n >> 6) * 96 + (n & 63); const int q = n - 1024, hh = q >> 5, pos = q & 31; return hh * 96 + 64 + 16 * ((pos >> 2) & 1) + 4 * (pos >> 3) + (pos & 3); }
        case 4: return (n >> 6) * 128 + (n & 63);
        default: return (n >> 6) * 128 + 64 + (n & 63);
    }
}
DI void conv_item(const float* W, int ldw, int K, int kvalid, bf16* WT, int map, int off, const float* gs, LAS float* scr, int item, int nblk, int lane) {
    const int kb = item / nblk, nb = item % nblk, k0 = 64 * kb, n0 = 32 * nb;
    const int oc = colmap(map, n0 + (lane & 31), off);
#pragma unroll 8
    for (int i = 0; i < 32; ++i) { const int kk = 2 * i + (lane >> 5); float v = 0.f; if (oc >= 0 && k0 + kk < kvalid) { v = W[(size_t)(k0 + kk) * ldw + oc]; if (gs) v *= gs[k0 + kk]; } scr[kk * 33 + (lane & 31)] = v; }
    asm volatile("s_waitcnt lgkmcnt(0)" ::: "memory");
    const int c = lane & 7;
#pragma unroll
    for (int j = 0; j < 4; ++j) { const int n = (lane >> 3) + 8 * j; const LAS float* s = scr + (8 * c) * 33 + n;
        u32x4 o; o.x = cvtpk(s[0 * 33], s[1 * 33]); o.y = cvtpk(s[2 * 33], s[3 * 33]); o.z = cvtpk(s[4 * 33], s[5 * 33]); o.w = cvtpk(s[6 * 33], s[7 * 33]);
        *(u32x4*)(WT + (size_t)(n0 + n) * K + k0 + 8 * c) = o; }
    asm volatile("s_waitcnt lgkmcnt(0)" ::: "memory");
}
DI int t5_bucket(int n) {
    if (n < 16) return n;
    int large = 16 + (int)(logf((float)n / 16.f) / 2.0794415416798357f * 16.f);
    return large < 31 ? large : 31;
}
DI void prologue(const Params& p, lptr lds, int wv) {
    const int tid = tidx(wv), lane = tid & 63, wave = tid >> 6;
    const int gw = blockIdx.x * 8 + wave, NGW = gridDim.x * 8, gt = blockIdx.x * NTHR + tid, NGT = gridDim.x * NTHR;
    unsigned char* ws = p.ws;
    if (blockIdx.x == 0) {
        if (tid < 16) ((unsigned*)(ws + WS_CNT))[tid] = 0u;
        if (tid >= 64 && tid < 66) {
            const int l = tid - 64; float a = 0.f, b = 0.f;
            for (int i = 0; i < 64; ++i) { a += p.lq1[l * 64 + i] * p.lk1[l * 64 + i]; b += p.lq2[l * 64 + i] * p.lk2[l * 64 + i]; }
            const float linit = 0.8f - 0.6f * expf(-0.3f * (float)l);
            ((float*)(ws + WS_LAM))[l] = expf(a) - expf(b) + linit; ((float*)(ws + WS_LAM))[2 + l] = 1.f - linit;
        }
    }
    for (int i = gt; i < 2048; i += NGT) { float* gd = (float*)(ws + WS_GAIN); gd[i] = p.pre_mix_g[i]; gd[2048 + i] = p.post_mix_g[i]; gd[4096 + i] = p.pre_mlp_g[i]; gd[6144 + i] = p.post_mlp_g[i]; if (i < 256) ((float*)(ws + WS_SUBG))[i] = p.subln_g[i]; }
    for (int i = gt; i < 8 * 128; i += NGT) { const int hh = i >> 7, n = i & 127; ((float*)(ws + WS_BIAS))[i] = p.rel_bias[t5_bucket(n) * 8 + hh] * LOG2E; }
    for (int i = gt; i < SEQ * 64; i += NGT) { const int s = i >> 6, d = i & 63; const float inv = (float)(1.0 / pow(10000.0, (double)d / 63.0)); const float ang = (float)s * inv;
        ((float*)(ws + WS_RCOS))[i] = (float)cos((double)ang); ((float*)(ws + WS_RSIN))[i] = (float)sin((double)ang); }
    for (int i = gt; i < SEQ * 16; i += NGT) { const int s = i >> 4, d = i & 15; const float inv = (float)(1.0 / pow(10000.0, (double)(2 * d) / 32.0)); const float ang = (float)s * inv;
        ((float*)(ws + WS_MCOS))[i] = (float)cos((double)ang); ((float*)(ws + WS_MSIN))[i] = (float)sin((double)ang); }
    LAS float* scr = (LAS float*)(lds + wave * 16384);
    constexpr int NJ = 19, ITEMS_L = 11456;
    for (int itg = gw; itg < 2 * ITEMS_L; itg += NGW) {
        const int l = itg / ITEMS_L; int it = itg - l * ITEMS_L;
        bf16* Wb = (bf16*)(ws + WS_W) + (size_t)l * WO_END;
        const float* win = p.w_in + (size_t)l * DM * DIN;
        int job = 0;
        {   const int cnt[NJ] = {256, 256, 512, 512, 512, 128, 128, 512, 512, 1536, 192, 128, 128, 512, 512, 512, 512, 2048, 2048};
#pragma unroll
            for (int j = 0; j < NJ - 1; ++j) { if (job == j && it >= cnt[j]) { it -= cnt[j]; job = j + 1; } } }
        const float* src = win; int ldw = DIN, K = 1024, kvalid = 4096, ns = 1024, map = 0, off = 0; const float* gs = nullptr; bf16* dst = Wb;
        switch (job) {
            case 0: ns = 512; map = 1; off = 0; dst = Wb + WO_IN1; break;
            case 1: ns = 512; map = 1; off = 512; dst = Wb + WO_IN1 + (size_t)512 * 1024; break;
            case 2: off = 2048; dst = Wb + WO_IN1 + (size_t)1024 * 1024; break;
            case 3: off = 3072; dst = Wb + WO_IN1 + (size_t)2048 * 1024; break;
            case 4: off = 4096; dst = Wb + WO_IN1 + (size_t)3072 * 1024; break;
            case 5: ns = 256; off = 6144; dst = Wb + WO_IN1 + (size_t)4096 * 1024; break;
            case 6: ns = 256; map = 2; dst = Wb + WO_IN1 + (size_t)4352 * 1024; break;
            case 7: off = 1024; dst = Wb + WO_V; break;
            case 8: off = 5120; dst = Wb + WO_V + (size_t)1024 * 1024; break;
            case 9: ns = 3072; off = 6560; dst = Wb + WO_G; break;
            case 10: src = p.w_uq + (size_t)l * 256 * 1536; ldw = 1536; K = 256; ns = 1536; map = 3; gs = p.q_norm_g + l * 256; dst = Wb + WO_UQ; break;
            case 11: src = p.w_ukv + (size_t)l * 128 * 2048; ldw = 2048; K = 256; kvalid = 128; map = 4; gs = p.kv_norm_g + l * 128; dst = Wb + WO_UK; break;
            case 12: src = p.w_ukv + (size_t)l * 128 * 2048; ldw = 2048; K = 256; kvalid = 128; map = 5; gs = p.kv_norm_g + l * 128; dst = Wb + WO_UV; break;
            case 13: src = p.w_ret_o + (size_t)l * 1024 * 1024; ldw = 1024; dst = Wb + WO_RO; break;
            case 14: src = p.w_diff_o + (size_t)l * 1024 * 1024; ldw = 1024; dst = Wb + WO_DO; break;
            case 15: src = p.w_mla_o + (size_t)l * 1024 * 1024; ldw = 1024; dst = Wb + WO_MO; break;
            case 16: src = p.w_out + (size_t)l * 1024 * 1024; ldw = 1024; dst = Wb + WO_OUT; break;
            case 17: src = p.w_up + (size_t)l * 1024 * 4096; ldw = 4096; ns = 4096; dst = Wb + WO_UP; break;
            default: src = p.w_down + (size_t)l * 4096 * 1024; ldw = 1024; K = 4096; dst = Wb + WO_DOWN; break;
        }
        conv_item(src, ldw, K, kvalid, dst, map, off, gs, scr, it, ns / 32, lane);
    }
}

DI void norm_rows(const float* x, const float* g, bf16* o, int rows, int wv) {
    const int tid_ = tidx(wv); const int lane = tid_ & 63, gw = blockIdx.x * 8 + (tid_ >> 6), NGW = gridDim.x * 8;
    for (int m = gw; m < rows; m += NGW) {
        const f32x4* xr = (const f32x4*)(x + (size_t)m * DM) + lane; f32x4 v[4]; float s = 0.f;
#pragma unroll
        for (int j = 0; j < 4; ++j) { v[j] = xr[64 * j]; s += sq4(v[j]); }
        const float rs = 1.0f / sqrtf(wave_sum(s, lane) * (1.f / DM) + EPS);
        u32x2* o8 = (u32x2*)(o + (size_t)m * DM) + lane;
#pragma unroll
        for (int j = 0; j < 4; ++j) { const f32x4 gg = ((const f32x4*)g)[lane + 64 * j]; u32x2 w; w.x = cvtpk(v[j][0] * rs * gg[0], v[j][1] * rs * gg[1]); w.y = cvtpk(v[j][2] * rs * gg[2], v[j][3] * rs * gg[3]); o8[64 * j] = w; }
    }
}
DI void resid_rows(const float* xin, const bf16* y, const float* ssq, const float* gpost, float* xout, const float* gnext, bf16* hout, int rows, int wv, bool ablate = false) {
    const int tid_ = tidx(wv); const int lane = tid_ & 63, gw = blockIdx.x * 8 + (tid_ >> 6), NGW = gridDim.x * 8;
    for (int m = gw; m < rows; m += NGW) {
        const float part = lane < 16 ? ssq[(size_t)m * 16 + lane] : 0.f;
        float rs = 1.0f / sqrtf(wave_sum(part, lane) * (1.f / DM) + EPS);
#ifdef ABL_MLP
        if (!gnext || gnext == (const float*)0 + 1) rs = rs; if (ablate) rs = 0.f;
#endif
        const f32x4* xr = (const f32x4*)(xin + (size_t)m * DM) + lane; const u32x2* yr = (const u32x2*)(y + (size_t)m * DM) + lane; f32x4* xo = (f32x4*)(xout + (size_t)m * DM) + lane;
        f32x4 v[4]; float s = 0.f;
#pragma unroll
        for (int j = 0; j < 4; ++j) { const f32x4 xv = xr[64 * j]; const u32x2 yw = yr[64 * j]; const f32x4 gg = ((const f32x4*)gpost)[lane + 64 * j];
            f32x4 yv = (f32x4){bflo(yw.x), bfhi(yw.x), bflo(yw.y), bfhi(yw.y)};
            v[j] = xv + yv * rs * gg; xo[64 * j] = v[j]; s += sq4(v[j]); }
        if (gnext) {
            const float rs2 = 1.0f / sqrtf(wave_sum(s, lane) * (1.f / DM) + EPS);
            u32x2* o8 = (u32x2*)(hout + (size_t)m * DM) + lane;
#pragma unroll
            for (int j = 0; j < 4; ++j) { const f32x4 gg = ((const f32x4*)gnext)[lane + 64 * j]; u32x2 w; w.x = cvtpk(v[j][0] * rs2 * gg[0], v[j][1] * rs2 * gg[1]); w.y = cvtpk(v[j][2] * rs2 * gg[2], v[j][3] * rs2 * gg[3]); o8[64 * j] = w; }
        }
    }
}

#define EPI_ARGS const f32x4 (&acc)[2][2][4][2], const pg8::Unit& u, int wr, int wc, int fr, int fq
#define FOR_AI_M _Pragma("unroll") for (int ai = 0; ai < 2; ++ai) _Pragma("unroll") for (int m = 0; m < 4; ++m)
#define FOR_BJ _Pragma("unroll") for (int bj = 0; bj < 2; ++bj)

struct EpiIn1 {
    static constexpr bool PERM = true, AFTER_DRAIN = false;
    unsigned char* ws;
    DI void operator()(EPI_ARGS) const {
        asm volatile("" : "+v"(fr), "+v"(fq));
        bf16 *RQ = (bf16*)(ws + WS_RQ), *RK = (bf16*)(ws + WS_RK), *RG = (bf16*)(ws + WS_RG), *DQ = (bf16*)(ws + WS_DQ), *DK = (bf16*)(ws + WS_DK), *CQ = (bf16*)(ws + WS_CQ), *CKV = (bf16*)(ws + WS_CKV), *KPE = (bf16*)(ws + WS_KPE);
        float *SSQ_CQ = (float*)(ws + WS_SSQ_CQ), *SSQ_CKV = (float*)(ws + WS_SSQ_CKV);
        const float *rcos = (const float*)(ws + WS_RCOS), *rsin = (const float*)(ws + WS_RSIN), *mcos = (const float*)(ws + WS_MCOS), *msin = (const float*)(ws + WS_MSIN);
        const int pn = u.pn, row0 = u.pm * 256 + wr * 64 + fr, c8 = wc * 32 + 8 * fq;
        if (pn < 4) {
            bf16* dst = pn < 2 ? RQ : RK; const int head = 2 * (pn & 1) + (wc >> 1), d0 = c8 & 63;
            const float l2g = log2f(1.f - ex2(-5.f - (float)head)), l2s = pn < 2 ? l2g : -l2g, sc0 = pn < 2 ? 1.f : KSC_RET;
            FOR_AI_M { const int t = row0 + ai * 128 + m * 16, s = t & (SEQ - 1); const float sc = sc0 * ex2(l2s * (float)(s & 63));
                const f32x4 c0 = *(const f32x4*)(rcos + s * 64 + d0), c1 = *(const f32x4*)(rcos + s * 64 + d0 + 4), s0 = *(const f32x4*)(rsin + s * 64 + d0), s1 = *(const f32x4*)(rsin + s * 64 + d0 + 4);
                const f32x4 x1a = acc[ai][0][m][0], x1b = acc[ai][0][m][1], x2a = acc[ai][1][m][0], x2b = acc[ai][1][m][1];
                bf16* o = dst + (size_t)t * 512 + head * 128 + d0;
                *(u32x4*)o = pack8((x1a * c0 - x2a * s0) * sc, (x1b * c1 - x2b * s1) * sc);
                *(u32x4*)(o + 64) = pack8((x2a * c0 + x1a * s0) * sc, (x2b * c1 + x1b * s1) * sc); asm volatile("" ::: "memory"); }
        } else if (pn < 16) {
            const int seg = (pn - 4) >> 2; bf16* dst = seg == 0 ? RG : (seg == 1 ? DQ : DK); const int colb = ((pn - 4) & 3) * 256 + c8;
            FOR_AI_M { const int t = row0 + ai * 128 + m * 16;
                FOR_BJ { f32x4 v0 = acc[ai][bj][m][0], v1 = acc[ai][bj][m][1];
                    if (seg == 0) {
#pragma unroll
                        for (int i = 0; i < 4; ++i) { v0[i] = v0[i] * sigm(v0[i]); v1[i] = v1[i] * sigm(v1[i]); } }
                    else if (seg == 1) { v0 = v0 * QSC_DIFF; v1 = v1 * QSC_DIFF; }
                    *(u32x4*)(dst + (size_t)t * 1024 + colb + bj * 128) = pack8(v0, v1); } }
        } else if (pn == 16) {
            FOR_AI_M { const int t = row0 + ai * 128 + m * 16; float ss = 0.f;
                FOR_BJ { const f32x4 v0 = acc[ai][bj][m][0], v1 = acc[ai][bj][m][1]; ss += sq4(v0) + sq4(v1); *(u32x4*)(CQ + (size_t)t * 256 + c8 + bj * 128) = pack8(v0, v1); }
                ss += shx(ss, 16, fq * 16 + fr); ss += shx(ss, 32, fq * 16 + fr);
                if (fq == 0) SSQ_CQ[(size_t)t * 4 + wc] = ss; }
        } else {
            FOR_AI_M { const int t = row0 + ai * 128 + m * 16, s = t & (SEQ - 1);
                const f32x4 v0 = acc[ai][0][m][0], v1 = acc[ai][0][m][1]; float ss = sq4(v0) + sq4(v1);
                *(u32x4*)(CKV + (size_t)t * 256 + c8) = pack8(v0, v1); *(u32x4*)(CKV + (size_t)t * 256 + 128 + c8) = pack8(acc[ai][1][m][0], acc[ai][1][m][1]);
                ss += shx(ss, 16, fq * 16 + fr); ss += shx(ss, 32, fq * 16 + fr);
                if (fq == 0) SSQ_CKV[(size_t)t * 4 + wc] = ss;
                if (wc == 0) { const f32x4 x1 = acc[ai][1][m][0], x2 = acc[ai][1][m][1]; const f32x4 c = *(const f32x4*)(mcos + s * 16 + 4 * fq), sn = *(const f32x4*)(msin + s * 16 + 4 * fq);
                    const f32x4 o1 = x1 * c - x2 * sn, o2 = x2 * c + x1 * sn; u32x2 w1, w2; w1.x = cvtpk(o1[0], o1[1]); w1.y = cvtpk(o1[2], o1[3]); w2.x = cvtpk(o2[0], o2[1]); w2.y = cvtpk(o2[2], o2[3]);
                    *(u32x2*)(KPE + (size_t)t * 32 + 4 * fq) = w1; *(u32x2*)(KPE + (size_t)t * 32 + 16 + 4 * fq) = w2; } }
        }
    }
};
struct EpiVt {
    static constexpr bool PERM = true, AFTER_DRAIN = false;
    bf16 *T0, *T1; const float* ssq; float inv_n;
    DI void operator()(EPI_ARGS) const {
        asm volatile("" : "+v"(fr), "+v"(fq));
        const int b = u.pn >> 3, s0 = (u.pn & 7) * 256 + wc * 32 + 8 * fq;
        float rs[2][8];
        FOR_BJ {
#pragma unroll
            for (int k = 0; k < 8; ++k) { rs[bj][k] = 1.f; if (ssq) { const f32x4 q = *(const f32x4*)(ssq + (size_t)(b * SEQ + s0 + bj * 128 + k) * 4); rs[bj][k] = 1.0f / sqrtf(((q[0] + q[1]) + (q[2] + q[3])) * inv_n + EPS); } } }
        FOR_AI_M { const int R = u.pm * 256 + ai * 128 + wr * 64 + m * 16 + fr;
            bf16* rowp = (R < 1024 ? T0 + (size_t)(b * 1024 + R) * SEQ : T1 + (size_t)(b * 1024 + R - 1024) * SEQ) + s0;
            FOR_BJ { f32x4 v0 = acc[ai][bj][m][0], v1 = acc[ai][bj][m][1];
#pragma unroll
                for (int i = 0; i < 4; ++i) { v0[i] *= rs[bj][i]; v1[i] *= rs[bj][4 + i]; }
                *(u32x4*)(rowp + bj * 128) = pack8(v0, v1); } }
    }
};
struct EpiUq {
    static constexpr bool PERM = true, AFTER_DRAIN = false;
    bf16 *QMn, *QMp; const float *ssq, *mcos, *msin; int wv;
    DI void operator()(EPI_ARGS) const {
        { const int t_ = tidx(wv); fr = t_ & 15; fq = (t_ >> 4) & 3; }
        const int pn = u.pn, row0 = u.pm * 256 + wr * 64 + fr, c8 = wc * 32 + 8 * fq;
        FOR_AI_M { const int t = row0 + ai * 128 + m * 16, s = t & (SEQ - 1);
            const f32x4 q = *(const f32x4*)(ssq + (size_t)t * 4); const float rs = QSC_MLA / sqrtf(((q[0] + q[1]) + (q[2] + q[3])) * (1.f / 256.f) + EPS);
            if (pn < 4) { FOR_BJ { *(u32x4*)(QMn + (size_t)t * 1024 + pn * 256 + bj * 128 + c8) = pack8(acc[ai][bj][m][0] * rs, acc[ai][bj][m][1] * rs); } }
            else { const f32x4 c = *(const f32x4*)(mcos + s * 16 + 4 * fq), sn = *(const f32x4*)(msin + s * 16 + 4 * fq);
                FOR_BJ { const int hh = (pn - 4) * 8 + bj * 4 + wc; const f32x4 x1 = acc[ai][bj][m][0] * rs, x2 = acc[ai][bj][m][1] * rs;
                    const f32x4 o1 = x1 * c - x2 * sn, o2 = x2 * c + x1 * sn; u32x2 w1, w2; w1.x = cvtpk(o1[0], o1[1]); w1.y = cvtpk(o1[2], o1[3]); w2.x = cvtpk(o2[0], o2[1]); w2.y = cvtpk(o2[2], o2[3]);
                    *(u32x2*)(QMp + (size_t)t * 512 + hh * 32 + 4 * fq) = w1; *(u32x2*)(QMp + (size_t)t * 512 + hh * 32 + 16 + 4 * fq) = w2; } }
            asm volatile("" ::: "memory");
        }
    }
};
struct EpiUk {
    static constexpr bool PERM = true, AFTER_DRAIN = false;
    bf16* KMn; const float* ssq;
    DI void operator()(EPI_ARGS) const {
        asm volatile("" : "+v"(fr), "+v"(fq));
        const int row0 = u.pm * 256 + wr * 64 + fr, c8 = wc * 32 + 8 * fq;
        FOR_AI_M { const int t = row0 + ai * 128 + m * 16;
            const f32x4 q = *(const f32x4*)(ssq + (size_t)t * 4); const float rs = 1.0f / sqrtf(((q[0] + q[1]) + (q[2] + q[3])) * (1.f / 128.f) + EPS);
            FOR_BJ { *(u32x4*)(KMn + (size_t)t * 1024 + u.pn * 256 + bj * 128 + c8) = pack8(acc[ai][bj][m][0] * rs, acc[ai][bj][m][1] * rs); } }
    }
};
template <int ACT  > struct EpiAct {
    static constexpr bool PERM = true, AFTER_DRAIN = false;
    bf16* O; int ldc;
    DI void operator()(EPI_ARGS) const {
        asm volatile("" : "+v"(fr), "+v"(fq));
        const int row0 = u.pm * 256 + wr * 64 + fr, c8 = u.pn * 256 + wc * 32 + 8 * fq;
        FOR_AI_M { const int t = row0 + ai * 128 + m * 16;
            FOR_BJ { f32x4 v0 = acc[ai][bj][m][0], v1 = acc[ai][bj][m][1];
#pragma unroll
                for (int i = 0; i < 4; ++i) { if (ACT == 0) { v0[i] = sigm(v0[i]); v1[i] = sigm(v1[i]); } else { const float a = fmaxf(v0[i], 0.f), b = fmaxf(v1[i], 0.f); v0[i] = a * a; v1[i] = b * b; } }
                *(u32x4*)(O + (size_t)t * ldc + c8 + bj * 128) = pack8(v0, v1); } }
    }
};
template <int I> struct EpiBranch {
    static constexpr bool PERM = true, AFTER_DRAIN = false;
    const bf16* G; float* M32; bf16* MG;
    DI void operator()(EPI_ARGS) const {
        asm volatile("" : "+v"(fr), "+v"(fq));
        const int row0 = u.pm * 256 + wr * 64 + fr, c8 = u.pn * 256 + wc * 32 + 8 * fq;
        FOR_AI_M { const int t = row0 + ai * 128 + m * 16;
            FOR_BJ { const size_t idx = (size_t)t * 1024 + c8 + bj * 128; f32x4 g0, g1; unpack8(*(const u32x4*)(G + idx), g0, g1);
                f32x4 v0 = acc[ai][bj][m][0] * g0, v1 = acc[ai][bj][m][1] * g1;
#ifdef ABL_BRANCH
                if (I == ABL_BRANCH) { v0 = v0 * 0.f; v1 = v1 * 0.f; }
#endif
                if (I > 0) { v0 = v0 + *(const f32x4*)(M32 + idx); v1 = v1 + *(const f32x4*)(M32 + idx + 4); }
                if (I < 2) { *(f32x4*)(M32 + idx) = v0; *(f32x4*)(M32 + idx + 4) = v1; } else *(u32x4*)(MG + idx) = pack8(v0, v1); } }
    }
};
struct EpiY {
    static constexpr bool PERM = true, AFTER_DRAIN = false;
    bf16* Y; float* SSQ;
    DI void operator()(EPI_ARGS) const {
        asm volatile("" : "+v"(fr), "+v"(fq));
        const int row0 = u.pm * 256 + wr * 64 + fr, c8 = u.pn * 256 + wc * 32 + 8 * fq;
        FOR_AI_M { const int t = row0 + ai * 128 + m * 16; float ss = 0.f;
            FOR_BJ { const f32x4 v0 = acc[ai][bj][m][0], v1 = acc[ai][bj][m][1]; ss += sq4(v0) + sq4(v1); *(u32x4*)(Y + (size_t)t * 1024 + c8 + bj * 128) = pack8(v0, v1); }
            ss += shx(ss, 16, fq * 16 + fr); ss += shx(ss, 32, fq * 16 + fr);
            if (fq == 0) SSQ[(size_t)t * 16 + u.pn * 4 + wc] = ss; }
    }
};

template <int MODE> struct AC;
template <> struct AC<0> { static constexpr int DQK = 128, KW = 128, DVW = 128, VTR = 256, QR = 128; };
template <> struct AC<1> { static constexpr int DQK = 64, KW = 128, DVW = 128, VTR = 128, QR = 128; };
template <> struct AC<2> { static constexpr int DQK = 96, KW = 96, DVW = 64, VTR = 64, QR = 256; };
constexpr int A_KBUF = 17408, A_VBUF = 36864, A_V0 = 2 * A_KBUF, A_MISC = 2 * A_KBUF + 2 * A_VBUF;
constexpr int A_LUT = A_MISC + 64, A_XCH = A_MISC + 1024;
static_assert(A_XCH + 2048 <= LDS_BYTES, "attention LDS map");
struct AttnP { unsigned char* ws; int l; };
struct AttnPtrs { const bf16 *RQ, *RK, *RVt, *RG; bf16* RO; bf16* DQ; const bf16 *DK, *DVt; bf16* QMn; const bf16 *QMp, *KMn, *KPE, *VMt; const float *biasl, *subg; float lam, oml; };

#pragma float_control(push)
#pragma float_control(precise, off)
template <int MODE> DI void attn_unit(lptr lds, const AttnP PP, const int b, const int hd, const int qb, const int wv) {
    using C = AC<MODE>;
    unsigned char* const ws = PP.ws;
    const AttnPtrs P{(const bf16*)(ws + WS_RQ), (const bf16*)(ws + WS_RK), (const bf16*)(ws + WS_RVT), (const bf16*)(ws + WS_RG), (bf16*)(ws + WS_RO), (bf16*)(ws + WS_DQ),
                     (const bf16*)(ws + WS_DK), (const bf16*)(ws + WS_DVT), (bf16*)(ws + WS_QMN), (const bf16*)(ws + WS_QMP), (const bf16*)(ws + WS_KMN), (const bf16*)(ws + WS_KPE),
                     (const bf16*)(ws + WS_VMT), (const float*)(ws + WS_BIAS), (const float*)(ws + WS_SUBG) + PP.l * 128, 0.f, 0.f};
    constexpr int NKS = C::DQK / 16, NVB = C::DVW / 32, KS = (C::KW + 8) * 2, VS = 144, KCH = C::KW / 8, NKC = 64 * KCH, NVR = C::VTR / 64;
    const int tid = tidx(wv), w = __builtin_amdgcn_readfirstlane(tid >> 6), lane = tid & 63, r = lane & 31, h = lane >> 5;
    const int rg = MODE == 2 ? w : (w >> 1), pp = MODE == 2 ? 0 : (w & 1);
    const int q0 = qb * C::QR, q0w = q0 + rg * 32, tok0 = b * SEQ, qq = q0w + r;
    const int ntiles = (q0 + C::QR) / 64;
    const bf16* Kg; const bf16* Vg;
    if (MODE == 0) { Kg = P.RK + (size_t)tok0 * 512 + hd * 128; Vg = P.RVt + (size_t)(b * 4 + hd) * 256 * SEQ; }
    else if (MODE == 1) { Kg = P.DK + (size_t)tok0 * 1024 + hd * 128; Vg = P.DVt + (size_t)(b * 8 + hd) * 128 * SEQ; }
    else { Kg = P.KMn + (size_t)tok0 * 1024 + hd * 64; Vg = P.VMt + (size_t)(b * 16 + hd) * 64 * SEQ; }
    const bf16* Kpe = P.KPE + (size_t)tok0 * 32;
    bf16x8 q[NKS];
    { const size_t t = (size_t)(tok0 + qq);
#pragma unroll
        for (int ks = 0; ks < NKS; ++ks) {
            const bf16* src;
            if (MODE == 0) src = P.RQ + t * 512 + hd * 128 + ks * 16 + 8 * h;
            else if (MODE == 1) src = P.DQ + t * 1024 + hd * 128 + pp * 64 + ks * 16 + 8 * h;
            else src = ks < 4 ? P.QMn + t * 1024 + hd * 64 + ks * 16 + 8 * h : P.QMp + t * 512 + hd * 32 + (ks - 4) * 16 + 8 * h;
            q[ks] = *(const bf16x8*)src; } }
    if (MODE == 1) { if (tid < 128) ((LAS float*)(lds + A_LUT))[tid] = P.biasl[hd * 128 + tid]; }
    u32x4 kreg[2], vreg[NVR];
#define A_GLOAD(kt) do { \
    _Pragma("unroll") for (int i_ = 0; i_ < 2; ++i_) { const int id_ = tid + 512 * i_; if (id_ < NKC) { const int row_ = id_ / KCH, cc_ = id_ % KCH; const size_t kr_ = (size_t)((kt) * 64 + row_); \
        const bf16* s_; if (MODE == 2) s_ = cc_ < 8 ? Kg + kr_ * 1024 + cc_ * 8 : Kpe + kr_ * 32 + (cc_ - 8) * 8; else s_ = Kg + kr_ * (MODE == 0 ? 512 : 1024) + cc_ * 8; kreg[i_] = *(const u32x4*)s_; } } \
    _Pragma("unroll") for (int i_ = 0; i_ < NVR; ++i_) { const int id_ = tid + 512 * i_, row_ = id_ >> 3, cc_ = id_ & 7; vreg[i_] = *(const u32x4*)(Vg + (size_t)row_ * SEQ + (kt) * 64 + cc_ * 8); } } while (0)
#define A_LWRITE(buf) do { \
    _Pragma("unroll") for (int i_ = 0; i_ < 2; ++i_) { const int id_ = tid + 512 * i_; if (id_ < NKC) { const int row_ = id_ / KCH, cc_ = id_ % KCH; *(LAS u32x4*)(lds + (buf) * A_KBUF + row_ * KS + cc_ * 16) = kreg[i_]; } } \
    _Pragma("unroll") for (int i_ = 0; i_ < NVR; ++i_) { const int id_ = tid + 512 * i_, row_ = id_ >> 3, cc_ = id_ & 7; *(LAS u32x4*)(lds + A_V0 + (buf) * A_VBUF + row_ * VS + cc_ * 16) = vreg[i_]; } } while (0)
    f32x16 O[NVB];
#pragma unroll
    for (int vb = 0; vb < NVB; ++vb)
#pragma unroll
        for (int i = 0; i < 16; ++i) O[vb][i] = 0.f;
    float mrun = -INFINITY, lrun = 0.f;
    const float l2g = MODE == 0 ? log2f(1.f - ex2(-5.f - (float)hd)) : 0.f;
    const float b31 = MODE == 1 ? P.biasl[hd * 128 + 127] : 0.f;
    const int pir = (r & 0x13) | ((r & 8) >> 1) | ((r & 4) << 1);
    const int koffb = ((MODE == 1 ? pp * 64 : 0) + 8 * h) * 2;
    const int vrow0 = (MODE == 0 ? pp * 128 : 0) + r;
    A_GLOAD(0); A_LWRITE(0);
    __syncthreads();
    for (int kt = 0; kt < ntiles; ++kt) {
        const int cur = kt & 1;
        if (kt + 1 < ntiles) A_GLOAD(kt + 1);
        if (kt * 64 <= q0w + 31) {
            const lptr Kb = lds + cur * A_KBUF + koffb, Vb = lds + A_V0 + cur * A_VBUF + (8 * h) * 2;
            f32x16 S0, S1;
#pragma unroll
            for (int i = 0; i < 16; ++i) { S0[i] = 0.f; S1[i] = 0.f; }
            {
                constexpr int CH = NKS > 6 ? 4 : NKS;
#pragma unroll
                for (int c0 = 0; c0 < NKS; c0 += CH) {
                    bf16x8 kf0[CH], kf1[CH];
#pragma unroll
                    for (int j = 0; j < CH; ++j) { kf0[j] = *(const LAS bf16x8*)(Kb + pir * KS + (c0 + j) * 32); kf1[j] = *(const LAS bf16x8*)(Kb + (32 + pir) * KS + (c0 + j) * 32); }
                    __builtin_amdgcn_sched_barrier(0);
                    __builtin_amdgcn_s_setprio(1);
#pragma unroll
                    for (int j = 0; j < CH; ++j) {
                        S0 = __builtin_amdgcn_mfma_f32_32x32x16_bf16(kf0[j], q[c0 + j], S0, 0, 0, 0);
                        S1 = __builtin_amdgcn_mfma_f32_32x32x16_bf16(kf1[j], q[c0 + j], S1, 0, 0, 0);
                    }
                    __builtin_amdgcn_s_setprio(0);
                    __builtin_amdgcn_sched_barrier(0);
                }
            }
            const int kb0 = kt * 64 + 8 * h;
            const bool diag = (kt * 64 + 63 > q0w);
            if (MODE == 0) {
                const float cs = ex2(l2g * (float)(64 * ((q0w >> 6) - kt)));
                if (diag) {
#pragma unroll
                    for (int i = 0; i < 16; ++i) { const int k0 = kb0 + 16 * (i >> 3) + (i & 7); S0[i] = (k0 <= qq) ? S0[i] * cs : 0.f; S1[i] = (k0 + 32 <= qq) ? S1[i] * cs : 0.f; }
                } else {
#pragma unroll
                    for (int i = 0; i < 16; ++i) { S0[i] *= cs; S1[i] *= cs; }
                }
            } else {
                float boff = 0.f;
                if (MODE == 1) {
                    if (q0w - (kt * 64 + 63) >= 113) boff = b31;
                    else {
                        const LAS float* lut = (const LAS float*)(lds + A_LUT);
#pragma unroll
                        for (int i = 0; i < 16; ++i) { const int k0 = kb0 + 16 * (i >> 3) + (i & 7); int d0 = qq - k0, d1 = d0 - 32;
                            d0 = d0 < 0 ? 0 : (d0 > 127 ? 127 : d0); d1 = d1 < 0 ? 0 : (d1 > 127 ? 127 : d1); S0[i] += lut[d0]; S1[i] += lut[d1]; }
                    }
                }
                if (diag) {
#pragma unroll
                    for (int i = 0; i < 16; ++i) { const int k0 = kb0 + 16 * (i >> 3) + (i & 7); if (k0 > qq) S0[i] = -INFINITY; if (k0 + 32 > qq) S1[i] = -INFINITY; }
                }
                float mx = fmaxf(S0[0], S1[0]);
#pragma unroll
                for (int i = 1; i < 16; ++i) mx = fmaxf(mx, fmaxf(S0[i], S1[i]));
                mx = fmaxf(mx, shx(mx, 32, lane)) + boff;
                if (__builtin_amdgcn_ballot_w64(mx - mrun > 8.f) != 0ull) {
                    const float mn = fmaxf(mrun, mx), al = ex2(mrun - mn); mrun = mn; lrun *= al;
#pragma unroll
                    for (int vb = 0; vb < NVB; ++vb)
#pragma unroll
                        for (int i = 0; i < 16; ++i) O[vb][i] *= al;
                }
                const float nmo = boff - mrun;
                const f32x2_t nm2 = {nmo, nmo}; f32x2_t ps2 = {0.f, 0.f};
#pragma unroll
                for (int i = 0; i < 8; ++i) {
                    f32x2_t a = (f32x2_t){S0[2 * i], S0[2 * i + 1]} + nm2, c = (f32x2_t){S1[2 * i], S1[2 * i + 1]} + nm2;
                    a.x = ex2(a.x); a.y = ex2(a.y); c.x = ex2(c.x); c.y = ex2(c.y); ps2 += a; ps2 += c;
                    S0[2 * i] = a.x; S0[2 * i + 1] = a.y; S1[2 * i] = c.x; S1[2 * i + 1] = c.y; }
                lrun += ps2.x + ps2.y;
            }
            bf16x8 pf[2][2];
#pragma unroll
            for (int s = 0; s < 2; ++s) {
                u32x4 t0, t1;
                t0.x = cvtpk(S0[8 * s + 0], S0[8 * s + 1]); t0.y = cvtpk(S0[8 * s + 2], S0[8 * s + 3]); t0.z = cvtpk(S0[8 * s + 4], S0[8 * s + 5]); t0.w = cvtpk(S0[8 * s + 6], S0[8 * s + 7]);
                t1.x = cvtpk(S1[8 * s + 0], S1[8 * s + 1]); t1.y = cvtpk(S1[8 * s + 2], S1[8 * s + 3]); t1.z = cvtpk(S1[8 * s + 4], S1[8 * s + 5]); t1.w = cvtpk(S1[8 * s + 6], S1[8 * s + 7]);
                pf[0][s] = __builtin_bit_cast(bf16x8, t0); pf[1][s] = __builtin_bit_cast(bf16x8, t1);
            }
#pragma unroll
            for (int vb = 0; vb < NVB; vb += 2) {
                bf16x8 vf[2][4];
#pragma unroll
                for (int u = 0; u < 2; ++u)
#pragma unroll
                    for (int j = 0; j < 4; ++j) vf[u][j] = *(const LAS bf16x8*)(Vb + (vrow0 + (vb + u) * 32) * VS + ((j >> 1) * 32 + 16 * (j & 1)) * 2);
                __builtin_amdgcn_sched_barrier(0);
                __builtin_amdgcn_s_setprio(1);
#pragma unroll
                for (int j = 0; j < 4; ++j) {
                    O[vb] = __builtin_amdgcn_mfma_f32_32x32x16_bf16(vf[0][j], pf[j >> 1][j & 1], O[vb], 0, 0, 0);
                    O[vb + 1] = __builtin_amdgcn_mfma_f32_32x32x16_bf16(vf[1][j], pf[j >> 1][j & 1], O[vb + 1], 0, 0, 0);
                }
                __builtin_amdgcn_s_setprio(0);
                __builtin_amdgcn_sched_barrier(0);
            }
        }
        if (kt + 1 < ntiles) A_LWRITE(cur ^ 1);
        __syncthreads();
    }
#undef A_GLOAD
#undef A_LWRITE
    const size_t trow = (size_t)(tok0 + qq);
    if (MODE == 0) {
        float ss = 0.f;
#pragma unroll
        for (int vb = 0; vb < NVB; ++vb)
#pragma unroll
            for (int i = 0; i < 16; ++i) ss += O[vb][i] * O[vb][i];
        ss += shx(ss, 32, lane);
        LAS float* xch = (LAS float*)(lds + A_XCH);
        if (h == 0) xch[w * 32 + r] = ss;
        __syncthreads();
        const float tot = ss + xch[(w ^ 1) * 32 + r];
        const float rs = 1.0f / sqrtf(tot * (1.f / 256.f) + EPS);
#pragma unroll
        for (int vb = 0; vb < NVB; ++vb)
#pragma unroll
            for (int g = 0; g < 4; ++g) { const size_t idx = trow * 1024 + hd * 256 + pp * 128 + vb * 32 + 8 * g + 4 * h; const u32x2 gw = *(const u32x2*)(P.RG + idx);
                u32x2 o; o.x = cvtpk(O[vb][4 * g] * rs * bflo(gw.x), O[vb][4 * g + 1] * rs * bfhi(gw.x)); o.y = cvtpk(O[vb][4 * g + 2] * rs * bflo(gw.y), O[vb][4 * g + 3] * rs * bfhi(gw.y));
                *(u32x2*)(P.RO + idx) = o; }
    } else if (MODE == 1) {
        const float lt = lrun + shx(lrun, 32, lane), il = 1.0f / lt;
        LAS float* X = (LAS float*)lds + (size_t)rg * 64 * 64;
        if (pp == 1) {
#pragma unroll
            for (int vb = 0; vb < NVB; ++vb)
#pragma unroll
                for (int i = 0; i < 16; ++i) X[(vb * 16 + i) * 64 + lane] = O[vb][i] * il;
        }
        __syncthreads();
        if (pp == 0) {
            const float lam = ((const float*)(ws + WS_LAM))[PP.l], oml = ((const float*)(ws + WS_LAM))[2 + PP.l];
            float ss = 0.f;
#pragma unroll
            for (int vb = 0; vb < NVB; ++vb)
#pragma unroll
                for (int i = 0; i < 16; ++i) { const float v = O[vb][i] * il - lam * X[(vb * 16 + i) * 64 + lane]; O[vb][i] = v; ss += v * v; }
            ss += shx(ss, 32, lane);
            const float rs = oml / sqrtf(ss * (1.f / 128.f) + EPS);
#pragma unroll
            for (int vb = 0; vb < NVB; ++vb)
#pragma unroll
                for (int g = 0; g < 4; ++g) { const int dv = vb * 32 + 8 * g + 4 * h; const f32x4 gg = *(const f32x4*)(P.subg + dv);
                    u32x2 o; o.x = cvtpk(O[vb][4 * g] * rs * gg[0], O[vb][4 * g + 1] * rs * gg[1]); o.y = cvtpk(O[vb][4 * g + 2] * rs * gg[2], O[vb][4 * g + 3] * rs * gg[3]);
                    *(u32x2*)(P.DQ + trow * 1024 + hd * 128 + dv) = o; }
        }
    } else {
        const float lt = lrun + shx(lrun, 32, lane), il = 1.0f / lt;
#pragma unroll
        for (int vb = 0; vb < NVB; ++vb)
#pragma unroll
            for (int g = 0; g < 4; ++g) { u32x2 o; o.x = cvtpk(O[vb][4 * g] * il, O[vb][4 * g + 1] * il); o.y = cvtpk(O[vb][4 * g + 2] * il, O[vb][4 * g + 3] * il);
                *(u32x2*)(P.QMn + trow * 1024 + hd * 64 + vb * 32 + 8 * g + 4 * h) = o; }
    }
}
#pragma float_control(pop)
DI void attn_phase(lptr lds, const AttnP P, unsigned* counter, const int wv) {
    for (;;) {
        __syncthreads();
        if (tidx(wv) == 0) *(LAS int*)(lds + A_MISC) = (int)atomicAdd(counter, 1u);
        __syncthreads();
        const int idx = __builtin_amdgcn_readfirstlane(*(LAS int*)(lds + A_MISC));
        if (idx >= 2560) break;
        const int pr = 7 - idx / 320, rem = idx % 320;
        if (rem < 128) attn_unit<2>(lds, P, rem >> 4, rem & 15, pr, wv);
        else if (rem < 160) { const int e = rem - 128; attn_unit<0>(lds, P, e >> 2, e & 3, 2 * pr + 1, wv); }
        else if (rem < 224) { const int e = rem - 160; attn_unit<1>(lds, P, e >> 3, e & 7, 2 * pr + 1, wv); }
        else if (rem < 256) { const int e = rem - 224; attn_unit<0>(lds, P, e >> 2, e & 3, 2 * pr, wv); }
        else { const int e = rem - 256; attn_unit<1>(lds, P, e >> 3, e & 7, 2 * pr, wv); }
    }
}


constexpr size_t WS_BAR = 131072;
#define XB_TMO      128
#define XB_XCNT(j)  (256  + 64 * (j))
#define XB_XSUB(j)  (1280 + 64 * (j))
#define XB_XGEN(j)  (2304 + 64 * (j))
#define XB_TOP      3328
#define XB_TOPGEN   3392
#define XCD_BAR_WORDS 3456
#define XB_SPIN_CAP (1u << 18)
constexpr int LDS_XB = 143360;
DI unsigned xb_ld(unsigned* p)              { return __hip_atomic_load(p, __ATOMIC_RELAXED, __HIP_MEMORY_SCOPE_AGENT); }
DI unsigned xb_add(unsigned* p, unsigned v) { return __hip_atomic_fetch_add(p, v, __ATOMIC_RELAXED, __HIP_MEMORY_SCOPE_AGENT); }
DI unsigned xb_xcc_id() { return (unsigned)__builtin_amdgcn_s_getreg((3 << 11) | 20) & 0xFu; }
#define XB_SPIN(cond, bar) do { unsigned _sp = 0; while (cond) { __builtin_amdgcn_s_sleep(1); \
    if ((++_sp & 255u) == 0u) { if (xb_ld(&(bar)[XB_TMO])) break; if (_sp > XB_SPIN_CAP) { atomicAdd(&(bar)[XB_TMO], 1u); break; } } } } while (0)
DI void xcd_barrier_complete(unsigned* bar, unsigned x, unsigned& nloc, unsigned& nx) {
    const unsigned G = gridDim.x;
    unsigned sum, cnt, mine, sp = 0u;
    for (;;) {
        sum = 0u; cnt = 0u; mine = 0u;
#pragma unroll
        for (unsigned j = 0; j < 16; ++j) { const unsigned c = xb_ld(&bar[XB_XCNT(j)]); sum += c; cnt += (c > 0u) ? 1u : 0u; mine = (j == x) ? c : mine; }
        if (sum == G) break;
        __builtin_amdgcn_s_sleep(1);
        if ((++sp & 255u) == 0u) { if (xb_ld(&bar[XB_TMO])) break; if (sp > XB_SPIN_CAP) { atomicAdd(&bar[XB_TMO], 1u); break; } }
    }
    nloc = mine > 0u ? mine : 1u; nx = cnt > 0u ? cnt : 1u;
}
DI void xcd_barrier(unsigned* bar, lptr lds, const int wv) {
    asm volatile("s_waitcnt vmcnt(0)" ::: "memory");
    __syncthreads();
    if (tidx(wv) == 0) {
        volatile LAS unsigned* st = (volatile LAS unsigned*)(lds + LDS_XB);
        const unsigned x = xb_xcc_id();
        __builtin_amdgcn_s_waitcnt(0);
        unsigned nloc = st[0], nx = st[1];
        if (nloc == 0u) { xcd_barrier_complete(bar, x, nloc, nx); st[0] = nloc; st[1] = nx; }
        const unsigned old = xb_add(&bar[XB_XSUB(x)], 1u);
        const unsigned gen = old / nloc;
        if (old + 1u == (gen + 1u) * nloc) {
            __builtin_amdgcn_fence(__ATOMIC_RELEASE, "agent");
            asm volatile("s_waitcnt vmcnt(0)" ::: "memory");
            const unsigned og = xb_add(&bar[XB_TOP], 1u);
            const unsigned tg = og / nx;
            if (og + 1u == (tg + 1u) * nx) xb_add(&bar[XB_TOPGEN], 1u);
            else XB_SPIN(xb_ld(&bar[XB_TOPGEN]) == tg, bar);
            __builtin_amdgcn_fence(__ATOMIC_ACQUIRE, "agent");
            xb_add(&bar[XB_XGEN(x)], 1u);
            asm volatile("s_waitcnt vmcnt(0)" ::: "memory");
        } else {
            XB_SPIN(xb_ld(&bar[XB_XGEN(x)]) == gen, bar);
            __builtin_amdgcn_fence(__ATOMIC_ACQUIRE, "agent");
            asm volatile("s_waitcnt vmcnt(0)" ::: "memory");
        }
    }
    __syncthreads();
}
constexpr int N_PHASES = 39;
template <class Epi> DI void run_gemm(lptr lds, int wv, const bf16* A, const bf16* Bt, int M, int N, int K, const Epi& E) {
#ifdef DIS_GEMM
    return;
#endif
    int bx_ = (int)blockIdx.x; asm volatile("" : "+s"(bx_));
    pg8::Gemm g{A, Bt, M, N, K}; pg8::StaticOrder S; S.init(M, N, (int)gridDim.x, bx_); S.wv = wv;
    pg8::gemm_phase<Epi, pg8::StaticOrder, true, true>(lds, g, S, E);
}
__global__ void __launch_bounds__(NTHR) mega_fwd(Params p) {
    extern __shared__ __attribute__((aligned(16))) unsigned char lds_raw[];
    lptr lds = (lptr)lds_raw;
#if !MK_MULTI
    cg::grid_group grid = cg::this_grid();
#endif
    const int wv = __builtin_amdgcn_readfirstlane((int)threadIdx.x >> 6);
#if !MK_MULTI
    if (threadIdx.x == 0) { ((volatile LAS unsigned*)(lds + LDS_XB))[0] = 0u; ((volatile LAS unsigned*)(lds + LDS_XB))[1] = 0u; (void)xb_add((unsigned*)(p.ws + WS_BAR) + XB_XCNT(xb_xcc_id()), 1u); }
    __syncthreads();
#endif
    int ph = p.ph_lo; const int ph_hi = p.ph_hi;
#ifdef MK_TS
    if (blockIdx.x == 0 && threadIdx.x == 0) ((unsigned long long*)(p.ws + 262144))[0] = __builtin_amdgcn_s_memrealtime();
#endif
    if (ph == 0) {
#ifndef DIS_PRO
        prologue(p, lds, wv);
#endif
        ++ph;
#if !MK_MULTI
        if (ph_hi < 0) grid.sync();
        if (ph < ph_hi) xcd_barrier((unsigned*)(p.ws + WS_BAR), lds, wv);
#endif
    }
    const float* xin0 = p.x; float* const outp = p.out; unsigned char* ws0 = p.ws;
    for (; ph < ph_hi; ++ph) {
        size_t z_ = 0; asm volatile("" : "+s"(z_));
        unsigned char* ws = ws0 + z_;
#ifdef MK_TS
        if (blockIdx.x == 0 && tidx(wv) == 0) ((unsigned long long*)(ws + 262144))[ph] = __builtin_amdgcn_s_memrealtime();
#endif
        const float* gains = (const float*)(ws + WS_GAIN);
        bf16* H = (bf16*)(ws + WS_H);
        const int hb = (ph - 1) / 19, k19 = (ph - 1) % 19;
        const size_t xoff = (size_t)hb * TH * DM;
        if (k19 == 0) norm_rows(xin0 + xoff, gains, H, TH, wv);
        else {
            const int l = (k19 - 1) / 9, k = (k19 - 1) % 9;
            const bf16* Wb = (const bf16*)(ws + WS_W) + (size_t)l * WO_END;
            if (k == 0) {
                EpiIn1 E1{ws};
                run_gemm(lds, wv, H, Wb + WO_IN1, TH, 4608, 1024, E1);
                EpiVt E2{(bf16*)(ws + WS_RVT), (bf16*)(ws + WS_DVT), nullptr, 0.f};
                run_gemm(lds, wv, Wb + WO_V, H, 2048, TH, 1024, E2);
            } else if (k == 1) {
                EpiUq Eq{(bf16*)(ws + WS_QMN), (bf16*)(ws + WS_QMP), (const float*)(ws + WS_SSQ_CQ), (const float*)(ws + WS_MCOS), (const float*)(ws + WS_MSIN), wv};
                run_gemm(lds, wv, (const bf16*)(ws + WS_CQ), Wb + WO_UQ, TH, 1536, 256, Eq);
                EpiUk Ek{(bf16*)(ws + WS_KMN), (const float*)(ws + WS_SSQ_CKV)};
                run_gemm(lds, wv, (const bf16*)(ws + WS_CKV), Wb + WO_UK, TH, 1024, 256, Ek);
                EpiVt Ev{(bf16*)(ws + WS_VMT), (bf16*)(ws + WS_VMT), (const float*)(ws + WS_SSQ_CKV), 1.f / 128.f};
                run_gemm(lds, wv, Wb + WO_UV, (const bf16*)(ws + WS_CKV), 1024, TH, 256, Ev);
            } else if (k == 2) {
#ifndef DIS_ATTN
                AttnP P{ws, l};
                attn_phase(lds, P, (unsigned*)(ws + WS_CNT) + hb * 2 + l, wv);
#endif
            } else if (k == 3) {
                bf16* G = (bf16*)(ws + WS_G); float* M32 = (float*)(ws + WS_M32); bf16* MG = (bf16*)(ws + WS_MG);
                const size_t GS = (size_t)TH * 1024;
                run_gemm(lds, wv, H, Wb + WO_G, TH, 1024, 1024, EpiAct<0>{G, 1024});
                run_gemm(lds, wv, (const bf16*)(ws + WS_RO), Wb + WO_RO, TH, 1024, 1024, EpiBranch<0>{G, M32, MG});
                run_gemm(lds, wv, H, Wb + WO_G + (size_t)1024 * 1024, TH, 1024, 1024, EpiAct<0>{G + GS, 1024});
                run_gemm(lds, wv, (const bf16*)(ws + WS_DQ), Wb + WO_DO, TH, 1024, 1024, EpiBranch<1>{G + GS, M32, MG});
                run_gemm(lds, wv, H, Wb + WO_G + (size_t)2048 * 1024, TH, 1024, 1024, EpiAct<0>{G + 2 * GS, 1024});
                run_gemm(lds, wv, (const bf16*)(ws + WS_QMN), Wb + WO_MO, TH, 1024, 1024, EpiBranch<2>{G + 2 * GS, M32, MG});
            } else if (k == 4) {
                run_gemm(lds, wv, (const bf16*)(ws + WS_MG), Wb + WO_OUT, TH, 1024, 1024, EpiY{(bf16*)(ws + WS_Y), (float*)(ws + WS_SSQ_Y)});
            } else if (k == 5) {
                resid_rows((l == 0 ? xin0 : (const float*)outp) + xoff, (const bf16*)(ws + WS_Y), (const float*)(ws + WS_SSQ_Y), gains + 2048 + l * DM, outp + xoff, gains + 4096 + l * DM, H, TH, wv);
            } else if (k == 6) {
                run_gemm(lds, wv, H, Wb + WO_UP, TH, DFF, 1024, EpiAct<1>{(bf16*)(ws + WS_U), DFF});
            } else if (k == 7) {
                run_gemm(lds, wv, (const bf16*)(ws + WS_U), Wb + WO_DOWN, TH, 1024, DFF, EpiY{(bf16*)(ws + WS_Y), (float*)(ws + WS_SSQ_Y)});
            } else {
                resid_rows(outp + xoff, (const bf16*)(ws + WS_Y), (const float*)(ws + WS_SSQ_Y), gains + 6144 + l * DM, outp + xoff, l == 0 ? gains + DM : nullptr, H, TH, wv, true);
            }
        }
#if !MK_MULTI
        if (ph + 1 < ph_hi) xcd_barrier((unsigned*)(ws + WS_BAR), lds, wv);
#endif
    }
#ifdef MK_TS
    if (blockIdx.x == 0 && tidx(wv) == 0) {
        unsigned long long* ts = (unsigned long long*)(ws0 + 262144); ts[N_PHASES] = __builtin_amdgcn_s_memrealtime();
        unsigned long long sum = 0;
        for (int q = 1; q < N_PHASES; ++q) { const int k19 = (q - 1) % 19; const int k = k19 == 0 ? 9 : (k19 - 1) % 9; if (MK_TS == k || (MK_TS == 10 && (k == 6 || k == 7)) || (MK_TS == 11 && (k == 5 || k == 8 || k == 9)) || MK_TS == 12) sum += ts[q + 1] - ts[q]; }
        if (MK_TS == 13) sum = ts[1] - ts[0];
        outp[0] = (float)sum * (0.01f / 32.f);
    }
#endif
}

extern "C" void kernel_launch(void* const* d_in, const int* in_sizes, int n_in, void* d_out, int out_size, void* d_ws, size_t ws_size, hipStream_t stream) {
    static int grid = 0;
    if (grid == 0) {
        if (n_in != 22 || ws_size < WS_END) { fprintf(stderr, "kernel_launch: unexpected inputs (n_in %d, ws %zu)\n", n_in, ws_size); grid = -1; return; }
        int dev = 0, cus = 0, per_cu = 0;
        hipGetDevice(&dev); hipDeviceGetAttribute(&cus, hipDeviceAttributeMultiprocessorCount, dev);
        if (hipFuncSetAttribute((const void*)mega_fwd, hipFuncAttributeMaxDynamicSharedMemorySize, LDS_BYTES) != hipSuccess) { fprintf(stderr, "kernel_launch: hipFuncSetAttribute failed\n"); grid = -1; return; }
        if (hipOccupancyMaxActiveBlocksPerMultiprocessor(&per_cu, (const void*)mega_fwd, NTHR, LDS_BYTES) != hipSuccess || per_cu < 1) { fprintf(stderr, "kernel_launch: occupancy query gave %d\n", per_cu); per_cu = 1; }
        (void)hipGetLastError();
        grid = cus * per_cu;
        if (grid > 256) grid = 256;
    }
    if (grid < 0) return;
    Params p{};
    const float** pf = (const float**)&p;
    for (int i = 0; i < 22; ++i) pf[i] = (const float*)d_in[i];
    p.out = (float*)d_out; p.ws = (unsigned char*)d_ws;
#if MK_MULTI
#ifdef MK_CHECK
    hipLaunchKernelGGL(chk_clear, dim3(1), dim3(128), 0, stream, (unsigned char*)d_ws);
#endif
    for (int ph = 0; ph < N_PHASES; ++ph) { p.ph_lo = ph; p.ph_hi = ph + 1; hipLaunchKernelGGL(mega_fwd, dim3(grid), dim3(NTHR), LDS_BYTES, stream, p);
#ifdef MK_CHECK
        if (ph >= 1) hipLaunchKernelGGL(chk, dim3(256), dim3(256), 0, stream, p, ph);
#endif
    }
#ifdef MK_CHECK
    hipLaunchKernelGGL(chk_report, dim3(1), dim3(64), 0, stream, (unsigned char*)d_ws, (float*)d_out);
#endif
#else
    p.ph_lo = 0; p.ph_hi = N_PHASES;
    if (hipMemsetAsync((char*)d_ws + WS_BAR, 0, XCD_BAR_WORDS * 4, stream) != hipSuccess) { fprintf(stderr, "kernel_launch: memset of the barrier words failed\n"); return; }
    void* args[] = {&p};
    hipError_t e = hipLaunchCooperativeKernel((const void*)mega_fwd, dim3(grid), dim3(NTHR), args, LDS_BYTES, stream);
    if (e != hipSuccess) fprintf(stderr, "cooperative launch failed: %s (grid %d)\n", hipGetErrorString(e), grid);
#endif
}
```

```cpp
#include <hip/hip_runtime.h>
#include <hip/hip_cooperative_groups.h>
#include <cstdio>
#include <cstdint>
namespace cg = cooperative_groups;
__device__ __forceinline__ int tidx(int wv) { int l; asm volatile("v_mbcnt_lo_u32_b32 %0, -1, 0\n\tv_mbcnt_hi_u32_b32 %0, -1, %0" : "=v"(l)); return (wv << 6) | l; }
namespace pg8 {
#define PG8_LAS __attribute__((address_space(3)))
typedef unsigned short bf16_t;
typedef short bf16x8 __attribute__((ext_vector_type(8)));
typedef float f32x4 __attribute__((ext_vector_type(4)));
typedef unsigned u32x4 __attribute__((ext_vector_type(4)));
constexpr int BM = 256, BK = 64, HALF = 128, HTB = HALF * BK * 2  , STAGE_BYTES = 8 * HTB, NXCD = 8, WGM = 8;

__host__ __device__ __forceinline__ int lds_byte(int r, int c) { const int st = (r >> 4) * 2 + (c >> 5), rr = r & 15, cc = c & 31, ob = rr * 64 + cc * 2; return st * 1024 + (ob ^ (((ob >> 9) & 1) << 5)); }
__host__ __device__ __forceinline__ void stage_rc(int b, int& R, int& C) { const int st = b / 1024, sb = b % 1024, swz = sb ^ (((sb >> 9) & 1) << 5); R = (st >> 1) * 16 + swz / 64; C = (st & 1) * 32 + (swz % 64) / 2; }
__host__ __device__ __forceinline__ int perm32(int rho) { const int n = rho >> 4, i = rho & 15; return 8 * (i >> 2) + 4 * n + (i & 3); }

struct Unit { int pm, pn, rpm, rpn, kind; };
struct Gemm { const bf16_t* A; const bf16_t* Bt; int M, N, K; };

struct StaticOrder {
    int nM, nN, nwg, G, c, wv;
    __host__ __device__ void init(int M, int N, int G_, int c_) { nM = M / BM; nN = N / BM; nwg = nM * nN; G = G_; c = c_; }
    __host__ __device__ bool next(int i, Unit& u) const {
        const long L = (long)i * G + c; if (L >= nwg) return false;
        int wgid = (int)L; { const int q = nwg / NXCD, r = nwg % NXCD, xcd = wgid % NXCD, off = wgid / NXCD; wgid = (xcd < r ? xcd * (q + 1) : r * (q + 1) + (xcd - r) * q) + off; }
        const int nig = WGM * nN, gid = wgid / nig, fm = gid * WGM, gsz = (nM - fm) < WGM ? (nM - fm) : WGM;
        u.pm = fm + ((wgid % nig) % gsz); u.pn = (wgid % nig) / gsz; return true;
    }
    __device__ __forceinline__ void a_ready(const Unit&) const {}
    __device__ __forceinline__ void done(const Unit&) const {}
};

__device__ __forceinline__ unsigned cvt_pk_bf16(float lo, float hi) { unsigned r; asm volatile("v_cvt_pk_bf16_f32 %0, %1, %2" : "=v"(r) : "v"(lo), "v"(hi)); return r; }
template <class Epi, class Sched, bool ALIGN_EPI = false, bool SP2 = false>
__device__ __forceinline__ void gemm_phase(PG8_LAS unsigned char* lds, const Gemm g, const Sched& S, const Epi& E) {
    const int tid = tidx(S.wv), wid = __builtin_amdgcn_readfirstlane(tid >> 6), lane = tid & 63, wr = wid >> 2, wc = wid & 3, fr = lane & 15, fq = lane >> 4;
    const int K = g.K, nt = K / BK;
    unsigned voffA[2], voffB[2];
#pragma unroll
    for (int i = 0; i < 2; ++i) { int R, C; stage_rc(tid * 16 + i * 8192, R, C); const int Rb = Epi::PERM ? ((R & ~31) + perm32(R & 31)) : R;
        voffA[i] = (unsigned)(R * K + C) * 2u; voffB[i] = (unsigned)(Rb * K + C) * 2u; }
    const size_t kstep = (size_t)(BK * 2);
    const size_t hstep = (size_t)HALF * K * 2;
    const size_t tstep = 2 * hstep;
    const unsigned ldsw = (unsigned)wid * 1024u;
    const int aoff = lds_byte(wr * 64 + fr, fq * 8), boff = lds_byte(wc * 32 + fr, fq * 8);
#define PG8_SA(b, h) (((b) * 2 + (h)) * HTB)
#define PG8_SB(b, h) ((4 + (b) * 2 + (h)) * HTB)
#define PG8_STAGE(bufoff, gbase, voff) do { _Pragma("unroll") for (int _i = 0; _i < 2; ++_i) \
        __builtin_amdgcn_global_load_lds((const unsigned*)((const char*)(gbase) + (voff)[_i]), (PG8_LAS unsigned*)(lds + (bufoff) + ldsw + _i * 8192), 16, 0, 0); } while (0)
#define PG8_LDA(dst, b, h) do { _Pragma("unroll") for (int m = 0; m < 4; ++m) _Pragma("unroll") for (int k = 0; k < 2; ++k) dst[m][k] = *(const PG8_LAS bf16x8*)(lds + PG8_SA(b, h) + aoff + m * 2048 + k * 1024); } while (0)
#define PG8_LDB(dst, b, h) do { _Pragma("unroll") for (int n = 0; n < 2; ++n) _Pragma("unroll") for (int k = 0; k < 2; ++k) dst[n][k] = *(const PG8_LAS bf16x8*)(lds + PG8_SB(b, h) + boff + n * 2048 + k * 1024); } while (0)
#define PG8_MMA(ai, bj, At, Bt) do { __builtin_amdgcn_s_setprio(1); _Pragma("unroll") for (int m = 0; m < 4; ++m) _Pragma("unroll") for (int n = 0; n < 2; ++n) _Pragma("unroll") for (int k = 0; k < 2; ++k) \
        acc[ai][bj][m][n] = __builtin_amdgcn_mfma_f32_16x16x32_bf16(Bt[n][k], At[m][k], acc[ai][bj][m][n], 0, 0, 0); __builtin_amdgcn_s_setprio(0); } while (0)
#define PG8_WAIT_V(n) asm volatile("s_waitcnt vmcnt(" #n ")" ::: "memory")
#define PG8_WAIT_L(n) asm volatile("s_waitcnt lgkmcnt(" #n ")" ::: "memory")
#define PG8_BAR __builtin_amdgcn_s_barrier()
#define PG8_SCHED __builtin_amdgcn_sched_barrier(0)
    Unit cur, nxt; int ui = 0;
    if (!S.next(0, cur)) return;
    f32x4 acc[2][2][4][2];
#pragma unroll
    for (int a = 0; a < 2; ++a)
#pragma unroll
        for (int b = 0; b < 2; ++b)
#pragma unroll
            for (int m = 0; m < 4; ++m)
#pragma unroll
                for (int n = 0; n < 2; ++n) acc[a][b][m][n] = (f32x4){0.f, 0.f, 0.f, 0.f};
    bf16x8 At[4][2], B0[2][2], B1[2][2];
    const char* cA = (const char*)g.A + (size_t)cur.pm * tstep; const char* cB = (const char*)g.Bt + (size_t)cur.pn * tstep;
    S.a_ready(cur);
    if constexpr (SP2) {
        PG8_STAGE(PG8_SB(0, 0), cB, voffB); PG8_STAGE(PG8_SB(0, 1), cB + hstep, voffB); PG8_STAGE(PG8_SA(0, 0), cA, voffA); PG8_STAGE(PG8_SA(0, 1), cA + hstep, voffA);
        if (wr == 1) PG8_BAR;
        PG8_WAIT_V(2); PG8_BAR;
        PG8_STAGE(PG8_SB(1, 0), cB + kstep, voffB); PG8_STAGE(PG8_SA(1, 0), cA + kstep, voffA); PG8_STAGE(PG8_SB(1, 1), cB + hstep + kstep, voffB);
        PG8_WAIT_V(6); PG8_BAR;
    } else {
        PG8_STAGE(PG8_SB(0, 0), cB, voffB); PG8_STAGE(PG8_SA(0, 0), cA, voffA); PG8_STAGE(PG8_SB(0, 1), cB + hstep, voffB); PG8_STAGE(PG8_SA(0, 1), cA + hstep, voffA);
        if (wr == 1) PG8_BAR;
        PG8_WAIT_V(4); PG8_BAR;
        PG8_STAGE(PG8_SB(1, 0), cB + kstep, voffB); PG8_STAGE(PG8_SA(1, 0), cA + kstep, voffA); PG8_STAGE(PG8_SB(1, 1), cB + hstep + kstep, voffB);
        PG8_WAIT_V(6); PG8_BAR;
    }
    for (;;) {
        const bool has_next = S.next(ui + 1, nxt);
        const char* nA = has_next ? (const char*)g.A + (size_t)nxt.pm * tstep : cA; const char* nB = has_next ? (const char*)g.Bt + (size_t)nxt.pn * tstep : cB;
        for (int t = 0; t < nt; t += 2) {
            const bool last = (t == nt - 2);
            const char* a1 = cA + (size_t)(t + 1) * kstep;
            const char* a2 = last ? nA : cA + (size_t)(t + 2) * kstep; const char* b2 = last ? nB : cB + (size_t)(t + 2) * kstep;
            const char* a3 = a2 + kstep; const char* b3 = b2 + kstep;
            if (last && has_next) S.a_ready(nxt);
            if constexpr (SP2) {
            PG8_LDB(B0, 0, 0); PG8_LDB(B1, 0, 1); PG8_SCHED; PG8_LDA(At, 0, 0); PG8_STAGE(PG8_SA(1, 1), a1 + hstep, voffA);
            PG8_WAIT_V(8); PG8_WAIT_L(0); PG8_BAR; PG8_MMA(0, 0, At, B0); PG8_MMA(0, 1, At, B1); PG8_BAR; PG8_SCHED;
            PG8_LDA(At, 0, 1); PG8_STAGE(PG8_SB(0, 0), b2, voffB); PG8_STAGE(PG8_SB(0, 1), b2 + hstep, voffB); PG8_STAGE(PG8_SA(0, 0), a2, voffA);
            PG8_WAIT_V(8); PG8_WAIT_L(0); PG8_BAR; PG8_MMA(1, 0, At, B0); PG8_MMA(1, 1, At, B1); PG8_BAR; PG8_SCHED;
            PG8_LDB(B0, 1, 0); PG8_LDB(B1, 1, 1); PG8_SCHED; PG8_LDA(At, 1, 0); PG8_STAGE(PG8_SA(0, 1), a2 + hstep, voffA);
            PG8_WAIT_V(8); PG8_WAIT_L(0); PG8_BAR; PG8_MMA(0, 0, At, B0); PG8_MMA(0, 1, At, B1); PG8_BAR; PG8_SCHED;
            PG8_LDA(At, 1, 1); PG8_STAGE(PG8_SB(1, 0), b3, voffB); PG8_STAGE(PG8_SB(1, 1), b3 + hstep, voffB); PG8_STAGE(PG8_SA(1, 0), a3, voffA);
            PG8_WAIT_V(8); PG8_WAIT_L(0); PG8_BAR; PG8_MMA(1, 0, At, B0); PG8_MMA(1, 1, At, B1); PG8_BAR; PG8_SCHED;
            } else {
            PG8_LDB(B0, 0, 0); PG8_SCHED; PG8_LDA(At, 0, 0); PG8_STAGE(PG8_SA(1, 1), a1 + hstep, voffA);
            PG8_WAIT_L(8); PG8_BAR; PG8_WAIT_L(0); PG8_MMA(0, 0, At, B0); PG8_BAR; PG8_SCHED;
            PG8_LDB(B1, 0, 1); PG8_STAGE(PG8_SB(0, 0), b2, voffB);
            PG8_BAR; PG8_WAIT_L(0); PG8_MMA(0, 1, At, B1); PG8_BAR;
            PG8_LDA(At, 0, 1); PG8_STAGE(PG8_SA(0, 0), a2, voffA);
            PG8_BAR; PG8_WAIT_L(0); PG8_MMA(1, 0, At, B0); PG8_BAR; PG8_SCHED;
            PG8_STAGE(PG8_SB(0, 1), b2 + hstep, voffB);
            PG8_WAIT_V(6); PG8_BAR; PG8_MMA(1, 1, At, B1); PG8_BAR;
            PG8_LDB(B0, 1, 0); PG8_SCHED; PG8_LDA(At, 1, 0); PG8_STAGE(PG8_SA(0, 1), a2 + hstep, voffA);
            PG8_WAIT_L(8); PG8_BAR; PG8_WAIT_L(0); PG8_MMA(0, 0, At, B0); PG8_BAR; PG8_SCHED;
            PG8_LDB(B1, 1, 1); PG8_STAGE(PG8_SB(1, 0), b3, voffB);
            PG8_BAR; PG8_WAIT_L(0); PG8_MMA(0, 1, At, B1); PG8_BAR;
            PG8_LDA(At, 1, 1); PG8_STAGE(PG8_SA(1, 0), a3, voffA);
            PG8_BAR; PG8_WAIT_L(0); PG8_MMA(1, 0, At, B0); PG8_BAR; PG8_SCHED;
            PG8_STAGE(PG8_SB(1, 1), b3 + hstep, voffB);
            PG8_WAIT_V(6); PG8_BAR; PG8_MMA(1, 1, At, B1); PG8_BAR;
            }
        }
        if constexpr (ALIGN_EPI) { if (wr == 0) PG8_BAR; }
        if constexpr (!Epi::AFTER_DRAIN) { E(acc, cur, wr, wc, fr, fq); S.done(cur); }
        if (!has_next) break;
#pragma unroll
        for (int a = 0; a < 2; ++a)
#pragma unroll
            for (int b = 0; b < 2; ++b)
#pragma unroll
                for (int m = 0; m < 4; ++m)
#pragma unroll
                    for (int n = 0; n < 2; ++n) acc[a][b][m][n] = (f32x4){0.f, 0.f, 0.f, 0.f};
        cur = nxt; cA = nA; cB = nB; ++ui;
        if constexpr (ALIGN_EPI) { if (wr == 1) PG8_BAR; }
    }
    PG8_WAIT_V(0);
    if constexpr (!ALIGN_EPI) { if (wr == 0) PG8_BAR; }
    PG8_BAR;
    if constexpr (Epi::AFTER_DRAIN) { E.fused(acc, cur, wr, wc, fr, fq, lds, wid, lane); S.done(cur); }
#undef PG8_SA
#undef PG8_SB
#undef PG8_STAGE
#undef PG8_LDA
#undef PG8_LDB
#undef PG8_MMA
#undef PG8_WAIT_V
#undef PG8_WAIT_L
#undef PG8_BAR
#undef PG8_SCHED
}
}


#ifndef MK_MULTI
#define MK_MULTI 0
#endif
#define DI __device__ __forceinline__
#define LAS __attribute__((address_space(3)))
typedef unsigned short bf16;
typedef short bf16x8 __attribute__((ext_vector_type(8)));
typedef float f32x4 __attribute__((ext_vector_type(4)));
typedef float f32x16 __attribute__((ext_vector_type(16)));
typedef unsigned u32x4 __attribute__((ext_vector_type(4)));
typedef unsigned u32x2 __attribute__((ext_vector_type(2)));
typedef float f32x2_t __attribute__((ext_vector_type(2)));
typedef __bf16 bf16x2_t __attribute__((ext_vector_type(2)));
typedef LAS unsigned char* lptr;


constexpr int SEQ = 2048, DM = 1024, TH = 16384  , DFF = 4096, DIN = 9632;
constexpr float EPS = 1e-6f, LOG2E = 1.4426950408889634f;
constexpr float QSC_DIFF = 0.125f * LOG2E;
constexpr float QSC_MLA = 0.10206207261596575f * LOG2E;
constexpr float KSC_RET = 0.08838834764831845f;
constexpr int NTHR = 512;
constexpr int LDS_BYTES = 147456;

constexpr size_t MiB = 1u << 20;
constexpr size_t WS_CNT = 0, WS_LAM = 256, WS_BIAS = 1024, WS_GAIN = 65536;
constexpr size_t WS_SUBG = WS_GAIN + 4 * 2 * 1024 * 4;
constexpr size_t WS_RCOS = 1 * MiB, WS_RSIN = WS_RCOS + 512 * 1024, WS_MCOS = 2 * MiB, WS_MSIN = WS_MCOS + 128 * 1024;
constexpr size_t WS_W = 4 * MiB;
constexpr size_t WO_IN1 = 0, WO_V = WO_IN1 + 4608 * 1024, WO_G = WO_V + 2048 * 1024, WO_RO = WO_G + 3072 * 1024, WO_DO = WO_RO + 1024 * 1024, WO_MO = WO_DO + 1024 * 1024, WO_OUT = WO_MO + 1024 * 1024,
                 WO_UP = WO_OUT + 1024 * 1024, WO_DOWN = WO_UP + 4096 * 1024, WO_UQ = WO_DOWN + 4096 * 1024, WO_UK = WO_UQ + 1536 * 256, WO_UV = WO_UK + 1024 * 256,
                 WO_END = 90 * 262144;
static_assert(WO_UV + 1024 * 256 <= WO_END && WO_G % 262144 == 0 && WO_RO % 262144 == 0, "weight map");
static_assert(WS_W + 2 * WO_END * 2 <= 96 * MiB, "weights fit");
constexpr size_t WS_H = 96 * MiB;
constexpr size_t WS_RQ = 128 * MiB, WS_RK = 144 * MiB, WS_RVT = 160 * MiB, WS_RG = 192 * MiB, WS_G = 128 * MiB;
constexpr size_t WS_DQ = 224 * MiB, WS_DK = 256 * MiB, WS_DVT = 288 * MiB, WS_M32 = 256 * MiB;
constexpr size_t WS_CQ = 320 * MiB, WS_CKV = 328 * MiB  , WS_KPE = 336 * MiB, WS_SSQ_CQ = 337 * MiB, WS_SSQ_CKV = WS_SSQ_CQ + 256 * 1024;
constexpr size_t WS_QMN = 338 * MiB, WS_QMP = 370 * MiB, WS_KMN = 386 * MiB, WS_VMT = 418 * MiB, WS_RO = 450 * MiB;
constexpr size_t WS_MG = 370 * MiB, WS_Y = 402 * MiB, WS_SSQ_Y = 434 * MiB, WS_U = 128 * MiB, WS_END = 482 * MiB;

struct Params {
    const float *x, *rel_bias, *pre_mix_g, *w_in, *w_ret_o, *lq1, *lk1, *lq2, *lk2, *subln_g, *w_diff_o, *q_norm_g, *w_uq, *kv_norm_g, *w_ukv, *w_mla_o,
                *w_out, *post_mix_g, *pre_mlp_g, *w_up, *w_down, *post_mlp_g;
    float* out; unsigned char* ws; int ph_lo, ph_hi;
};

DI unsigned cvtpk(float lo, float hi) { f32x2_t v = {lo, hi}; bf16x2_t b = __builtin_convertvector(v, bf16x2_t); return __builtin_bit_cast(unsigned, b); }
DI u32x4 pack8(f32x4 a, f32x4 b) { u32x4 w; w.x = cvtpk(a[0], a[1]); w.y = cvtpk(a[2], a[3]); w.z = cvtpk(b[0], b[1]); w.w = cvtpk(b[2], b[3]); return w; }
DI float bflo(unsigned u) { return __uint_as_float(u << 16); }
DI float bfhi(unsigned u) { return __uint_as_float(u & 0xffff0000u); }
DI void unpack8(u32x4 w, f32x4& a, f32x4& b) { a = (f32x4){bflo(w.x), bfhi(w.x), bflo(w.y), bfhi(w.y)}; b = (f32x4){bflo(w.z), bfhi(w.z), bflo(w.w), bfhi(w.w)}; }
DI float ex2(float x) { return __builtin_amdgcn_exp2f(x); }
DI float sigm(float x) { return __builtin_amdgcn_rcpf(1.f + ex2(-x * LOG2E)); }
DI float shx(float v, int m, int lane) { return __int_as_float(__builtin_amdgcn_ds_bpermute((lane ^ m) << 2, __float_as_int(v))); }
DI float wave_sum(float v, int lane) {
#pragma unroll
    for (int o = 1; o < 64; o <<= 1) v += shx(v, o, lane);
    return v;
}
DI float sq4(f32x4 v) { return (v[0] * v[0] + v[1] * v[1]) + (v[2] * v[2] + v[3] * v[3]); }

DI int colmap(int map, int n, int off) {
    switch (map) {
        case 0: return off + n;
        case 1: { const int p = n & 127, bj = (n >> 7) & 1; return off + (n & ~255) + (p >> 6) * 128 + bj * 64 + (p & 63); }
        case 2: { if (n < 128) return 6400 + n; if (n >= 160) return -1; const int q = n - 128; return 6528 + 16 * ((q >> 2) & 1) + 4 * (q >> 3) + (q & 3); }
        case 3: { if (n < 1024) return (n >> 6) * 96 + (n & 63); const int q = n - 1024, hh = q >> 5, pos = q & 31; return hh * 96 + 64 + 16 * ((pos >> 2) & 1) + 4 * (pos >> 3) + (pos & 3); }
        case 4: return (n >> 6) * 128 + (n & 63);
        default: return (n >> 6) * 128 + 64 + (n & 63);
    }
}
DI void conv_item(const float* W, int ldw, int K, int kvalid, bf16* WT, int map, int off, const float* gs, LAS float* scr, int item, int nblk, int lane) {
    const int kb = item / nblk, nb = item % nblk, k0 = 64 * kb, n0 = 32 * nb;
    const int oc = colmap(map, n0 + (lane & 31), off);
#pragma unroll 8
    for (int i = 0; i < 32; ++i) { const int kk = 2 * i + (lane >> 5); float v = 0.f; if (oc >= 0 && k0 + kk < kvalid) { v = W[(size_t)(k0 + kk) * ldw + oc]; if (gs) v *= gs[k0 + kk]; } scr[kk * 33 + (lane & 31)] = v; }
    asm volatile("s_waitcnt lgkmcnt(0)" ::: "memory");
    const int c = lane & 7;
#pragma unroll
    for (int j = 0; j < 4; ++j) { const int n = (lane >> 3) + 8 * j; const LAS float* s = scr + (8 * c) * 33 + n;
        u32x4 o; o.x = cvtpk(s[0 * 33], s[1 * 33]); o.y = cvtpk(s[2 * 33], s[3 * 33]); o.z = cvtpk(s[4 * 33], s[5 * 33]); o.w = cvtpk(s[6 * 33], s[7 * 33]);
        *(u32x4*)(WT + (size_t)(n0 + n) * K + k0 + 8 * c) = o; }
    asm volatile("s_waitcnt lgkmcnt(0)" ::: "memory");
}
DI int t5_bucket(int n) {
    if (n < 16) return n;
    int large = 16 + (int)(logf((float)n / 16.f) / 2.0794415416798357f * 16.f);
    return large < 31 ? large : 31;
}
DI void prologue(const Params& p, lptr lds, int wv) {
    const int tid = tidx(wv), lane = tid & 63, wave = tid >> 6;
    const int gw = blockIdx.x * 8 + wave, NGW = gridDim.x * 8, gt = blockIdx.x * NTHR + tid, NGT = gridDim.x * NTHR;
    unsigned char* ws = p.ws;
    if (blockIdx.x == 0) {
        if (tid < 64) ((unsigned*)(ws + WS_CNT))[tid] = 0u;
        if (tid >= 64 && tid < 66) {
            const int l = tid - 64; float a = 0.f, b = 0.f;
            for (int i = 0; i < 64; ++i) { a += p.lq1[l * 64 + i] * p.lk1[l * 64 + i]; b += p.lq2[l * 64 + i] * p.lk2[l * 64 + i]; }
            const float linit = 0.8f - 0.6f * expf(-0.3f * (float)l);
            ((float*)(ws + WS_LAM))[l] = expf(a) - expf(b) + linit; ((float*)(ws + WS_LAM))[2 + l] = 1.f - linit;
        }
    }
    for (int i = gt; i < 2048; i += NGT) { float* gd = (float*)(ws + WS_GAIN); gd[i] = p.pre_mix_g[i]; gd[2048 + i] = p.post_mix_g[i]; gd[4096 + i] = p.pre_mlp_g[i]; gd[6144 + i] = p.post_mlp_g[i]; if (i < 256) ((float*)(ws + WS_SUBG))[i] = p.subln_g[i]; }
    for (int i = gt; i < 8 * 128; i += NGT) { const int hh = i >> 7, n = i & 127; ((float*)(ws + WS_BIAS))[i] = p.rel_bias[t5_bucket(n) * 8 + hh] * LOG2E; }
    for (int i = gt; i < SEQ * 64; i += NGT) { const int s = i >> 6, d = i & 63; const float inv = (float)(1.0 / pow(10000.0, (double)d / 63.0)); const float ang = (float)s * inv;
        ((float*)(ws + WS_RCOS))[i] = (float)cos((double)ang); ((float*)(ws + WS_RSIN))[i] = (float)sin((double)ang); }
    for (int i = gt; i < SEQ * 16; i += NGT) { const int s = i >> 4, d = i & 15; const float inv = (float)(1.0 / pow(10000.0, (double)(2 * d) / 32.0)); const float ang = (float)s * inv;
        ((float*)(ws + WS_MCOS))[i] = (float)cos((double)ang); ((float*)(ws + WS_MSIN))[i] = (float)sin((double)ang); }
    LAS float* scr = (LAS float*)(lds + wave * 16384);
    constexpr int NJ = 19, ITEMS_L = 11456;
    for (int itg = gw; itg < 2 * ITEMS_L; itg += NGW) {
        const int l = itg / ITEMS_L; int it = itg - l * ITEMS_L;
        bf16* Wb = (bf16*)(ws + WS_W) + (size_t)l * WO_END;
        const float* win = p.w_in + (size_t)l * DM * DIN;
        int job = 0;
        {   const int cnt[NJ] = {256, 256, 512, 512, 512, 128, 128, 512, 512, 1536, 192, 128, 128, 512, 512, 512, 512, 2048, 2048};
#pragma unroll
            for (int j = 0; j < NJ - 1; ++j) { if (job == j && it >= cnt[j]) { it -= cnt[j]; job = j + 1; } } }
        const float* src = win; int ldw = DIN, K = 1024, kvalid = 4096, ns = 1024, map = 0, off = 0; const float* gs = nullptr; bf16* dst = Wb;
        switch (job) {
            case 0: ns = 512; map = 1; off = 0; dst = Wb + WO_IN1; break;
            case 1: ns = 512; map = 1; off = 512; dst = Wb + WO_IN1 + (size_t)512 * 1024; break;
            case 2: off = 2048; dst = Wb + WO_IN1 + (size_t)1024 * 1024; break;
            case 3: off = 3072; dst = Wb + WO_IN1 + (size_t)2048 * 1024; break;
            case 4: off = 4096; dst = Wb + WO_IN1 + (size_t)3072 * 1024; break;
            case 5: ns = 256; off = 6144; dst = Wb + WO_IN1 + (size_t)4096 * 1024; break;
            case 6: ns = 256; map = 2; dst = Wb + WO_IN1 + (size_t)4352 * 1024; break;
            case 7: off = 1024; dst = Wb + WO_V; break;
            case 8: off = 5120; dst = Wb + WO_V + (size_t)1024 * 1024; break;
            case 9: ns = 3072; off = 6560; dst = Wb + WO_G; break;
            case 10: src = p.w_uq + (size_t)l * 256 * 1536; ldw = 1536; K = 256; ns = 1536; map = 3; gs = p.q_norm_g + l * 256; dst = Wb + WO_UQ; break;
            case 11: src = p.w_ukv + (size_t)l * 128 * 2048; ldw = 2048; K = 256; kvalid = 128; map = 4; gs = p.kv_norm_g + l * 128; dst = Wb + WO_UK; break;
            case 12: src = p.w_ukv + (size_t)l * 128 * 2048; ldw = 2048; K = 256; kvalid = 128; map = 5; gs = p.kv_norm_g + l * 128; dst = Wb + WO_UV; break;
            case 13: src = p.w_ret_o + (size_t)l * 1024 * 1024; ldw = 1024; dst = Wb + WO_RO; break;
            case 14: src = p.w_diff_o + (size_t)l * 1024 * 1024; ldw = 1024; dst = Wb + WO_DO; break;
            case 15: src = p.w_mla_o + (size_t)l * 1024 * 1024; ldw = 1024; dst = Wb + WO_MO; break;
            case 16: src = p.w_out + (size_t)l * 1024 * 1024; ldw = 1024; dst = Wb + WO_OUT; break;
            case 17: src = p.w_up + (size_t)l * 1024 * 4096; ldw = 4096; ns = 4096; dst = Wb + WO_UP; break;
            default: src = p.w_down + (size_t)l * 4096 * 1024; ldw = 1024; K = 4096; dst = Wb + WO_DOWN; break;
        }
        conv_item(src, ldw, K, kvalid, dst, map, off, gs, scr, it, ns / 32, lane);
    }
}

DI void norm_rows(const float* x, const float* g, bf16* o, int rows, int wv) {
    const int tid_ = tidx(wv); const int lane = tid_ & 63, gw = blockIdx.x * 8 + (tid_ >> 6), NGW = gridDim.x * 8;
    for (int m = gw; m < rows; m += NGW) {
        const f32x4* xr = (const f32x4*)(x + (size_t)m * DM) + lane; f32x4 v[4]; float s = 0.f;
#pragma unroll
        for (int j = 0; j < 4; ++j) { v[j] = xr[64 * j]; s += sq4(v[j]); }
        const float rs = 1.0f / sqrtf(wave_sum(s, lane) * (1.f / DM) + EPS);
        u32x2* o8 = (u32x2*)(o + (size_t)m * DM) + lane;
#pragma unroll
        for (int j = 0; j < 4; ++j) { const f32x4 gg = ((const f32x4*)g)[lane + 64 * j]; u32x2 w; w.x = cvtpk(v[j][0] * rs * gg[0], v[j][1] * rs * gg[1]); w.y = cvtpk(v[j][2] * rs * gg[2], v[j][3] * rs * gg[3]); o8[64 * j] = w; }
    }
}
DI void resid_rows(const float* xin, const bf16* y, const float* ssq, const float* gpost, float* xout, const float* gnext, bf16* hout, int rows, int wv, bool ablate = false) {
    const int tid_ = tidx(wv); const int lane = tid_ & 63, gw = blockIdx.x * 8 + (tid_ >> 6), NGW = gridDim.x * 8;
    for (int m = gw; m < rows; m += NGW) {
        const float part = lane < 16 ? ssq[(size_t)m * 16 + lane] : 0.f;
        float rs = 1.0f / sqrtf(wave_sum(part, lane) * (1.f / DM) + EPS);
#ifdef ABL_MLP
        if (!gnext || gnext == (const float*)0 + 1) rs = rs; if (ablate) rs = 0.f;
#endif
        const f32x4* xr = (const f32x4*)(xin + (size_t)m * DM) + lane; const u32x2* yr = (const u32x2*)(y + (size_t)m * DM) + lane; f32x4* xo = (f32x4*)(xout + (size_t)m * DM) + lane;
        f32x4 v[4]; float s = 0.f;
#pragma unroll
        for (int j = 0; j < 4; ++j) { const f32x4 xv = xr[64 * j]; const u32x2 yw = yr[64 * j]; const f32x4 gg = ((const f32x4*)gpost)[lane + 64 * j];
            f32x4 yv = (f32x4){bflo(yw.x), bfhi(yw.x), bflo(yw.y), bfhi(yw.y)};
            v[j] = xv + yv * rs * gg; xo[64 * j] = v[j]; s += sq4(v[j]); }
        if (gnext) {
            const float rs2 = 1.0f / sqrtf(wave_sum(s, lane) * (1.f / DM) + EPS);
            u32x2* o8 = (u32x2*)(hout + (size_t)m * DM) + lane;
#pragma unroll
            for (int j = 0; j < 4; ++j) { const f32x4 gg = ((const f32x4*)gnext)[lane + 64 * j]; u32x2 w; w.x = cvtpk(v[j][0] * rs2 * gg[0], v[j][1] * rs2 * gg[1]); w.y = cvtpk(v[j][2] * rs2 * gg[2], v[j][3] * rs2 * gg[3]); o8[64 * j] = w; }
        }
    }
}

#define EPI_ARGS const f32x4 (&acc)[2][2][4][2], const pg8::Unit& u, int wr, int wc, int fr, int fq
#define FOR_AI_M _Pragma("unroll") for (int ai = 0; ai < 2; ++ai) _Pragma("unroll") for (int m = 0; m < 4; ++m)
#define FOR_BJ _Pragma("unroll") for (int bj = 0; bj < 2; ++bj)

struct EpiIn1 {
    static constexpr bool PERM = true, AFTER_DRAIN = false;
    unsigned char* ws;
    DI void operator()(EPI_ARGS) const {
        asm volatile("" : "+v"(fr), "+v"(fq));
        bf16 *RQ = (bf16*)(ws + WS_RQ), *RK = (bf16*)(ws + WS_RK), *RG = (bf16*)(ws + WS_RG), *DQ = (bf16*)(ws + WS_DQ), *DK = (bf16*)(ws + WS_DK), *CQ = (bf16*)(ws + WS_CQ), *CKV = (bf16*)(ws + WS_CKV), *KPE = (bf16*)(ws + WS_KPE);
        float *SSQ_CQ = (float*)(ws + WS_SSQ_CQ), *SSQ_CKV = (float*)(ws + WS_SSQ_CKV);
        const float *rcos = (const float*)(ws + WS_RCOS), *rsin = (const float*)(ws + WS_RSIN), *mcos = (const float*)(ws + WS_MCOS), *msin = (const float*)(ws + WS_MSIN);
        const int pn = u.pn, row0 = u.pm * 256 + wr * 64 + fr, c8 = wc * 32 + 8 * fq;
        if (pn < 4) {
            bf16* dst = pn < 2 ? RQ : RK; const int head = 2 * (pn & 1) + (wc >> 1), d0 = c8 & 63;
            const float l2g = log2f(1.f - ex2(-5.f - (float)head)), l2s = pn < 2 ? l2g : -l2g, sc0 = pn < 2 ? 1.f : KSC_RET;
            FOR_AI_M { const int t = row0 + ai * 128 + m * 16, s = t & (SEQ - 1); const float sc = sc0 * ex2(l2s * (float)(s & 63));
                const f32x4 c0 = *(const f32x4*)(rcos + s * 64 + d0), c1 = *(const f32x4*)(rcos + s * 64 + d0 + 4), s0 = *(const f32x4*)(rsin + s * 64 + d0), s1 = *(const f32x4*)(rsin + s * 64 + d0 + 4);
                const f32x4 x1a = acc[ai][0][m][0], x1b = acc[ai][0][m][1], x2a = acc[ai][1][m][0], x2b = acc[ai][1][m][1];
                bf16* o = dst + (size_t)t * 512 + head * 128 + d0;
                *(u32x4*)o = pack8((x1a * c0 - x2a * s0) * sc, (x1b * c1 - x2b * s1) * sc);
                *(u32x4*)(o + 64) = pack8((x2a * c0 + x1a * s0) * sc, (x2b * c1 + x1b * s1) * sc); asm volatile("" ::: "memory"); }
        } else if (pn < 16) {
            const int seg = (pn - 4) >> 2; bf16* dst = seg == 0 ? RG : (seg == 1 ? DQ : DK); const int colb = ((pn - 4) & 3) * 256 + c8;
            FOR_AI_M { const int t = row0 + ai * 128 + m * 16;
                FOR_BJ { f32x4 v0 = acc[ai][bj][m][0], v1 = acc[ai][bj][m][1];
                    if (seg == 0) {
#pragma unroll
                        for (int i = 0; i < 4; ++i) { v0[i] = v0[i] * sigm(v0[i]); v1[i] = v1[i] * sigm(v1[i]); } }
                    else if (seg == 1) { v0 = v0 * QSC_DIFF; v1 = v1 * QSC_DIFF; }
                    *(u32x4*)(dst + (size_t)t * 1024 + colb + bj * 128) = pack8(v0, v1); } }
        } else if (pn == 16) {
            FOR_AI_M { const int t = row0 + ai * 128 + m * 16; float ss = 0.f;
                FOR_BJ { const f32x4 v0 = acc[ai][bj][m][0], v1 = acc[ai][bj][m][1]; ss += sq4(v0) + sq4(v1); *(u32x4*)(CQ + (size_t)t * 256 + c8 + bj * 128) = pack8(v0, v1); }
                ss += shx(ss, 16, fq * 16 + fr); ss += shx(ss, 32, fq * 16 + fr);
                if (fq == 0) SSQ_CQ[(size_t)t * 4 + wc] = ss; }
        } else {
            FOR_AI_M { const int t = row0 + ai * 128 + m * 16, s = t & (SEQ - 1);
                const f32x4 v0 = acc[ai][0][m][0], v1 = acc[ai][0][m][1]; float ss = sq4(v0) + sq4(v1);
                *(u32x4*)(CKV + (size_t)t * 256 + c8) = pack8(v0, v1); *(u32x4*)(CKV + (size_t)t * 256 + 128 + c8) = pack8(acc[ai][1][m][0], acc[ai][1][m][1]);
                ss += shx(ss, 16, fq * 16 + fr); ss += shx(ss, 32, fq * 16 + fr);
                if (fq == 0) SSQ_CKV[(size_t)t * 4 + wc] = ss;
                if (wc == 0) { const f32x4 x1 = acc[ai][1][m][0], x2 = acc[ai][1][m][1]; const f32x4 c = *(const f32x4*)(mcos + s * 16 + 4 * fq), sn = *(const f32x4*)(msin + s * 16 + 4 * fq);
                    const f32x4 o1 = x1 * c - x2 * sn, o2 = x2 * c + x1 * sn; u32x2 w1, w2; w1.x = cvtpk(o1[0], o1[1]); w1.y = cvtpk(o1[2], o1[3]); w2.x = cvtpk(o2[0], o2[1]); w2.y = cvtpk(o2[2], o2[3]);
                    *(u32x2*)(KPE + (size_t)t * 32 + 4 * fq) = w1; *(u32x2*)(KPE + (size_t)t * 32 + 16 + 4 * fq) = w2; } }
        }
    }
};
struct EpiVt {
    static constexpr bool PERM = true, AFTER_DRAIN = false;
    bf16 *T0, *T1; const float* ssq; float inv_n;
    DI void operator()(EPI_ARGS) const {
        asm volatile("" : "+v"(fr), "+v"(fq));
        const int b = u.pn >> 3, s0 = (u.pn & 7) * 256 + wc * 32 + 8 * fq;
        float rs[2][8];
        FOR_BJ {
#pragma unroll
            for (int k = 0; k < 8; ++k) { rs[bj][k] = 1.f; if (ssq) { const f32x4 q = *(const f32x4*)(ssq + (size_t)(b * SEQ + s0 + bj * 128 + k) * 4); rs[bj][k] = 1.0f / sqrtf(((q[0] + q[1]) + (q[2] + q[3])) * inv_n + EPS); } } }
        FOR_AI_M { const int R = u.pm * 256 + ai * 128 + wr * 64 + m * 16 + fr;
            bf16* rowp = (R < 1024 ? T0 + (size_t)(b * 1024 + R) * SEQ : T1 + (size_t)(b * 1024 + R - 1024) * SEQ) + s0;
            FOR_BJ { f32x4 v0 = acc[ai][bj][m][0], v1 = acc[ai][bj][m][1];
#pragma unroll
                for (int i = 0; i < 4; ++i) { v0[i] *= rs[bj][i]; v1[i] *= rs[bj][4 + i]; }
                *(u32x4*)(rowp + bj * 128) = pack8(v0, v1); } }
    }
};
struct EpiUq {
    static constexpr bool PERM = true, AFTER_DRAIN = false;
    bf16 *QMn, *QMp; const float *ssq, *mcos, *msin; int wv;
    DI void operator()(EPI_ARGS) const {
        { const int t_ = tidx(wv); fr = t_ & 15; fq = (t_ >> 4) & 3; }
        const int pn = u.pn, row0 = u.pm * 256 + wr * 64 + fr, c8 = wc * 32 + 8 * fq;
        FOR_AI_M { const int t = row0 + ai * 128 + m * 16, s = t & (SEQ - 1);
            const f32x4 q = *(const f32x4*)(ssq + (size_t)t * 4); const float rs = QSC_MLA / sqrtf(((q[0] + q[1]) + (q[2] + q[3])) * (1.f / 256.f) + EPS);
            if (pn < 4) { FOR_BJ { *(u32x4*)(QMn + (size_t)t * 1024 + pn * 256 + bj * 128 + c8) = pack8(acc[ai][bj][m][0] * rs, acc[ai][bj][m][1] * rs); } }
            else { const f32x4 c = *(const f32x4*)(mcos + s * 16 + 4 * fq), sn = *(const f32x4*)(msin + s * 16 + 4 * fq);
                FOR_BJ { const int hh = (pn - 4) * 8 + bj * 4 + wc; const f32x4 x1 = acc[ai][bj][m][0] * rs, x2 = acc[ai][bj][m][1] * rs;
                    const f32x4 o1 = x1 * c - x2 * sn, o2 = x2 * c + x1 * sn; u32x2 w1, w2; w1.x = cvtpk(o1[0], o1[1]); w1.y = cvtpk(o1[2], o1[3]); w2.x = cvtpk(o2[0], o2[1]); w2.y = cvtpk(o2[2], o2[3]);
                    *(u32x2*)(QMp + (size_t)t * 512 + hh * 32 + 4 * fq) = w1; *(u32x2*)(QMp + (size_t)t * 512 + hh * 32 + 16 + 4 * fq) = w2; } }
            asm volatile("" ::: "memory");
        }
    }
};
struct EpiUk {
    static constexpr bool PERM = true, AFTER_DRAIN = false;
    bf16* KMn; const float* ssq;
    DI void operator()(EPI_ARGS) const {
        asm volatile("" : "+v"(fr), "+v"(fq));
        const int row0 = u.pm * 256 + wr * 64 + fr, c8 = wc * 32 + 8 * fq;
        FOR_AI_M { const int t = row0 + ai * 128 + m * 16;
            const f32x4 q = *(const f32x4*)(ssq + (size_t)t * 4); const float rs = 1.0f / sqrtf(((q[0] + q[1]) + (q[2] + q[3])) * (1.f / 128.f) + EPS);
            FOR_BJ { *(u32x4*)(KMn + (size_t)t * 1024 + u.pn * 256 + bj * 128 + c8) = pack8(acc[ai][bj][m][0] * rs, acc[ai][bj][m][1] * rs); } }
    }
};
template <int ACT  > struct EpiAct {
    static constexpr bool PERM = true, AFTER_DRAIN = false;
    bf16* O; int ldc;
    DI void operator()(EPI_ARGS) const {
        asm volatile("" : "+v"(fr), "+v"(fq));
        const int row0 = u.pm * 256 + wr * 64 + fr, c8 = u.pn * 256 + wc * 32 + 8 * fq;
        FOR_AI_M { const int t = row0 + ai * 128 + m * 16;
            FOR_BJ { f32x4 v0 = acc[ai][bj][m][0], v1 = acc[ai][bj][m][1];
#pragma unroll
                for (int i = 0; i < 4; ++i) { if (ACT == 0) { v0[i] = sigm(v0[i]); v1[i] = sigm(v1[i]); } else { const float a = fmaxf(v0[i], 0.f), b = fmaxf(v1[i], 0.f); v0[i] = a * a; v1[i] = b * b; } }
                *(u32x4*)(O + (size_t)t * ldc + c8 + bj * 128) = pack8(v0, v1); } }
    }
};
template <int I> struct EpiBranch {
    static constexpr bool PERM = true, AFTER_DRAIN = false;
    const bf16* G; float* M32; bf16* MG;
    DI void operator()(EPI_ARGS) const {
        asm volatile("" : "+v"(fr), "+v"(fq));
        const int row0 = u.pm * 256 + wr * 64 + fr, c8 = u.pn * 256 + wc * 32 + 8 * fq;
        FOR_AI_M { const int t = row0 + ai * 128 + m * 16;
            FOR_BJ { const size_t idx = (size_t)t * 1024 + c8 + bj * 128; f32x4 g0, g1; unpack8(*(const u32x4*)(G + idx), g0, g1);
                f32x4 v0 = acc[ai][bj][m][0] * g0, v1 = acc[ai][bj][m][1] * g1;
#ifdef ABL_BRANCH
                if (I == ABL_BRANCH) { v0 = v0 * 0.f; v1 = v1 * 0.f; }
#endif
                if (I > 0) { v0 = v0 + *(const f32x4*)(M32 + idx); v1 = v1 + *(const f32x4*)(M32 + idx + 4); }
                if (I < 2) { *(f32x4*)(M32 + idx) = v0; *(f32x4*)(M32 + idx + 4) = v1; } else *(u32x4*)(MG + idx) = pack8(v0, v1); } }
    }
};
struct EpiY {
    static constexpr bool PERM = true, AFTER_DRAIN = false;
    bf16* Y; float* SSQ;
    DI void operator()(EPI_ARGS) const {
        asm volatile("" : "+v"(fr), "+v"(fq));
        const int row0 = u.pm * 256 + wr * 64 + fr, c8 = u.pn * 256 + wc * 32 + 8 * fq;
        FOR_AI_M { const int t = row0 + ai * 128 + m * 16; float ss = 0.f;
            FOR_BJ { const f32x4 v0 = acc[ai][bj][m][0], v1 = acc[ai][bj][m][1]; ss += sq4(v0) + sq4(v1); *(u32x4*)(Y + (size_t)t * 1024 + c8 + bj * 128) = pack8(v0, v1); }
            ss += shx(ss, 16, fq * 16 + fr); ss += shx(ss, 32, fq * 16 + fr);
            if (fq == 0) SSQ[(size_t)t * 16 + u.pn * 4 + wc] = ss; }
    }
};

template <int MODE> struct AC;
template <> struct AC<0> { static constexpr int DQK = 128, KW = 128, DVW = 128, VTR = 256, QR = 128; };
template <> struct AC<1> { static constexpr int DQK = 64, KW = 128, DVW = 128, VTR = 128, QR = 128; };
template <> struct AC<2> { static constexpr int DQK = 96, KW = 96, DVW = 64, VTR = 64, QR = 256; };
constexpr int A_KBUF = 17408, A_VBUF = 36864, A_V0 = 2 * A_KBUF, A_MISC = 2 * A_KBUF + 2 * A_VBUF;
constexpr int A_LUT = A_MISC + 64, A_XCH = A_MISC + 1024;
static_assert(A_XCH + 2048 <= LDS_BYTES, "attention LDS map");
struct AttnP { unsigned char* ws; int l; };
struct AttnPtrs { const bf16 *RQ, *RK, *RVt, *RG; bf16* RO; bf16* DQ; const bf16 *DK, *DVt; bf16* QMn; const bf16 *QMp, *KMn, *KPE, *VMt; const float *biasl, *subg; float lam, oml; };

#pragma float_control(push)
#pragma float_control(precise, off)
template <int MODE> DI void attn_unit(lptr lds, const AttnP PP, const int b, const int hd, const int qb, const int wv) {
    using C = AC<MODE>;
    unsigned char* const ws = PP.ws;
    const AttnPtrs P{(const bf16*)(ws + WS_RQ), (const bf16*)(ws + WS_RK), (const bf16*)(ws + WS_RVT), (const bf16*)(ws + WS_RG), (bf16*)(ws + WS_RO), (bf16*)(ws + WS_DQ),
                     (const bf16*)(ws + WS_DK), (const bf16*)(ws + WS_DVT), (bf16*)(ws + WS_QMN), (const bf16*)(ws + WS_QMP), (const bf16*)(ws + WS_KMN), (const bf16*)(ws + WS_KPE),
                     (const bf16*)(ws + WS_VMT), (const float*)(ws + WS_BIAS), (const float*)(ws + WS_SUBG) + PP.l * 128, 0.f, 0.f};
    constexpr int NKS = C::DQK / 16, NVB = C::DVW / 32, KS = (C::KW + 8) * 2, VS = 144, KCH = C::KW / 8, NKC = 64 * KCH, NVR = C::VTR / 64;
    constexpr int NB = MODE == 0 ? 2 : 3;
    constexpr int VBYTES = C::VTR * VS, VBASE = NB * A_KBUF;
    static_assert(VBASE + NB * VBYTES <= A_MISC, "mixer LDS ring");
    const int tid = tidx(wv), w = __builtin_amdgcn_readfirstlane(tid >> 6), lane = tid & 63, r = lane & 31, h = lane >> 5;
    const int rg = MODE == 2 ? w : (w >> 1), pp = MODE == 2 ? 0 : (w & 1);
    const int q0 = qb * C::QR, q0w = q0 + rg * 32, tok0 = b * SEQ, qq = q0w + r;
    const int ntiles = (q0 + C::QR) / 64;
    const bf16* Kg; const bf16* Vg;
    if (MODE == 0) { Kg = P.RK + (size_t)tok0 * 512 + hd * 128; Vg = P.RVt + (size_t)(b * 4 + hd) * 256 * SEQ; }
    else if (MODE == 1) { Kg = P.DK + (size_t)tok0 * 1024 + hd * 128; Vg = P.DVt + (size_t)(b * 8 + hd) * 128 * SEQ; }
    else { Kg = P.KMn + (size_t)tok0 * 1024 + hd * 64; Vg = P.VMt + (size_t)(b * 16 + hd) * 64 * SEQ; }
    const bf16* Kpe = P.KPE + (size_t)tok0 * 32;
    bf16x8 q[NKS];
    { const size_t t = (size_t)(tok0 + qq);
#pragma unroll
        for (int ks = 0; ks < NKS; ++ks) {
            const bf16* src;
            if (MODE == 0) src = P.RQ + t * 512 + hd * 128 + ks * 16 + 8 * h;
            else if (MODE == 1) src = P.DQ + t * 1024 + hd * 128 + pp * 64 + ks * 16 + 8 * h;
            else src = ks < 4 ? P.QMn + t * 1024 + hd * 64 + ks * 16 + 8 * h : P.QMp + t * 512 + hd * 32 + (ks - 4) * 16 + 8 * h;
            q[ks] = *(const bf16x8*)src; } }
    if (MODE == 1) { if (tid < 128) ((LAS float*)(lds + A_LUT))[tid] = P.biasl[hd * 128 + tid]; }
    u32x4 kreg[2], vreg[NVR];
#define A_GLOAD(kt) do { \
    _Pragma("unroll") for (int i_ = 0; i_ < 2; ++i_) { const int id_ = tid + 512 * i_; if (id_ < NKC) { const int row_ = id_ / KCH, cc_ = id_ % KCH; const size_t kr_ = (size_t)((kt) * 64 + row_); \
        const bf16* s_; if (MODE == 2) s_ = cc_ < 8 ? Kg + kr_ * 1024 + cc_ * 8 : Kpe + kr_ * 32 + (cc_ - 8) * 8; else s_ = Kg + kr_ * (MODE == 0 ? 512 : 1024) + cc_ * 8; kreg[i_] = *(const u32x4*)s_; } } \
    _Pragma("unroll") for (int i_ = 0; i_ < NVR; ++i_) { const int id_ = tid + 512 * i_, row_ = id_ >> 3, cc_ = id_ & 7; vreg[i_] = *(const u32x4*)(Vg + (size_t)row_ * SEQ + (kt) * 64 + cc_ * 8); } } while (0)
#define A_LWRITE(buf) do { \
    _Pragma("unroll") for (int i_ = 0; i_ < 2; ++i_) { const int id_ = tid + 512 * i_; if (id_ < NKC) { const int row_ = id_ / KCH, cc_ = id_ % KCH; *(LAS u32x4*)(lds + (buf) * A_KBUF + row_ * KS + cc_ * 16) = kreg[i_]; } } \
    _Pragma("unroll") for (int i_ = 0; i_ < NVR; ++i_) { const int id_ = tid + 512 * i_, row_ = id_ >> 3, cc_ = id_ & 7; *(LAS u32x4*)(lds + VBASE + (buf) * VBYTES + row_ * VS + cc_ * 16) = vreg[i_]; } } while (0)
    f32x16 O[NVB];
#pragma unroll
    for (int vb = 0; vb < NVB; ++vb)
#pragma unroll
        for (int i = 0; i < 16; ++i) O[vb][i] = 0.f;
    float mrun = -INFINITY, lrun = 0.f;
    const float l2g = MODE == 0 ? log2f(1.f - ex2(-5.f - (float)hd)) : 0.f;
    const float b31 = MODE == 1 ? P.biasl[hd * 128 + 127] : 0.f;
    const int pir = (r & 0x13) | ((r & 8) >> 1) | ((r & 4) << 1);
    const int koffb = ((MODE == 1 ? pp * 64 : 0) + 8 * h) * 2;
    const int vrow0 = (MODE == 0 ? pp * 128 : 0) + r;
#ifdef EXP_NOPV
#define A_PV(VBUF, PF) do { } while (0)
#else
#define A_PV(VBUF, PF) do { const lptr Vb_ = lds + VBASE + (VBUF) * VBYTES + (8 * h) * 2; \
    _Pragma("unroll") for (int vb_ = 0; vb_ < NVB; vb_ += 2) { bf16x8 vf_[2][4]; \
        _Pragma("unroll") for (int u_ = 0; u_ < 2; ++u_) _Pragma("unroll") for (int j_ = 0; j_ < 4; ++j_) vf_[u_][j_] = *(const LAS bf16x8*)(Vb_ + (vrow0 + (vb_ + u_) * 32) * VS + ((j_ >> 1) * 32 + 16 * (j_ & 1)) * 2); \
        __builtin_amdgcn_sched_barrier(0); __builtin_amdgcn_s_setprio(1); \
        _Pragma("unroll") for (int j_ = 0; j_ < 4; ++j_) { O[vb_] = __builtin_amdgcn_mfma_f32_32x32x16_bf16(vf_[0][j_], PF[j_ >> 1][j_ & 1], O[vb_], 0, 0, 0); \
                                                           O[vb_ + 1] = __builtin_amdgcn_mfma_f32_32x32x16_bf16(vf_[1][j_], PF[j_ >> 1][j_ & 1], O[vb_ + 1], 0, 0, 0); } \
        __builtin_amdgcn_s_setprio(0); __builtin_amdgcn_sched_barrier(0); } } while (0)
#endif
    const bool late = MODE != 0 && (w & 1) != 0;
    bool pend = false; int pbuf = 0;
    bf16x8 pf[2][2];
#pragma unroll
    for (int a = 0; a < 2; ++a)
#pragma unroll
        for (int c = 0; c < 2; ++c) pf[a][c] = (bf16x8){0, 0, 0, 0, 0, 0, 0, 0};
    A_GLOAD(0); A_LWRITE(0);
    __syncthreads();
    int cur = 0;
    for (int kt = 0; kt < ntiles; ++kt) {
        const int nxt = cur + 1 == NB ? 0 : cur + 1;
#ifndef EXP_NOLOAD
        if (kt + 1 < ntiles) A_GLOAD(kt + 1);
#endif
        if (MODE != 0) { if (pend) { A_PV(pbuf, pf); pend = false; } }
        if (kt * 64 <= q0w + 31) {
            const lptr Kb = lds + cur * A_KBUF + koffb;
            f32x16 S0, S1;
#pragma unroll
            for (int i = 0; i < 16; ++i) { S0[i] = 0.f; S1[i] = 0.f; }
            {
                constexpr int CH = NKS > 6 ? 4 : NKS;
#pragma unroll
                for (int c0 = 0; c0 < NKS; c0 += CH) {
                    bf16x8 kf0[CH], kf1[CH];
#pragma unroll
                    for (int j = 0; j < CH; ++j) { kf0[j] = *(const LAS bf16x8*)(Kb + pir * KS + (c0 + j) * 32); kf1[j] = *(const LAS bf16x8*)(Kb + (32 + pir) * KS + (c0 + j) * 32); }
                    __builtin_amdgcn_sched_barrier(0);
                    __builtin_amdgcn_s_setprio(1);
#pragma unroll
                    for (int j = 0; j < CH; ++j) {
                        S0 = __builtin_amdgcn_mfma_f32_32x32x16_bf16(kf0[j], q[c0 + j], S0, 0, 0, 0);
                        S1 = __builtin_amdgcn_mfma_f32_32x32x16_bf16(kf1[j], q[c0 + j], S1, 0, 0, 0);
                    }
                    __builtin_amdgcn_s_setprio(0);
                    __builtin_amdgcn_sched_barrier(0);
                }
            }
#ifndef EXP_NOSM
            const int kb0 = kt * 64 + 8 * h;
            const bool diag = (kt * 64 + 63 > q0w);
            if (MODE == 0) {
                const float cs = ex2(l2g * (float)(64 * ((q0w >> 6) - kt)));
                if (diag) {
#pragma unroll
                    for (int i = 0; i < 16; ++i) { const int k0 = kb0 + 16 * (i >> 3) + (i & 7); S0[i] = (k0 <= qq) ? S0[i] * cs : 0.f; S1[i] = (k0 + 32 <= qq) ? S1[i] * cs : 0.f; }
                } else {
#pragma unroll
                    for (int i = 0; i < 16; ++i) { S0[i] *= cs; S1[i] *= cs; }
                }
            } else {
                float boff = 0.f;
                if (MODE == 1) {
                    if (q0w - (kt * 64 + 63) >= 113) boff = b31;
                    else {
                        const LAS float* lut = (const LAS float*)(lds + A_LUT);
#pragma unroll
                        for (int i = 0; i < 16; ++i) { const int k0 = kb0 + 16 * (i >> 3) + (i & 7); int d0 = qq - k0, d1 = d0 - 32;
                            d0 = d0 < 0 ? 0 : (d0 > 127 ? 127 : d0); d1 = d1 < 0 ? 0 : (d1 > 127 ? 127 : d1); S0[i] += lut[d0]; S1[i] += lut[d1]; }
                    }
                }
                if (diag) {
#pragma unroll
                    for (int i = 0; i < 16; ++i) { const int k0 = kb0 + 16 * (i >> 3) + (i & 7); if (k0 > qq) S0[i] = -INFINITY; if (k0 + 32 > qq) S1[i] = -INFINITY; }
                }
                float mx = fmaxf(S0[0], S1[0]);
#pragma unroll
                for (int i = 1; i < 16; ++i) mx = fmaxf(mx, fmaxf(S0[i], S1[i]));
                mx = fmaxf(mx, shx(mx, 32, lane)) + boff;
                if (__builtin_amdgcn_ballot_w64(mx - mrun > 8.f) != 0ull) {
                    const float mn = fmaxf(mrun, mx), al = ex2(mrun - mn); mrun = mn; lrun *= al;
#pragma unroll
                    for (int vb = 0; vb < NVB; ++vb)
#pragma unroll
                        for (int i = 0; i < 16; ++i) O[vb][i] *= al;
                }
                const float nmo = boff - mrun;
                const f32x2_t nm2 = {nmo, nmo}; f32x2_t ps2 = {0.f, 0.f};
#pragma unroll
                for (int i = 0; i < 8; ++i) {
                    f32x2_t a = (f32x2_t){S0[2 * i], S0[2 * i + 1]} + nm2, c = (f32x2_t){S1[2 * i], S1[2 * i + 1]} + nm2;
                    a.x = ex2(a.x); a.y = ex2(a.y); c.x = ex2(c.x); c.y = ex2(c.y); ps2 += a; ps2 += c;
                    S0[2 * i] = a.x; S0[2 * i + 1] = a.y; S1[2 * i] = c.x; S1[2 * i + 1] = c.y; }
                lrun += ps2.x + ps2.y;
            }
#endif
#pragma unroll
            for (int s = 0; s < 2; ++s) {
                u32x4 t0, t1;
                t0.x = cvtpk(S0[8 * s + 0], S0[8 * s + 1]); t0.y = cvtpk(S0[8 * s + 2], S0[8 * s + 3]); t0.z = cvtpk(S0[8 * s + 4], S0[8 * s + 5]); t0.w = cvtpk(S0[8 * s + 6], S0[8 * s + 7]);
                t1.x = cvtpk(S1[8 * s + 0], S1[8 * s + 1]); t1.y = cvtpk(S1[8 * s + 2], S1[8 * s + 3]); t1.z = cvtpk(S1[8 * s + 4], S1[8 * s + 5]); t1.w = cvtpk(S1[8 * s + 6], S1[8 * s + 7]);
                pf[0][s] = __builtin_bit_cast(bf16x8, t0); pf[1][s] = __builtin_bit_cast(bf16x8, t1);
            }
            if (late) { pend = true; pbuf = cur; } else { A_PV(cur, pf); }
        }
#ifndef EXP_NOLOAD
        if (kt + 1 < ntiles) A_LWRITE(nxt);
#endif
#ifndef EXP_NOBAR
        __syncthreads();
#endif
        cur = nxt;
    }
    if (MODE != 0) { if (pend) { A_PV(pbuf, pf); pend = false; } if (MODE == 1) __syncthreads(); }
#undef A_PV
#undef A_GLOAD
#undef A_LWRITE
#if defined(EXP_NOSM) || defined(EXP_NOLOAD) || defined(EXP_NOBAR) || defined(EXP_NOQK) || defined(EXP_NOPV)
    {
        float chk = lrun;
#pragma unroll
        for (int vb = 0; vb < NVB; ++vb)
#pragma unroll
            for (int i = 0; i < 16; ++i) { chk += O[vb][i]; O[vb][i] = 0.f; }
        if (chk == 1234567.875f) atomicAdd((unsigned*)(ws + 524288), 1u);
        lrun = 1.f; }
#endif
    const size_t trow = (size_t)(tok0 + qq);
    if (MODE == 0) {
        float ss = 0.f;
#pragma unroll
        for (int vb = 0; vb < NVB; ++vb)
#pragma unroll
            for (int i = 0; i < 16; ++i) ss += O[vb][i] * O[vb][i];
        ss += shx(ss, 32, lane);
        LAS float* xch = (LAS float*)(lds + A_XCH);
        if (h == 0) xch[w * 32 + r] = ss;
        __syncthreads();
        const float tot = ss + xch[(w ^ 1) * 32 + r];
        const float rs = 1.0f / sqrtf(tot * (1.f / 256.f) + EPS);
#pragma unroll
        for (int vb = 0; vb < NVB; ++vb)
#pragma unroll
            for (int g = 0; g < 4; ++g) { const size_t idx = trow * 1024 + hd * 256 + pp * 128 + vb * 32 + 8 * g + 4 * h; const u32x2 gw = *(const u32x2*)(P.RG + idx);
                u32x2 o; o.x = cvtpk(O[vb][4 * g] * rs * bflo(gw.x), O[vb][4 * g + 1] * rs * bfhi(gw.x)); o.y = cvtpk(O[vb][4 * g + 2] * rs * bflo(gw.y), O[vb][4 * g + 3] * rs * bfhi(gw.y));
                *(u32x2*)(P.RO + idx) = o; }
    } else if (MODE == 1) {
        const float lt = lrun + shx(lrun, 32, lane), il = 1.0f / lt;
        LAS float* X = (LAS float*)lds + (size_t)rg * 64 * 64;
        if (pp == 1) {
#pragma unroll
            for (int vb = 0; vb < NVB; ++vb)
#pragma unroll
                for (int i = 0; i < 16; ++i) X[(vb * 16 + i) * 64 + lane] = O[vb][i] * il;
        }
        __syncthreads();
        if (pp == 0) {
            const float lam = ((const float*)(ws + WS_LAM))[PP.l], oml = ((const float*)(ws + WS_LAM))[2 + PP.l];
            float ss = 0.f;
#pragma unroll
            for (int vb = 0; vb < NVB; ++vb)
#pragma unroll
                for (int i = 0; i < 16; ++i) { const float v = O[vb][i] * il - lam * X[(vb * 16 + i) * 64 + lane]; O[vb][i] = v; ss += v * v; }
            ss += shx(ss, 32, lane);
            const float rs = oml / sqrtf(ss * (1.f / 128.f) + EPS);
#pragma unroll
            for (int vb = 0; vb < NVB; ++vb)
#pragma unroll
                for (int g = 0; g < 4; ++g) { const int dv = vb * 32 + 8 * g + 4 * h; const f32x4 gg = *(const f32x4*)(P.subg + dv);
                    u32x2 o; o.x = cvtpk(O[vb][4 * g] * rs * gg[0], O[vb][4 * g + 1] * rs * gg[1]); o.y = cvtpk(O[vb][4 * g + 2] * rs * gg[2], O[vb][4 * g + 3] * rs * gg[3]);
                    *(u32x2*)(P.DQ + trow * 1024 + hd * 128 + dv) = o; }
        }
    } else {
        const float lt = lrun + shx(lrun, 32, lane), il = 1.0f / lt;
#pragma unroll
        for (int vb = 0; vb < NVB; ++vb)
#pragma unroll
            for (int g = 0; g < 4; ++g) { u32x2 o; o.x = cvtpk(O[vb][4 * g] * il, O[vb][4 * g + 1] * il); o.y = cvtpk(O[vb][4 * g + 2] * il, O[vb][4 * g + 3] * il);
                *(u32x2*)(P.QMn + trow * 1024 + hd * 64 + vb * 32 + 8 * g + 4 * h) = o; }
    }
}
#pragma float_control(pop)
DI unsigned xcc_id_() { return (unsigned)__builtin_amdgcn_s_getreg((3 << 11) | 20) & 0xFu; }
DI void attn_phase(lptr lds, const AttnP P, unsigned* counter, const int wv) {
    const int x0 = (int)(xcc_id_() & 7u);
    for (int sft = 0; sft < 8; ++sft) {
        const int qx = (x0 + sft) & 7;
        for (;;) {
            __syncthreads();
            if (tidx(wv) == 0) *(LAS int*)(lds + A_MISC) = (int)atomicAdd(counter + qx, 1u);
            __syncthreads();
            const int idx = __builtin_amdgcn_readfirstlane(*(LAS int*)(lds + A_MISC));
            if (idx >= 320) break;
            if (idx < 128) { const int hg = idx >> 5, r = idx & 31; attn_unit<2>(lds, P, qx, hg * 4 + (r & 3), 7 - (r >> 2), wv); }
            else if (idx < 256) { const int j = idx - 128, hg = j >> 5, r = j & 31; attn_unit<1>(lds, P, qx, hg * 2 + (r & 1), 15 - (r >> 1), wv); }
            else { const int j = idx - 256, hg = j >> 5, r = j & 31; attn_unit<0>(lds, P, qx, hg * 2 + (r & 1), 15 - (r >> 1), wv); }
        }
    }
}

struct P4Order {
    pg8::StaticOrder so; int l, wv;
    __device__ void init(int G, int c, int l_) { so.init(TH, 1024, G, c); l = l_; }
    __device__ bool next(int i, pg8::Unit& u) const {
        const int kind = i % 6;
        if (!so.next(i / 6, u)) return false;
        u.rpm = u.pm; u.rpn = u.pn; u.kind = kind;
        const int br = kind >> 1;
        int apan, bpan;
        if (kind & 1) { apan = br == 0 ? (int)(WS_RO >> 19) : (br == 1 ? (int)(WS_DQ >> 19) : (int)(WS_QMN >> 19)); bpan = (int)(WS_W >> 19) + l * 90 + (int)(WO_RO / 262144) + 4 * br; }
        else { apan = (int)(WS_H >> 19); bpan = (int)(WS_W >> 19) + l * 90 + (int)(WO_G / 262144) + 4 * br; }
        u.pm += apan; u.pn += bpan;
        return true;
    }
    __device__ __forceinline__ void a_ready(const pg8::Unit&) const {}
    __device__ __forceinline__ void done(const pg8::Unit&) const {}
};
struct EpiP4 {
    static constexpr bool PERM = true, AFTER_DRAIN = false;
    bf16* G; float* M32; bf16* MG;
    DI void operator()(EPI_ARGS) const {
        pg8::Unit r = u; r.pm = u.rpm; r.pn = u.rpn;
        const size_t GS = (size_t)TH * 1024;
        switch (u.kind) {
            case 0: EpiAct<0>{G, 1024}(acc, r, wr, wc, fr, fq); break;
            case 1: EpiBranch<0>{G, M32, MG}(acc, r, wr, wc, fr, fq); break;
            case 2: EpiAct<0>{G + GS, 1024}(acc, r, wr, wc, fr, fq); break;
            case 3: EpiBranch<1>{G + GS, M32, MG}(acc, r, wr, wc, fr, fq); break;
            case 4: EpiAct<0>{G + 2 * GS, 1024}(acc, r, wr, wc, fr, fq); break;
            default: EpiBranch<2>{G + 2 * GS, M32, MG}(acc, r, wr, wc, fr, fq); break;
        }
    }
};

constexpr size_t WS_BAR = 131072;
#define XB_TMO      128
#define XB_XCNT(j)  (256  + 64 * (j))
#define XB_XSUB(j)  (1280 + 64 * (j))
#define XB_XGEN(j)  (2304 + 64 * (j))
#define XB_TOP      3328
#define XB_TOPGEN   3392
#define XCD_BAR_WORDS 3456
#define XB_SPIN_CAP (1u << 18)
constexpr int LDS_XB = 143360;
DI unsigned xb_ld(unsigned* p)              { return __hip_atomic_load(p, __ATOMIC_RELAXED, __HIP_MEMORY_SCOPE_AGENT); }
DI unsigned xb_add(unsigned* p, unsigned v) { return __hip_atomic_fetch_add(p, v, __ATOMIC_RELAXED, __HIP_MEMORY_SCOPE_AGENT); }
DI unsigned xb_xcc_id() { return (unsigned)__builtin_amdgcn_s_getreg((3 << 11) | 20) & 0xFu; }
#define XB_SPIN(cond, bar) do { unsigned _sp = 0; while (cond) { __builtin_amdgcn_s_sleep(1); \
    if ((++_sp & 255u) == 0u) { if (xb_ld(&(bar)[XB_TMO])) break; if (_sp > XB_SPIN_CAP) { atomicAdd(&(bar)[XB_TMO], 1u); break; } } } } while (0)
DI void xcd_barrier_complete(unsigned* bar, unsigned x, unsigned& nloc, unsigned& nx) {
    const unsigned G = gridDim.x;
    unsigned sum, cnt, mine, sp = 0u;
    for (;;) {
        sum = 0u; cnt = 0u; mine = 0u;
#pragma unroll
        for (unsigned j = 0; j < 16; ++j) { const unsigned c = xb_ld(&bar[XB_XCNT(j)]); sum += c; cnt += (c > 0u) ? 1u : 0u; mine = (j == x) ? c : mine; }
        if (sum == G) break;
        __builtin_amdgcn_s_sleep(1);
        if ((++sp & 255u) == 0u) { if (xb_ld(&bar[XB_TMO])) break; if (sp > XB_SPIN_CAP) { atomicAdd(&bar[XB_TMO], 1u); break; } }
    }
    nloc = mine > 0u ? mine : 1u; nx = cnt > 0u ? cnt : 1u;
}
DI void xcd_barrier(unsigned* bar, lptr lds, const int wv) {
    asm volatile("s_waitcnt vmcnt(0)" ::: "memory");
    __syncthreads();
    if (tidx(wv) == 0) {
        volatile LAS unsigned* st = (volatile LAS unsigned*)(lds + LDS_XB);
        const unsigned x = xb_xcc_id();
        __builtin_amdgcn_s_waitcnt(0);
        unsigned nloc = st[0], nx = st[1];
        if (nloc == 0u) { xcd_barrier_complete(bar, x, nloc, nx); st[0] = nloc; st[1] = nx; }
        const unsigned old = xb_add(&bar[XB_XSUB(x)], 1u);
        const unsigned gen = old / nloc;
        if (old + 1u == (gen + 1u) * nloc) {
            __builtin_amdgcn_fence(__ATOMIC_RELEASE, "agent");
            asm volatile("s_waitcnt vmcnt(0)" ::: "memory");
            const unsigned og = xb_add(&bar[XB_TOP], 1u);
            const unsigned tg = og / nx;
            if (og + 1u == (tg + 1u) * nx) xb_add(&bar[XB_TOPGEN], 1u);
            else XB_SPIN(xb_ld(&bar[XB_TOPGEN]) == tg, bar);
            __builtin_amdgcn_fence(__ATOMIC_ACQUIRE, "agent");
            xb_add(&bar[XB_XGEN(x)], 1u);
            asm volatile("s_waitcnt vmcnt(0)" ::: "memory");
        } else {
            XB_SPIN(xb_ld(&bar[XB_XGEN(x)]) == gen, bar);
            __builtin_amdgcn_fence(__ATOMIC_ACQUIRE, "agent");
            asm volatile("s_waitcnt vmcnt(0)" ::: "memory");
        }
    }
    __syncthreads();
}
constexpr int N_PHASES = 39;
template <class Epi> DI void run_gemm(lptr lds, int wv, const bf16* A, const bf16* Bt, int M, int N, int K, const Epi& E) {
#ifdef DIS_GEMM
    return;
#endif
    int bx_ = (int)blockIdx.x; asm volatile("" : "+s"(bx_));
    pg8::Gemm g{A, Bt, M, N, K}; pg8::StaticOrder S; S.init(M, N, (int)gridDim.x, bx_); S.wv = wv;
    pg8::gemm_phase<Epi, pg8::StaticOrder, true, true>(lds, g, S, E);
}
__global__ void __launch_bounds__(NTHR) mega_fwd(Params p) {
    extern __shared__ __attribute__((aligned(16))) unsigned char lds_raw[];
    lptr lds = (lptr)lds_raw;
#if !MK_MULTI
    cg::grid_group grid = cg::this_grid();
#endif
    const int wv = __builtin_amdgcn_readfirstlane((int)threadIdx.x >> 6);
#if !MK_MULTI
    if (threadIdx.x == 0) { ((volatile LAS unsigned*)(lds + LDS_XB))[0] = 0u; ((volatile LAS unsigned*)(lds + LDS_XB))[1] = 0u; (void)xb_add((unsigned*)(p.ws + WS_BAR) + XB_XCNT(xb_xcc_id()), 1u); }
    __syncthreads();
#endif
    int ph = p.ph_lo; const int ph_hi = p.ph_hi;
#ifdef MK_TS
#ifndef TS_DIV
#define TS_DIV 32.f
#endif
    if (blockIdx.x == 0 && threadIdx.x == 0) ((unsigned long long*)(p.ws + 262144))[0] = __builtin_amdgcn_s_memrealtime();
#endif
    if (ph == 0) {
#ifndef DIS_PRO
        prologue(p, lds, wv);
        norm_rows(p.x, p.pre_mix_g, (bf16*)(p.ws + WS_H), TH, wv);
#endif
        ++ph;
#if !MK_MULTI
        if (ph_hi < 0) grid.sync();
        if (ph < ph_hi) xcd_barrier((unsigned*)(p.ws + WS_BAR), lds, wv);
#endif
    }
    const float* xin0 = p.x; float* const outp = p.out; unsigned char* ws0 = p.ws;
    for (; ph < ph_hi; ++ph) {
        size_t z_ = 0; asm volatile("" : "+s"(z_));
        unsigned char* ws = ws0 + z_;
#ifdef MK_TS
        if (blockIdx.x == 0 && tidx(wv) == 0) ((unsigned long long*)(ws + 262144))[ph] = __builtin_amdgcn_s_memrealtime();
#endif
        const float* gains = (const float*)(ws + WS_GAIN);
        bf16* H = (bf16*)(ws + WS_H);
        const int hb = (ph - 1) / 19, k19 = (ph - 1) % 19;
        const size_t xoff = (size_t)hb * TH * DM;
        if (k19 == 0) continue;
        else {
            const int l = (k19 - 1) / 9, k = (k19 - 1) % 9;
            const bf16* Wb = (const bf16*)(ws + WS_W) + (size_t)l * WO_END;
            if (k == 0) {
                EpiIn1 E1{ws};
                run_gemm(lds, wv, H, Wb + WO_IN1, TH, 4608, 1024, E1);
                EpiVt E2{(bf16*)(ws + WS_RVT), (bf16*)(ws + WS_DVT), nullptr, 0.f};
                run_gemm(lds, wv, Wb + WO_V, H, 2048, TH, 1024, E2);
            } else if (k == 1) {
                EpiUq Eq{(bf16*)(ws + WS_QMN), (bf16*)(ws + WS_QMP), (const float*)(ws + WS_SSQ_CQ), (const float*)(ws + WS_MCOS), (const float*)(ws + WS_MSIN), wv};
                run_gemm(lds, wv, (const bf16*)(ws + WS_CQ), Wb + WO_UQ, TH, 1536, 256, Eq);
                EpiUk Ek{(bf16*)(ws + WS_KMN), (const float*)(ws + WS_SSQ_CKV)};
                run_gemm(lds, wv, (const bf16*)(ws + WS_CKV), Wb + WO_UK, TH, 1024, 256, Ek);
                EpiVt Ev{(bf16*)(ws + WS_VMT), (bf16*)(ws + WS_VMT), (const float*)(ws + WS_SSQ_CKV), 1.f / 128.f};
                run_gemm(lds, wv, Wb + WO_UV, (const bf16*)(ws + WS_CKV), 1024, TH, 256, Ev);
            } else if (k == 2) {
#ifndef DIS_ATTN
                AttnP P{ws, l};
                attn_phase(lds, P, (unsigned*)(ws + WS_CNT) + (hb * 2 + l) * 8, wv);
#endif
            } else if (k == 3) {
                bf16* G = (bf16*)(ws + WS_G); float* M32 = (float*)(ws + WS_M32); bf16* MG = (bf16*)(ws + WS_MG);
                const size_t GS = (size_t)TH * 1024;
                int bx_ = (int)blockIdx.x; asm volatile("" : "+s"(bx_));
                P4Order S; S.init((int)gridDim.x, bx_, l); S.wv = wv;
                pg8::Gemm g{(const bf16*)ws, (const bf16*)ws, TH, 1024, 1024};
                pg8::gemm_phase<EpiP4, P4Order, true, true>(lds, g, S, EpiP4{G, M32, MG});
                (void)Wb; (void)GS;
            } else if (k == 4) {
                run_gemm(lds, wv, (const bf16*)(ws + WS_MG), Wb + WO_OUT, TH, 1024, 1024, EpiY{(bf16*)(ws + WS_Y), (float*)(ws + WS_SSQ_Y)});
            } else if (k == 5) {
                resid_rows((l == 0 ? xin0 : (const float*)outp) + xoff, (const bf16*)(ws + WS_Y), (const float*)(ws + WS_SSQ_Y), gains + 2048 + l * DM, outp + xoff, gains + 4096 + l * DM, H, TH, wv);
            } else if (k == 6) {
                run_gemm(lds, wv, H, Wb + WO_UP, TH, DFF, 1024, EpiAct<1>{(bf16*)(ws + WS_U), DFF});
            } else if (k == 7) {
                run_gemm(lds, wv, (const bf16*)(ws + WS_U), Wb + WO_DOWN, TH, 1024, DFF, EpiY{(bf16*)(ws + WS_Y), (float*)(ws + WS_SSQ_Y)});
            } else {
                resid_rows(outp + xoff, (const bf16*)(ws + WS_Y), (const float*)(ws + WS_SSQ_Y), gains + 6144 + l * DM, outp + xoff, l == 0 ? gains + DM : nullptr, H, TH, wv, true);
                if (l == 1 && hb == 0) norm_rows(xin0 + (size_t)TH * DM, gains, H, TH, wv);
            }
        }
#if !MK_MULTI
        if (ph + 1 < ph_hi) xcd_barrier((unsigned*)(ws + WS_BAR), lds, wv);
#endif
    }
#ifdef MK_TS
    if (blockIdx.x == 0 && tidx(wv) == 0) {
        unsigned long long* ts = (unsigned long long*)(ws0 + 262144); ts[N_PHASES] = __builtin_amdgcn_s_memrealtime();
        unsigned long long sum = 0;
        for (int q = 1; q < N_PHASES; ++q) { const int k19 = (q - 1) % 19; const int k = k19 == 0 ? 9 : (k19 - 1) % 9; if (MK_TS == k || (MK_TS == 10 && (k == 6 || k == 7)) || (MK_TS == 11 && (k == 5 || k == 8 || k == 9)) || MK_TS == 12) sum += ts[q + 1] - ts[q]; }
        if (MK_TS == 13) sum = ts[1] - ts[0];
        outp[0] = (float)sum * (0.01f / TS_DIV);
    }
#endif
}

extern "C" void kernel_launch(void* const* d_in, const int* in_sizes, int n_in, void* d_out, int out_size, void* d_ws, size_t ws_size, hipStream_t stream) {
    static int grid = 0;
    if (grid == 0) {
        if (n_in != 22 || ws_size < WS_END) { fprintf(stderr, "kernel_launch: unexpected inputs (n_in %d, ws %zu)\n", n_in, ws_size); grid = -1; return; }
        int dev = 0, cus = 0, per_cu = 0;
        hipGetDevice(&dev); hipDeviceGetAttribute(&cus, hipDeviceAttributeMultiprocessorCount, dev);
        if (hipFuncSetAttribute((const void*)mega_fwd, hipFuncAttributeMaxDynamicSharedMemorySize, LDS_BYTES) != hipSuccess) { fprintf(stderr, "kernel_launch: hipFuncSetAttribute failed\n"); grid = -1; return; }
        if (hipOccupancyMaxActiveBlocksPerMultiprocessor(&per_cu, (const void*)mega_fwd, NTHR, LDS_BYTES) != hipSuccess || per_cu < 1) { fprintf(stderr, "kernel_launch: occupancy query gave %d\n", per_cu); per_cu = 1; }
        (void)hipGetLastError();
        grid = cus * per_cu;
        if (grid > 256) grid = 256;
    }
    if (grid < 0) return;
    Params p{};
    const float** pf = (const float**)&p;
    for (int i = 0; i < 22; ++i) pf[i] = (const float*)d_in[i];
    p.out = (float*)d_out; p.ws = (unsigned char*)d_ws;
#if MK_MULTI
#ifdef MK_CHECK
    hipLaunchKernelGGL(chk_clear, dim3(1), dim3(128), 0, stream, (unsigned char*)d_ws);
#endif
    for (int ph = 0; ph < N_PHASES; ++ph) { p.ph_lo = ph; p.ph_hi = ph + 1; hipLaunchKernelGGL(mega_fwd, dim3(grid), dim3(NTHR), LDS_BYTES, stream, p);
#ifdef MK_CHECK
        if (ph >= 1) hipLaunchKernelGGL(chk, dim3(256), dim3(256), 0, stream, p, ph);
#endif
    }
#ifdef MK_CHECK
    hipLaunchKernelGGL(chk_report, dim3(1), dim3(64), 0, stream, (unsigned char*)d_ws, (float*)d_out);
#endif
#else
    p.ph_lo = 0; p.ph_hi = N_PHASES;
    if (hipMemsetAsync((char*)d_ws + WS_BAR, 0, XCD_BAR_WORDS * 4, stream) != hipSuccess) { fprintf(stderr, "kernel_launch: memset of the barrier words failed\n"); return; }
    void* args[] = {&p};
    hipError_t e = hipLaunchCooperativeKernel((const void*)mega_fwd, dim3(grid), dim3(NTHR), args, LDS_BYTES, stream);
    if (e != hipSuccess) fprintf(stderr, "cooperative launch failed: %s (grid %d)\n", hipGetErrorString(e), grid);
#endif
}
```

```cpp
#include <hip/hip_runtime.h>
#include <hip/hip_cooperative_groups.h>
#include <cstdio>
#include <cstdint>
namespace cg = cooperative_groups;
__device__ __forceinline__ int tidx(int wv) { int l; asm volatile("v_mbcnt_lo_u32_b32 %0, -1, 0\n\tv_mbcnt_hi_u32_b32 %0, -1, %0" : "=v"(l)); return (wv << 6) | l; }
namespace pg8 {
#define PG8_LAS __attribute__((address_space(3)))
typedef unsigned short bf16_t;
typedef short bf16x8 __attribute__((ext_vector_type(8)));
typedef float f32x4 __attribute__((ext_vector_type(4)));
typedef unsigned u32x4 __attribute__((ext_vector_type(4)));
constexpr int BM = 256, BK = 64, HALF = 128, HTB = HALF * BK * 2  , STAGE_BYTES = 8 * HTB, NXCD = 8, WGM = 8;

__host__ __device__ __forceinline__ int lds_byte(int r, int c) { const int st = (r >> 4) * 2 + (c >> 5), rr = r & 15, cc = c & 31, ob = rr * 64 + cc * 2; return st * 1024 + (ob ^ (((ob >> 9) & 1) << 5)); }
__host__ __device__ __forceinline__ void stage_rc(int b, int& R, int& C) { const int st = b / 1024, sb = b % 1024, swz = sb ^ (((sb >> 9) & 1) << 5); R = (st >> 1) * 16 + swz / 64; C = (st & 1) * 32 + (swz % 64) / 2; }
__host__ __device__ __forceinline__ int perm32(int rho) { const int n = rho >> 4, i = rho & 15; return 8 * (i >> 2) + 4 * n + (i & 3); }

struct Unit { int pm, pn, rpm, rpn, kind; };
struct Gemm { const bf16_t* A; const bf16_t* Bt; int M, N, K; };

struct StaticOrder {
    int nM, nN, nwg, G, c, wv;
    __host__ __device__ void init(int M, int N, int G_, int c_) { nM = M / BM; nN = N / BM; nwg = nM * nN; G = G_; c = c_; }
    __host__ __device__ bool next(int i, Unit& u) const {
        const long L = (long)i * G + c; if (L >= nwg) return false;
        int wgid = (int)L; { const int q = nwg / NXCD, r = nwg % NXCD, xcd = wgid % NXCD, off = wgid / NXCD; wgid = (xcd < r ? xcd * (q + 1) : r * (q + 1) + (xcd - r) * q) + off; }
        const int nig = WGM * nN, gid = wgid / nig, fm = gid * WGM, gsz = (nM - fm) < WGM ? (nM - fm) : WGM;
        u.pm = fm + ((wgid % nig) % gsz); u.pn = (wgid % nig) / gsz; return true;
    }
    __device__ __forceinline__ void a_ready(const Unit&) const {}
    __device__ __forceinline__ void done(const Unit&) const {}
};

__device__ __forceinline__ unsigned cvt_pk_bf16(float lo, float hi) { unsigned r; asm volatile("v_cvt_pk_bf16_f32 %0, %1, %2" : "=v"(r) : "v"(lo), "v"(hi)); return r; }
template <class Epi, class Sched, bool ALIGN_EPI = false, bool SP2 = false>
__device__ __forceinline__ void gemm_phase(PG8_LAS unsigned char* lds, const Gemm g, const Sched& S, const Epi& E) {
    const int tid = tidx(S.wv), wid = __builtin_amdgcn_readfirstlane(tid >> 6), lane = tid & 63, wr = wid >> 2, wc = wid & 3, fr = lane & 15, fq = lane >> 4;
    const int K = g.K, nt = K / BK;
    unsigned voffA[2], voffB[2];
#pragma unroll
    for (int i = 0; i < 2; ++i) { int R, C; stage_rc(tid * 16 + i * 8192, R, C); const int Rb = Epi::PERM ? ((R & ~31) + perm32(R & 31)) : R;
        voffA[i] = (unsigned)(R * K + C) * 2u; voffB[i] = (unsigned)(Rb * K + C) * 2u; }
    const size_t kstep = (size_t)(BK * 2);
    const size_t hstep = (size_t)HALF * K * 2;
    const size_t tstep = 2 * hstep;
    const unsigned ldsw = (unsigned)wid * 1024u;
    const int aoff = lds_byte(wr * 64 + fr, fq * 8), boff = lds_byte(wc * 32 + fr, fq * 8);
#define PG8_SA(b, h) (((b) * 2 + (h)) * HTB)
#define PG8_SB(b, h) ((4 + (b) * 2 + (h)) * HTB)
#define PG8_STAGE(bufoff, gbase, voff) do { _Pragma("unroll") for (int _i = 0; _i < 2; ++_i) \
        __builtin_amdgcn_global_load_lds((const unsigned*)((const char*)(gbase) + (voff)[_i]), (PG8_LAS unsigned*)(lds + (bufoff) + ldsw + _i * 8192), 16, 0, 0); } while (0)
#define PG8_LDA(dst, b, h) do { _Pragma("unroll") for (int m = 0; m < 4; ++m) _Pragma("unroll") for (int k = 0; k < 2; ++k) dst[m][k] = *(const PG8_LAS bf16x8*)(lds + PG8_SA(b, h) + aoff + m * 2048 + k * 1024); } while (0)
#define PG8_LDB(dst, b, h) do { _Pragma("unroll") for (int n = 0; n < 2; ++n) _Pragma("unroll") for (int k = 0; k < 2; ++k) dst[n][k] = *(const PG8_LAS bf16x8*)(lds + PG8_SB(b, h) + boff + n * 2048 + k * 1024); } while (0)
#define PG8_MMA(ai, bj, At, Bt) do { __builtin_amdgcn_s_setprio(1); _Pragma("unroll") for (int m = 0; m < 4; ++m) _Pragma("unroll") for (int n = 0; n < 2; ++n) _Pragma("unroll") for (int k = 0; k < 2; ++k) \
        acc[ai][bj][m][n] = __builtin_amdgcn_mfma_f32_16x16x32_bf16(Bt[n][k], At[m][k], acc[ai][bj][m][n], 0, 0, 0); __builtin_amdgcn_s_setprio(0); } while (0)
#define PG8_WAIT_V(n) asm volatile("s_waitcnt vmcnt(" #n ")" ::: "memory")
#define PG8_WAIT_L(n) asm volatile("s_waitcnt lgkmcnt(" #n ")" ::: "memory")
#define PG8_BAR __builtin_amdgcn_s_barrier()
#define PG8_SCHED __builtin_amdgcn_sched_barrier(0)
    Unit cur, nxt; int ui = 0;
    if (!S.next(0, cur)) return;
    f32x4 acc[2][2][4][2];
#pragma unroll
    for (int a = 0; a < 2; ++a)
#pragma unroll
        for (int b = 0; b < 2; ++b)
#pragma unroll
            for (int m = 0; m < 4; ++m)
#pragma unroll
                for (int n = 0; n < 2; ++n) acc[a][b][m][n] = (f32x4){0.f, 0.f, 0.f, 0.f};
    bf16x8 At[4][2], B0[2][2], B1[2][2];
    const char* cA = (const char*)g.A + (size_t)cur.pm * tstep; const char* cB = (const char*)g.Bt + (size_t)cur.pn * tstep;
    S.a_ready(cur);
    if constexpr (SP2) {
        PG8_STAGE(PG8_SB(0, 0), cB, voffB); PG8_STAGE(PG8_SB(0, 1), cB + hstep, voffB); PG8_STAGE(PG8_SA(0, 0), cA, voffA); PG8_STAGE(PG8_SA(0, 1), cA + hstep, voffA);
        if (wr == 1) PG8_BAR;
        PG8_WAIT_V(2); PG8_BAR;
        PG8_STAGE(PG8_SB(1, 0), cB + kstep, voffB); PG8_STAGE(PG8_SA(1, 0), cA + kstep, voffA); PG8_STAGE(PG8_SB(1, 1), cB + hstep + kstep, voffB);
        PG8_WAIT_V(6); PG8_BAR;
    } else {
        PG8_STAGE(PG8_SB(0, 0), cB, voffB); PG8_STAGE(PG8_SA(0, 0), cA, voffA); PG8_STAGE(PG8_SB(0, 1), cB + hstep, voffB); PG8_STAGE(PG8_SA(0, 1), cA + hstep, voffA);
        if (wr == 1) PG8_BAR;
        PG8_WAIT_V(4); PG8_BAR;
        PG8_STAGE(PG8_SB(1, 0), cB + kstep, voffB); PG8_STAGE(PG8_SA(1, 0), cA + kstep, voffA); PG8_STAGE(PG8_SB(1, 1), cB + hstep + kstep, voffB);
        PG8_WAIT_V(6); PG8_BAR;
    }
    for (;;) {
        const bool has_next = S.next(ui + 1, nxt);
        const char* nA = has_next ? (const char*)g.A + (size_t)nxt.pm * tstep : cA; const char* nB = has_next ? (const char*)g.Bt + (size_t)nxt.pn * tstep : cB;
        for (int t = 0; t < nt; t += 2) {
            const bool last = (t == nt - 2);
            const char* a1 = cA + (size_t)(t + 1) * kstep;
            const char* a2 = last ? nA : cA + (size_t)(t + 2) * kstep; const char* b2 = last ? nB : cB + (size_t)(t + 2) * kstep;
            const char* a3 = a2 + kstep; const char* b3 = b2 + kstep;
            if (last && has_next) S.a_ready(nxt);
            if constexpr (SP2) {
            PG8_LDB(B0, 0, 0); PG8_LDB(B1, 0, 1); PG8_SCHED; PG8_LDA(At, 0, 0); PG8_STAGE(PG8_SA(1, 1), a1 + hstep, voffA);
            PG8_WAIT_V(8); PG8_WAIT_L(0); PG8_BAR; PG8_MMA(0, 0, At, B0); PG8_MMA(0, 1, At, B1); PG8_BAR; PG8_SCHED;
            PG8_LDA(At, 0, 1); PG8_STAGE(PG8_SB(0, 0), b2, voffB); PG8_STAGE(PG8_SB(0, 1), b2 + hstep, voffB); PG8_STAGE(PG8_SA(0, 0), a2, voffA);
            PG8_WAIT_V(8); PG8_WAIT_L(0); PG8_BAR; PG8_MMA(1, 0, At, B0); PG8_MMA(1, 1, At, B1); PG8_BAR; PG8_SCHED;
            PG8_LDB(B0, 1, 0); PG8_LDB(B1, 1, 1); PG8_SCHED; PG8_LDA(At, 1, 0); PG8_STAGE(PG8_SA(0, 1), a2 + hstep, voffA);
            PG8_WAIT_V(8); PG8_WAIT_L(0); PG8_BAR; PG8_MMA(0, 0, At, B0); PG8_MMA(0, 1, At, B1); PG8_BAR; PG8_SCHED;
            PG8_LDA(At, 1, 1); PG8_STAGE(PG8_SB(1, 0), b3, voffB); PG8_STAGE(PG8_SB(1, 1), b3 + hstep, voffB); PG8_STAGE(PG8_SA(1, 0), a3, voffA);
            PG8_WAIT_V(8); PG8_WAIT_L(0); PG8_BAR; PG8_MMA(1, 0, At, B0); PG8_MMA(1, 1, At, B1); PG8_BAR; PG8_SCHED;
            } else {
            PG8_LDB(B0, 0, 0); PG8_SCHED; PG8_LDA(At, 0, 0); PG8_STAGE(PG8_SA(1, 1), a1 + hstep, voffA);
            PG8_WAIT_L(8); PG8_BAR; PG8_WAIT_L(0); PG8_MMA(0, 0, At, B0); PG8_BAR; PG8_SCHED;
            PG8_LDB(B1, 0, 1); PG8_STAGE(PG8_SB(0, 0), b2, voffB);
            PG8_BAR; PG8_WAIT_L(0); PG8_MMA(0, 1, At, B1); PG8_BAR;
            PG8_LDA(At, 0, 1); PG8_STAGE(PG8_SA(0, 0), a2, voffA);
            PG8_BAR; PG8_WAIT_L(0); PG8_MMA(1, 0, At, B0); PG8_BAR; PG8_SCHED;
            PG8_STAGE(PG8_SB(0, 1), b2 + hstep, voffB);
            PG8_WAIT_V(6); PG8_BAR; PG8_MMA(1, 1, At, B1); PG8_BAR;
            PG8_LDB(B0, 1, 0); PG8_SCHED; PG8_LDA(At, 1, 0); PG8_STAGE(PG8_SA(0, 1), a2 + hstep, voffA);
            PG8_WAIT_L(8); PG8_BAR; PG8_WAIT_L(0); PG8_MMA(0, 0, At, B0); PG8_BAR; PG8_SCHED;
            PG8_LDB(B1, 1, 1); PG8_STAGE(PG8_SB(1, 0), b3, voffB);
            PG8_BAR; PG8_WAIT_L(0); PG8_MMA(0, 1, At, B1); PG8_BAR;
            PG8_LDA(At, 1, 1); PG8_STAGE(PG8_SA(1, 0), a3, voffA);
            PG8_BAR; PG8_WAIT_L(0); PG8_MMA(1, 0, At, B0); PG8_BAR; PG8_SCHED;
            PG8_STAGE(PG8_SB(1, 1), b3 + hstep, voffB);
            PG8_WAIT_V(6); PG8_BAR; PG8_MMA(1, 1, At, B1); PG8_BAR;
            }
        }
        if constexpr (ALIGN_EPI) { if (wr == 0) PG8_BAR; }
        if constexpr (!Epi::AFTER_DRAIN) { E(acc, cur, wr, wc, fr, fq); asm volatile("s_waitcnt vmcnt(0)" ::: "memory"); S.done(cur); }
        if (!has_next) break;
#pragma unroll
        for (int a = 0; a < 2; ++a)
#pragma unroll
            for (int b = 0; b < 2; ++b)
#pragma unroll
                for (int m = 0; m < 4; ++m)
#pragma unroll
                    for (int n = 0; n < 2; ++n) acc[a][b][m][n] = (f32x4){0.f, 0.f, 0.f, 0.f};
        cur = nxt; cA = nA; cB = nB; ++ui;
        if constexpr (ALIGN_EPI) { if (wr == 1) PG8_BAR; }
    }
    PG8_WAIT_V(0);
    if constexpr (!ALIGN_EPI) { if (wr == 0) PG8_BAR; }
    PG8_BAR;
    if constexpr (Epi::AFTER_DRAIN) { E.fused(acc, cur, wr, wc, fr, fq, lds, wid, lane); S.done(cur); }
#undef PG8_SA
#undef PG8_SB
#undef PG8_STAGE
#undef PG8_LDA
#undef PG8_LDB
#undef PG8_MMA
#undef PG8_WAIT_V
#undef PG8_WAIT_L
#undef PG8_BAR
#undef PG8_SCHED
}
}


#ifndef MK_MULTI
#define MK_MULTI 0
#endif
#define DI __device__ __forceinline__
#define LAS __attribute__((address_space(3)))
typedef unsigned short bf16;
typedef short bf16x8 __attribute__((ext_vector_type(8)));
typedef float f32x4 __attribute__((ext_vector_type(4)));
typedef float f32x16 __attribute__((ext_vector_type(16)));
typedef unsigned u32x4 __attribute__((ext_vector_type(4)));
typedef unsigned u32x2 __attribute__((ext_vector_type(2)));
typedef float f32x2_t __attribute__((ext_vector_type(2)));
typedef __bf16 bf16x2_t __attribute__((ext_vector_type(2)));
typedef LAS unsigned char* lptr;


constexpr int SEQ = 2048, DM = 1024, TH = 16384  , DFF = 4096, DIN = 9632;
constexpr float EPS = 1e-6f, LOG2E = 1.4426950408889634f;
constexpr float QSC_DIFF = 0.125f * LOG2E;
constexpr float QSC_MLA = 0.10206207261596575f * LOG2E;
constexpr float KSC_RET = 0.08838834764831845f;
constexpr int NTHR = 512;
constexpr int LDS_BYTES = 147456;

constexpr size_t MiB = 1u << 20;
constexpr size_t WS_CNT = 0, WS_LAM = 256, WS_BIAS = 1024, WS_GAIN = 65536;
constexpr size_t WS_SUBG = WS_GAIN + 4 * 2 * 1024 * 4;
constexpr size_t WS_RCOS = 1 * MiB, WS_RSIN = WS_RCOS + 512 * 1024, WS_MCOS = 2 * MiB, WS_MSIN = WS_MCOS + 128 * 1024;
constexpr size_t WS_W = 4 * MiB;
constexpr size_t WO_IN1 = 0, WO_V = WO_IN1 + 4608 * 1024, WO_G = WO_V + 2048 * 1024, WO_RO = WO_G + 3072 * 1024, WO_DO = WO_RO + 1024 * 1024, WO_MO = WO_DO + 1024 * 1024, WO_OUT = WO_MO + 1024 * 1024,
                 WO_UP = WO_OUT + 1024 * 1024, WO_DOWN = WO_UP + 4096 * 1024, WO_UQ = WO_DOWN + 4096 * 1024, WO_UK = WO_UQ + 1536 * 256, WO_UV = WO_UK + 1024 * 256,
                 WO_END = 90 * 262144;
static_assert(WO_UV + 1024 * 256 <= WO_END && WO_G % 262144 == 0 && WO_RO % 262144 == 0, "weight map");
static_assert(WS_W + 2 * WO_END * 2 <= 96 * MiB, "weights fit");
constexpr size_t WS_H = 96 * MiB;
constexpr size_t WS_RQ = 128 * MiB, WS_RK = 144 * MiB, WS_RVT = 160 * MiB, WS_RG = 192 * MiB, WS_G = 128 * MiB;
constexpr size_t WS_DQ = 224 * MiB, WS_DK = 256 * MiB, WS_DVT = 288 * MiB, WS_M32 = 256 * MiB;
constexpr size_t WS_CQ = 320 * MiB, WS_CKV = 328 * MiB  , WS_KPE = 336 * MiB, WS_SSQ_CQ = 337 * MiB, WS_SSQ_CKV = WS_SSQ_CQ + 256 * 1024;
constexpr size_t WS_QMN = 338 * MiB, WS_QMP = 370 * MiB, WS_KMN = 386 * MiB, WS_VMT = 418 * MiB, WS_RO = 450 * MiB;
constexpr size_t WS_MG = 370 * MiB, WS_Y = 402 * MiB, WS_SSQ_Y = 434 * MiB, WS_U = 128 * MiB, WS_END = 482 * MiB;

struct Params {
    const float *x, *rel_bias, *pre_mix_g, *w_in, *w_ret_o, *lq1, *lk1, *lq2, *lk2, *subln_g, *w_diff_o, *q_norm_g, *w_uq, *kv_norm_g, *w_ukv, *w_mla_o,
                *w_out, *post_mix_g, *pre_mlp_g, *w_up, *w_down, *post_mlp_g;
    float* out; unsigned char* ws; int ph_lo, ph_hi;
};

DI unsigned cvtpk(float lo, float hi) { f32x2_t v = {lo, hi}; bf16x2_t b = __builtin_convertvector(v, bf16x2_t); return __builtin_bit_cast(unsigned, b); }
DI u32x4 pack8(f32x4 a, f32x4 b) { u32x4 w; w.x = cvtpk(a[0], a[1]); w.y = cvtpk(a[2], a[3]); w.z = cvtpk(b[0], b[1]); w.w = cvtpk(b[2], b[3]); return w; }
DI float bflo(unsigned u) { return __uint_as_float(u << 16); }
DI float bfhi(unsigned u) { return __uint_as_float(u & 0xffff0000u); }
DI void unpack8(u32x4 w, f32x4& a, f32x4& b) { a = (f32x4){bflo(w.x), bfhi(w.x), bflo(w.y), bfhi(w.y)}; b = (f32x4){bflo(w.z), bfhi(w.z), bflo(w.w), bfhi(w.w)}; }
DI float ex2(float x) { return __builtin_amdgcn_exp2f(x); }
DI float sigm(float x) { return __builtin_amdgcn_rcpf(1.f + ex2(-x * LOG2E)); }
DI float shx(float v, int m, int lane) { return __int_as_float(__builtin_amdgcn_ds_bpermute((lane ^ m) << 2, __float_as_int(v))); }
DI float wave_sum(float v, int lane) {
#pragma unroll
    for (int o = 1; o < 64; o <<= 1) v += shx(v, o, lane);
    return v;
}
DI float sq4(f32x4 v) { return (v[0] * v[0] + v[1] * v[1]) + (v[2] * v[2] + v[3] * v[3]); }

DI int colmap(int map, int n, int off) {
    switch (map) {
        case 0: return off + n;
        case 1: { const int p = n & 127, bj = (n >> 7) & 1; return off + (n & ~255) + (p >> 6) * 128 + bj * 64 + (p & 63); }
        case 2: { if (n < 128) return 6400 + n; if (n >= 160) return -1; const int q = n - 128; return 6528 + 16 * ((q >> 2) & 1) + 4 * (q >> 3) + (q & 3); }
        case 3: { if (n < 1024) return (n >> 6) * 96 + (n & 63); const int q = n - 1024, hh = q >> 5, pos = q & 31; return hh * 96 + 64 + 16 * ((pos >> 2) & 1) + 4 * (pos >> 3) + (pos & 3); }
        case 4: return (n >> 6) * 128 + (n & 63);
        default: return (n >> 6) * 128 + 64 + (n & 63);
    }
}
DI void conv_item(const float* W, int ldw, int K, int kvalid, bf16* WT, int map, int off, const float* gs, LAS float* scr, int item, int nblk, int lane) {
    const int kb = item / nblk, nb = item % nblk, k0 = 64 * kb, n0 = 32 * nb;
    const int oc = colmap(map, n0 + (lane & 31), off);
#pragma unroll 8
    for (int i = 0; i < 32; ++i) { const int kk = 2 * i + (lane >> 5); float v = 0.f; if (oc >= 0 && k0 + kk < kvalid) { v = W[(size_t)(k0 + kk) * ldw + oc]; if (gs) v *= gs[k0 + kk]; } scr[kk * 33 + (lane & 31)] = v; }
    asm volatile("s_waitcnt lgkmcnt(0)" ::: "memory");
    const int c = lane & 7;
#pragma unroll
    for (int j = 0; j < 4; ++j) { const int n = (lane >> 3) + 8 * j; const LAS float* s = scr + (8 * c) * 33 + n;
        u32x4 o; o.x = cvtpk(s[0 * 33], s[1 * 33]); o.y = cvtpk(s[2 * 33], s[3 * 33]); o.z = cvtpk(s[4 * 33], s[5 * 33]); o.w = cvtpk(s[6 * 33], s[7 * 33]);
        *(u32x4*)(WT + (size_t)(n0 + n) * K + k0 + 8 * c) = o; }
    asm volatile("s_waitcnt lgkmcnt(0)" ::: "memory");
}
DI int t5_bucket(int n) {
    if (n < 16) return n;
    int large = 16 + (int)(logf((float)n / 16.f) / 2.0794415416798357f * 16.f);
    return large < 31 ? large : 31;
}
DI void prologue(const Params& p, lptr lds, int wv) {
    const int tid = tidx(wv), lane = tid & 63, wave = tid >> 6;
    const int gw = blockIdx.x * 8 + wave, NGW = gridDim.x * 8, gt = blockIdx.x * NTHR + tid, NGT = gridDim.x * NTHR;
    unsigned char* ws = p.ws;
    if (blockIdx.x == 0) {
        if (tid < 64) ((unsigned*)(ws + WS_CNT))[tid] = 0u;
        if (tid >= 64 && tid < 66) {
            const int l = tid - 64; float a = 0.f, b = 0.f;
            for (int i = 0; i < 64; ++i) { a += p.lq1[l * 64 + i] * p.lk1[l * 64 + i]; b += p.lq2[l * 64 + i] * p.lk2[l * 64 + i]; }
            const float linit = 0.8f - 0.6f * expf(-0.3f * (float)l);
            ((float*)(ws + WS_LAM))[l] = expf(a) - expf(b) + linit; ((float*)(ws + WS_LAM))[2 + l] = 1.f - linit;
        }
    }
    for (int i = gt; i < 2048; i += NGT) { float* gd = (float*)(ws + WS_GAIN); gd[i] = p.pre_mix_g[i]; gd[2048 + i] = p.post_mix_g[i]; gd[4096 + i] = p.pre_mlp_g[i]; gd[6144 + i] = p.post_mlp_g[i]; if (i < 256) ((float*)(ws + WS_SUBG))[i] = p.subln_g[i]; }
    for (int i = gt; i < 8 * 128; i += NGT) { const int hh = i >> 7, n = i & 127; ((float*)(ws + WS_BIAS))[i] = p.rel_bias[t5_bucket(n) * 8 + hh] * LOG2E; }
    for (int i = gt; i < SEQ * 64; i += NGT) { const int s = i >> 6, d = i & 63; const float inv = (float)(1.0 / pow(10000.0, (double)d / 63.0)); const float ang = (float)s * inv;
        ((float*)(ws + WS_RCOS))[i] = (float)cos((double)ang); ((float*)(ws + WS_RSIN))[i] = (float)sin((double)ang); }
    for (int i = gt; i < SEQ * 16; i += NGT) { const int s = i >> 4, d = i & 15; const float inv = (float)(1.0 / pow(10000.0, (double)(2 * d) / 32.0)); const float ang = (float)s * inv;
        ((float*)(ws + WS_MCOS))[i] = (float)cos((double)ang); ((float*)(ws + WS_MSIN))[i] = (float)sin((double)ang); }
    LAS float* scr = (LAS float*)(lds + wave * 16384);
    constexpr int NJ = 19, ITEMS_L = 11456;
    for (int itg = gw; itg < 2 * ITEMS_L; itg += NGW) {
        const int l = itg / ITEMS_L; int it = itg - l * ITEMS_L;
        bf16* Wb = (bf16*)(ws + WS_W) + (size_t)l * WO_END;
        const float* win = p.w_in + (size_t)l * DM * DIN;
        int job = 0;
        {   const int cnt[NJ] = {256, 256, 512, 512, 512, 128, 128, 512, 512, 1536, 192, 128, 128, 512, 512, 512, 512, 2048, 2048};
#pragma unroll
            for (int j = 0; j < NJ - 1; ++j) { if (job == j && it >= cnt[j]) { it -= cnt[j]; job = j + 1; } } }
        const float* src = win; int ldw = DIN, K = 1024, kvalid = 4096, ns = 1024, map = 0, off = 0; const float* gs = nullptr; bf16* dst = Wb;
        switch (job) {
            case 0: ns = 512; map = 1; off = 0; dst = Wb + WO_IN1; break;
            case 1: ns = 512; map = 1; off = 512; dst = Wb + WO_IN1 + (size_t)512 * 1024; break;
            case 2: off = 2048; dst = Wb + WO_IN1 + (size_t)1024 * 1024; break;
            case 3: off = 3072; dst = Wb + WO_IN1 + (size_t)2048 * 1024; break;
            case 4: off = 4096; dst = Wb + WO_IN1 + (size_t)3072 * 1024; break;
            case 5: ns = 256; off = 6144; dst = Wb + WO_IN1 + (size_t)4096 * 1024; break;
            case 6: ns = 256; map = 2; dst = Wb + WO_IN1 + (size_t)4352 * 1024; break;
            case 7: off = 1024; dst = Wb + WO_V; break;
            case 8: off = 5120; dst = Wb + WO_V + (size_t)1024 * 1024; break;
            case 9: ns = 3072; off = 6560; dst = Wb + WO_G; break;
            case 10: src = p.w_uq + (size_t)l * 256 * 1536; ldw = 1536; K = 256; ns = 1536; map = 3; gs = p.q_norm_g + l * 256; dst = Wb + WO_UQ; break;
            case 11: src = p.w_ukv + (size_t)l * 128 * 2048; ldw = 2048; K = 256; kvalid = 128; map = 4; gs = p.kv_norm_g + l * 128; dst = Wb + WO_UK; break;
            case 12: src = p.w_ukv + (size_t)l * 128 * 2048; ldw = 2048; K = 256; kvalid = 128; map = 5; gs = p.kv_norm_g + l * 128; dst = Wb + WO_UV; break;
            case 13: src = p.w_ret_o + (size_t)l * 1024 * 1024; ldw = 1024; dst = Wb + WO_RO; break;
            case 14: src = p.w_diff_o + (size_t)l * 1024 * 1024; ldw = 1024; dst = Wb + WO_DO; break;
            case 15: src = p.w_mla_o + (size_t)l * 1024 * 1024; ldw = 1024; dst = Wb + WO_MO; break;
            case 16: src = p.w_out + (size_t)l * 1024 * 1024; ldw = 1024; dst = Wb + WO_OUT; break;
            case 17: src = p.w_up + (size_t)l * 1024 * 4096; ldw = 4096; ns = 4096; dst = Wb + WO_UP; break;
            default: src = p.w_down + (size_t)l * 4096 * 1024; ldw = 1024; K = 4096; dst = Wb + WO_DOWN; break;
        }
        conv_item(src, ldw, K, kvalid, dst, map, off, gs, scr, it, ns / 32, lane);
    }
}

DI void norm_rows(const float* x, const float* g, bf16* o, int rows, int wv) {
    const int tid_ = tidx(wv); const int lane = tid_ & 63, gw = blockIdx.x * 8 + (tid_ >> 6), NGW = gridDim.x * 8;
    for (int m = gw; m < rows; m += NGW) {
        const f32x4* xr = (const f32x4*)(x + (size_t)m * DM) + lane; f32x4 v[4]; float s = 0.f;
#pragma unroll
        for (int j = 0; j < 4; ++j) { v[j] = xr[64 * j]; s += sq4(v[j]); }
        const float rs = 1.0f / sqrtf(wave_sum(s, lane) * (1.f / DM) + EPS);
        u32x2* o8 = (u32x2*)(o + (size_t)m * DM) + lane;
#pragma unroll
        for (int j = 0; j < 4; ++j) { const f32x4 gg = ((const f32x4*)g)[lane + 64 * j]; u32x2 w; w.x = cvtpk(v[j][0] * rs * gg[0], v[j][1] * rs * gg[1]); w.y = cvtpk(v[j][2] * rs * gg[2], v[j][3] * rs * gg[3]); o8[64 * j] = w; }
    }
}
DI void resid_rows(const float* xin, const bf16* y, const float* ssq, const float* gpost, float* xout, const float* gnext, bf16* hout, int rows, int wv, bool ablate = false) {
    const int tid_ = tidx(wv); const int lane = tid_ & 63, gw = blockIdx.x * 8 + (tid_ >> 6), NGW = gridDim.x * 8;
    for (int m = gw; m < rows; m += NGW) {
        const float part = lane < 16 ? ssq[(size_t)m * 16 + lane] : 0.f;
        float rs = 1.0f / sqrtf(wave_sum(part, lane) * (1.f / DM) + EPS);
#ifdef ABL_MLP
        if (!gnext || gnext == (const float*)0 + 1) rs = rs; if (ablate) rs = 0.f;
#endif
        const f32x4* xr = (const f32x4*)(xin + (size_t)m * DM) + lane; const u32x2* yr = (const u32x2*)(y + (size_t)m * DM) + lane; f32x4* xo = (f32x4*)(xout + (size_t)m * DM) + lane;
        f32x4 v[4]; float s = 0.f;
#pragma unroll
        for (int j = 0; j < 4; ++j) { const f32x4 xv = xr[64 * j]; const u32x2 yw = yr[64 * j]; const f32x4 gg = ((const f32x4*)gpost)[lane + 64 * j];
            f32x4 yv = (f32x4){bflo(yw.x), bfhi(yw.x), bflo(yw.y), bfhi(yw.y)};
            v[j] = xv + yv * rs * gg; xo[64 * j] = v[j]; s += sq4(v[j]); }
        if (gnext) {
            const float rs2 = 1.0f / sqrtf(wave_sum(s, lane) * (1.f / DM) + EPS);
            u32x2* o8 = (u32x2*)(hout + (size_t)m * DM) + lane;
#pragma unroll
            for (int j = 0; j < 4; ++j) { const f32x4 gg = ((const f32x4*)gnext)[lane + 64 * j]; u32x2 w; w.x = cvtpk(v[j][0] * rs2 * gg[0], v[j][1] * rs2 * gg[1]); w.y = cvtpk(v[j][2] * rs2 * gg[2], v[j][3] * rs2 * gg[3]); o8[64 * j] = w; }
        }
    }
}

#define EPI_ARGS const f32x4 (&acc)[2][2][4][2], const pg8::Unit& u, int wr, int wc, int fr, int fq
#define FOR_AI_M _Pragma("unroll") for (int ai = 0; ai < 2; ++ai) _Pragma("unroll") for (int m = 0; m < 4; ++m)
#define FOR_BJ _Pragma("unroll") for (int bj = 0; bj < 2; ++bj)

struct EpiIn1 {
    static constexpr bool PERM = true, AFTER_DRAIN = false;
    unsigned char* ws;
    DI void operator()(EPI_ARGS) const {
        asm volatile("" : "+v"(fr), "+v"(fq));
        bf16 *RQ = (bf16*)(ws + WS_RQ), *RK = (bf16*)(ws + WS_RK), *RG = (bf16*)(ws + WS_RG), *DQ = (bf16*)(ws + WS_DQ), *DK = (bf16*)(ws + WS_DK), *CQ = (bf16*)(ws + WS_CQ), *CKV = (bf16*)(ws + WS_CKV), *KPE = (bf16*)(ws + WS_KPE);
        float *SSQ_CQ = (float*)(ws + WS_SSQ_CQ), *SSQ_CKV = (float*)(ws + WS_SSQ_CKV);
        const float *rcos = (const float*)(ws + WS_RCOS), *rsin = (const float*)(ws + WS_RSIN), *mcos = (const float*)(ws + WS_MCOS), *msin = (const float*)(ws + WS_MSIN);
        const int pn = u.pn, row0 = u.pm * 256 + wr * 64 + fr, c8 = wc * 32 + 8 * fq;
        if (pn < 4) {
            bf16* dst = pn < 2 ? RQ : RK; const int head = 2 * (pn & 1) + (wc >> 1), d0 = c8 & 63;
            const float l2g = log2f(1.f - ex2(-5.f - (float)head)), l2s = pn < 2 ? l2g : -l2g, sc0 = pn < 2 ? 1.f : KSC_RET;
            FOR_AI_M { const int t = row0 + ai * 128 + m * 16, s = t & (SEQ - 1); const float sc = sc0 * ex2(l2s * (float)(s & 63));
                const f32x4 c0 = *(const f32x4*)(rcos + s * 64 + d0), c1 = *(const f32x4*)(rcos + s * 64 + d0 + 4), s0 = *(const f32x4*)(rsin + s * 64 + d0), s1 = *(const f32x4*)(rsin + s * 64 + d0 + 4);
                const f32x4 x1a = acc[ai][0][m][0], x1b = acc[ai][0][m][1], x2a = acc[ai][1][m][0], x2b = acc[ai][1][m][1];
                bf16* o = dst + (size_t)t * 512 + head * 128 + d0;
                *(u32x4*)o = pack8((x1a * c0 - x2a * s0) * sc, (x1b * c1 - x2b * s1) * sc);
                *(u32x4*)(o + 64) = pack8((x2a * c0 + x1a * s0) * sc, (x2b * c1 + x1b * s1) * sc); asm volatile("" ::: "memory"); }
        } else if (pn < 16) {
            const int seg = (pn - 4) >> 2; bf16* dst = seg == 0 ? RG : (seg == 1 ? DQ : DK); const int colb = ((pn - 4) & 3) * 256 + c8;
            FOR_AI_M { const int t = row0 + ai * 128 + m * 16;
                FOR_BJ { f32x4 v0 = acc[ai][bj][m][0], v1 = acc[ai][bj][m][1];
                    if (seg == 0) {
#pragma unroll
                        for (int i = 0; i < 4; ++i) { v0[i] = v0[i] * sigm(v0[i]); v1[i] = v1[i] * sigm(v1[i]); } }
                    else if (seg == 1) { v0 = v0 * QSC_DIFF; v1 = v1 * QSC_DIFF; }
                    *(u32x4*)(dst + (size_t)t * 1024 + colb + bj * 128) = pack8(v0, v1); } }
        } else if (pn == 16) {
            FOR_AI_M { const int t = row0 + ai * 128 + m * 16; float ss = 0.f;
                FOR_BJ { const f32x4 v0 = acc[ai][bj][m][0], v1 = acc[ai][bj][m][1]; ss += sq4(v0) + sq4(v1); *(u32x4*)(CQ + (size_t)t * 256 + c8 + bj * 128) = pack8(v0, v1); }
                ss += shx(ss, 16, fq * 16 + fr); ss += shx(ss, 32, fq * 16 + fr);
                if (fq == 0) SSQ_CQ[(size_t)t * 4 + wc] = ss; }
        } else {
            FOR_AI_M { const int t = row0 + ai * 128 + m * 16, s = t & (SEQ - 1);
                const f32x4 v0 = acc[ai][0][m][0], v1 = acc[ai][0][m][1]; float ss = sq4(v0) + sq4(v1);
                *(u32x4*)(CKV + (size_t)t * 256 + c8) = pack8(v0, v1); *(u32x4*)(CKV + (size_t)t * 256 + 128 + c8) = pack8(acc[ai][1][m][0], acc[ai][1][m][1]);
                ss += shx(ss, 16, fq * 16 + fr); ss += shx(ss, 32, fq * 16 + fr);
                if (fq == 0) SSQ_CKV[(size_t)t * 4 + wc] = ss;
                if (wc == 0) { const f32x4 x1 = acc[ai][1][m][0], x2 = acc[ai][1][m][1]; const f32x4 c = *(const f32x4*)(mcos + s * 16 + 4 * fq), sn = *(const f32x4*)(msin + s * 16 + 4 * fq);
                    const f32x4 o1 = x1 * c - x2 * sn, o2 = x2 * c + x1 * sn; u32x2 w1, w2; w1.x = cvtpk(o1[0], o1[1]); w1.y = cvtpk(o1[2], o1[3]); w2.x = cvtpk(o2[0], o2[1]); w2.y = cvtpk(o2[2], o2[3]);
                    *(u32x2*)(KPE + (size_t)t * 32 + 4 * fq) = w1; *(u32x2*)(KPE + (size_t)t * 32 + 16 + 4 * fq) = w2; } }
        }
    }
};
struct EpiVt {
    static constexpr bool PERM = true, AFTER_DRAIN = false;
    bf16 *T0, *T1; const float* ssq; float inv_n;
    DI void operator()(EPI_ARGS) const {
        asm volatile("" : "+v"(fr), "+v"(fq));
        const int b = u.pn >> 3, s0 = (u.pn & 7) * 256 + wc * 32 + 8 * fq;
        float rs[2][8];
        FOR_BJ {
#pragma unroll
            for (int k = 0; k < 8; ++k) { rs[bj][k] = 1.f; if (ssq) { const f32x4 q = *(const f32x4*)(ssq + (size_t)(b * SEQ + s0 + bj * 128 + k) * 4); rs[bj][k] = 1.0f / sqrtf(((q[0] + q[1]) + (q[2] + q[3])) * inv_n + EPS); } } }
        FOR_AI_M { const int R = u.pm * 256 + ai * 128 + wr * 64 + m * 16 + fr;
            bf16* rowp = (R < 1024 ? T0 + (size_t)(b * 1024 + R) * SEQ : T1 + (size_t)(b * 1024 + R - 1024) * SEQ) + s0;
            FOR_BJ { f32x4 v0 = acc[ai][bj][m][0], v1 = acc[ai][bj][m][1];
#pragma unroll
                for (int i = 0; i < 4; ++i) { v0[i] *= rs[bj][i]; v1[i] *= rs[bj][4 + i]; }
                *(u32x4*)(rowp + bj * 128) = pack8(v0, v1); } }
    }
};
struct EpiUq {
    static constexpr bool PERM = true, AFTER_DRAIN = false;
    bf16 *QMn, *QMp; const float *ssq, *mcos, *msin; int wv;
    DI void operator()(EPI_ARGS) const {
        { const int t_ = tidx(wv); fr = t_ & 15; fq = (t_ >> 4) & 3; }
        const int pn = u.pn, row0 = u.pm * 256 + wr * 64 + fr, c8 = wc * 32 + 8 * fq;
        FOR_AI_M { const int t = row0 + ai * 128 + m * 16, s = t & (SEQ - 1);
            const f32x4 q = *(const f32x4*)(ssq + (size_t)t * 4); const float rs = QSC_MLA / sqrtf(((q[0] + q[1]) + (q[2] + q[3])) * (1.f / 256.f) + EPS);
            if (pn < 4) { FOR_BJ { *(u32x4*)(QMn + (size_t)t * 1024 + pn * 256 + bj * 128 + c8) = pack8(acc[ai][bj][m][0] * rs, acc[ai][bj][m][1] * rs); } }
            else { const f32x4 c = *(const f32x4*)(mcos + s * 16 + 4 * fq), sn = *(const f32x4*)(msin + s * 16 + 4 * fq);
                FOR_BJ { const int hh = (pn - 4) * 8 + bj * 4 + wc; const f32x4 x1 = acc[ai][bj][m][0] * rs, x2 = acc[ai][bj][m][1] * rs;
                    const f32x4 o1 = x1 * c - x2 * sn, o2 = x2 * c + x1 * sn; u32x2 w1, w2; w1.x = cvtpk(o1[0], o1[1]); w1.y = cvtpk(o1[2], o1[3]); w2.x = cvtpk(o2[0], o2[1]); w2.y = cvtpk(o2[2], o2[3]);
                    *(u32x2*)(QMp + (size_t)t * 512 + hh * 32 + 4 * fq) = w1; *(u32x2*)(QMp + (size_t)t * 512 + hh * 32 + 16 + 4 * fq) = w2; } }
            asm volatile("" ::: "memory");
        }
    }
};
struct EpiUk {
    static constexpr bool PERM = true, AFTER_DRAIN = false;
    bf16* KMn; const float* ssq;
    DI void operator()(EPI_ARGS) const {
        asm volatile("" : "+v"(fr), "+v"(fq));
        const int row0 = u.pm * 256 + wr * 64 + fr, c8 = wc * 32 + 8 * fq;
        FOR_AI_M { const int t = row0 + ai * 128 + m * 16;
            const f32x4 q = *(const f32x4*)(ssq + (size_t)t * 4); const float rs = 1.0f / sqrtf(((q[0] + q[1]) + (q[2] + q[3])) * (1.f / 128.f) + EPS);
            FOR_BJ { *(u32x4*)(KMn + (size_t)t * 1024 + u.pn * 256 + bj * 128 + c8) = pack8(acc[ai][bj][m][0] * rs, acc[ai][bj][m][1] * rs); } }
    }
};
template <int ACT  > struct EpiAct {
    static constexpr bool PERM = true, AFTER_DRAIN = false;
    bf16* O; int ldc;
    DI void operator()(EPI_ARGS) const {
        asm volatile("" : "+v"(fr), "+v"(fq));
        const int row0 = u.pm * 256 + wr * 64 + fr, c8 = u.pn * 256 + wc * 32 + 8 * fq;
        FOR_AI_M { const int t = row0 + ai * 128 + m * 16;
            FOR_BJ { f32x4 v0 = acc[ai][bj][m][0], v1 = acc[ai][bj][m][1];
#pragma unroll
                for (int i = 0; i < 4; ++i) { if (ACT == 0) { v0[i] = sigm(v0[i]); v1[i] = sigm(v1[i]); } else { const float a = fmaxf(v0[i], 0.f), b = fmaxf(v1[i], 0.f); v0[i] = a * a; v1[i] = b * b; } }
                *(u32x4*)(O + (size_t)t * ldc + c8 + bj * 128) = pack8(v0, v1); } }
    }
};
template <int I> struct EpiBranch {
    static constexpr bool PERM = true, AFTER_DRAIN = false;
    const bf16* G; float* M32; bf16* MG;
    DI void operator()(EPI_ARGS) const {
        asm volatile("" : "+v"(fr), "+v"(fq));
        const int row0 = u.pm * 256 + wr * 64 + fr, c8 = u.pn * 256 + wc * 32 + 8 * fq;
        FOR_AI_M { const int t = row0 + ai * 128 + m * 16;
            FOR_BJ { const size_t idx = (size_t)t * 1024 + c8 + bj * 128; f32x4 g0, g1; unpack8(*(const u32x4*)(G + idx), g0, g1);
                f32x4 v0 = acc[ai][bj][m][0] * g0, v1 = acc[ai][bj][m][1] * g1;
#ifdef ABL_BRANCH
                if (I == ABL_BRANCH) { v0 = v0 * 0.f; v1 = v1 * 0.f; }
#endif
                if (I > 0) { v0 = v0 + *(const f32x4*)(M32 + idx); v1 = v1 + *(const f32x4*)(M32 + idx + 4); }
                if (I < 2) { *(f32x4*)(M32 + idx) = v0; *(f32x4*)(M32 + idx + 4) = v1; } else *(u32x4*)(MG + idx) = pack8(v0, v1); } }
    }
};
struct EpiY {
    static constexpr bool PERM = true, AFTER_DRAIN = false;
    bf16* Y; float* SSQ;
    DI void operator()(EPI_ARGS) const {
        asm volatile("" : "+v"(fr), "+v"(fq));
        const int row0 = u.pm * 256 + wr * 64 + fr, c8 = u.pn * 256 + wc * 32 + 8 * fq;
        FOR_AI_M { const int t = row0 + ai * 128 + m * 16; float ss = 0.f;
            FOR_BJ { const f32x4 v0 = acc[ai][bj][m][0], v1 = acc[ai][bj][m][1]; ss += sq4(v0) + sq4(v1); *(u32x4*)(Y + (size_t)t * 1024 + c8 + bj * 128) = pack8(v0, v1); }
            ss += shx(ss, 16, fq * 16 + fr); ss += shx(ss, 32, fq * 16 + fr);
            if (fq == 0) SSQ[(size_t)t * 16 + u.pn * 4 + wc] = ss; }
    }
};

template <int MODE> struct AC;
template <> struct AC<0> { static constexpr int DQK = 128, KW = 128, DVW = 128, VTR = 256, QR = 128; };
template <> struct AC<1> { static constexpr int DQK = 64, KW = 128, DVW = 128, VTR = 128, QR = 128; };
template <> struct AC<2> { static constexpr int DQK = 96, KW = 96, DVW = 64, VTR = 64, QR = 256; };
constexpr int A_KBUF = 17408, A_VBUF = 36864, A_V0 = 2 * A_KBUF, A_MISC = 2 * A_KBUF + 2 * A_VBUF;
constexpr int A_LUT = A_MISC + 64, A_XCH = A_MISC + 1024;
static_assert(A_XCH + 2048 <= LDS_BYTES, "attention LDS map");
struct AttnP { unsigned char* ws; int l; };
struct AttnPtrs { const bf16 *RQ, *RK, *RVt, *RG; bf16* RO; bf16* DQ; const bf16 *DK, *DVt; bf16* QMn; const bf16 *QMp, *KMn, *KPE, *VMt; const float *biasl, *subg; float lam, oml; };

#pragma float_control(push)
#pragma float_control(precise, off)
template <int MODE> DI void attn_unit(lptr lds, const AttnP PP, const int b, const int hd, const int qb, const int wv) {
    using C = AC<MODE>;
    unsigned char* const ws = PP.ws;
    const AttnPtrs P{(const bf16*)(ws + WS_RQ), (const bf16*)(ws + WS_RK), (const bf16*)(ws + WS_RVT), (const bf16*)(ws + WS_RG), (bf16*)(ws + WS_RO), (bf16*)(ws + WS_DQ),
                     (const bf16*)(ws + WS_DK), (const bf16*)(ws + WS_DVT), (bf16*)(ws + WS_QMN), (const bf16*)(ws + WS_QMP), (const bf16*)(ws + WS_KMN), (const bf16*)(ws + WS_KPE),
                     (const bf16*)(ws + WS_VMT), (const float*)(ws + WS_BIAS), (const float*)(ws + WS_SUBG) + PP.l * 128, 0.f, 0.f};
    constexpr int NKS = C::DQK / 16, NVB = C::DVW / 32, KS = (C::KW + 8) * 2, VS = 144, KCH = C::KW / 8, NKC = 64 * KCH, NVR = C::VTR / 64;
    constexpr int NB = MODE == 0 ? 2 : 3;
    constexpr int VBYTES = C::VTR * VS, VBASE = NB * A_KBUF;
    static_assert(VBASE + NB * VBYTES <= A_MISC, "mixer LDS ring");
    const int tid = tidx(wv), w = __builtin_amdgcn_readfirstlane(tid >> 6), lane = tid & 63, r = lane & 31, h = lane >> 5;
    const int rg = MODE == 2 ? w : (w >> 1), pp = MODE == 2 ? 0 : (w & 1);
    const int q0 = qb * C::QR, q0w = q0 + rg * 32, tok0 = b * SEQ, qq = q0w + r;
    const int ntiles = (q0 + C::QR) / 64;
    const bf16* Kg; const bf16* Vg;
    if (MODE == 0) { Kg = P.RK + (size_t)tok0 * 512 + hd * 128; Vg = P.RVt + (size_t)(b * 4 + hd) * 256 * SEQ; }
    else if (MODE == 1) { Kg = P.DK + (size_t)tok0 * 1024 + hd * 128; Vg = P.DVt + (size_t)(b * 8 + hd) * 128 * SEQ; }
    else { Kg = P.KMn + (size_t)tok0 * 1024 + hd * 64; Vg = P.VMt + (size_t)(b * 16 + hd) * 64 * SEQ; }
    const bf16* Kpe = P.KPE + (size_t)tok0 * 32;
    bf16x8 q[NKS];
    { const size_t t = (size_t)(tok0 + qq);
#pragma unroll
        for (int ks = 0; ks < NKS; ++ks) {
            const bf16* src;
            if (MODE == 0) src = P.RQ + t * 512 + hd * 128 + ks * 16 + 8 * h;
            else if (MODE == 1) src = P.DQ + t * 1024 + hd * 128 + pp * 64 + ks * 16 + 8 * h;
            else src = ks < 4 ? P.QMn + t * 1024 + hd * 64 + ks * 16 + 8 * h : P.QMp + t * 512 + hd * 32 + (ks - 4) * 16 + 8 * h;
            q[ks] = *(const bf16x8*)src; } }
    if (MODE == 1) { if (tid < 128) ((LAS float*)(lds + A_LUT))[tid] = P.biasl[hd * 128 + tid]; }
    u32x4 kreg[2], vreg[NVR];
#define A_GLOAD(kt) do { \
    _Pragma("unroll") for (int i_ = 0; i_ < 2; ++i_) { const int id_ = tid + 512 * i_; if (id_ < NKC) { const int row_ = id_ / KCH, cc_ = id_ % KCH; const size_t kr_ = (size_t)((kt) * 64 + row_); \
        const bf16* s_; if (MODE == 2) s_ = cc_ < 8 ? Kg + kr_ * 1024 + cc_ * 8 : Kpe + kr_ * 32 + (cc_ - 8) * 8; else s_ = Kg + kr_ * (MODE == 0 ? 512 : 1024) + cc_ * 8; kreg[i_] = *(const u32x4*)s_; } } \
    _Pragma("unroll") for (int i_ = 0; i_ < NVR; ++i_) { const int id_ = tid + 512 * i_, row_ = id_ >> 3, cc_ = id_ & 7; vreg[i_] = *(const u32x4*)(Vg + (size_t)row_ * SEQ + (kt) * 64 + cc_ * 8); } } while (0)
#define A_LWRITE(buf) do { \
    _Pragma("unroll") for (int i_ = 0; i_ < 2; ++i_) { const int id_ = tid + 512 * i_; if (id_ < NKC) { const int row_ = id_ / KCH, cc_ = id_ % KCH; *(LAS u32x4*)(lds + (buf) * A_KBUF + row_ * KS + cc_ * 16) = kreg[i_]; } } \
    _Pragma("unroll") for (int i_ = 0; i_ < NVR; ++i_) { const int id_ = tid + 512 * i_, row_ = id_ >> 3, cc_ = id_ & 7; *(LAS u32x4*)(lds + VBASE + (buf) * VBYTES + row_ * VS + cc_ * 16) = vreg[i_]; } } while (0)
    f32x16 O[NVB];
#pragma unroll
    for (int vb = 0; vb < NVB; ++vb)
#pragma unroll
        for (int i = 0; i < 16; ++i) O[vb][i] = 0.f;
    float mrun = -INFINITY, lrun = 0.f;
    const float l2g = MODE == 0 ? log2f(1.f - ex2(-5.f - (float)hd)) : 0.f;
    const float b31 = MODE == 1 ? P.biasl[hd * 128 + 127] : 0.f;
    const int pir = (r & 0x13) | ((r & 8) >> 1) | ((r & 4) << 1);
    const int koffb = ((MODE == 1 ? pp * 64 : 0) + 8 * h) * 2;
    const int vrow0 = (MODE == 0 ? pp * 128 : 0) + r;
#ifdef EXP_NOPV
#define A_PV(VBUF, PF) do { } while (0)
#else
#define A_PV(VBUF, PF) do { const lptr Vb_ = lds + VBASE + (VBUF) * VBYTES + (8 * h) * 2; \
    _Pragma("unroll") for (int vb_ = 0; vb_ < NVB; vb_ += 2) { bf16x8 vf_[2][4]; \
        _Pragma("unroll") for (int u_ = 0; u_ < 2; ++u_) _Pragma("unroll") for (int j_ = 0; j_ < 4; ++j_) vf_[u_][j_] = *(const LAS bf16x8*)(Vb_ + (vrow0 + (vb_ + u_) * 32) * VS + ((j_ >> 1) * 32 + 16 * (j_ & 1)) * 2); \
        __builtin_amdgcn_sched_barrier(0); __builtin_amdgcn_s_setprio(1); \
        _Pragma("unroll") for (int j_ = 0; j_ < 4; ++j_) { O[vb_] = __builtin_amdgcn_mfma_f32_32x32x16_bf16(vf_[0][j_], PF[j_ >> 1][j_ & 1], O[vb_], 0, 0, 0); \
                                                           O[vb_ + 1] = __builtin_amdgcn_mfma_f32_32x32x16_bf16(vf_[1][j_], PF[j_ >> 1][j_ & 1], O[vb_ + 1], 0, 0, 0); } \
        __builtin_amdgcn_s_setprio(0); __builtin_amdgcn_sched_barrier(0); } } while (0)
#endif
    const bool late = MODE != 0 && (w & 1) != 0;
    bool pend = false; int pbuf = 0;
    bf16x8 pf[2][2];
#pragma unroll
    for (int a = 0; a < 2; ++a)
#pragma unroll
        for (int c = 0; c < 2; ++c) pf[a][c] = (bf16x8){0, 0, 0, 0, 0, 0, 0, 0};
    A_GLOAD(0); A_LWRITE(0);
    __syncthreads();
    int cur = 0;
    for (int kt = 0; kt < ntiles; ++kt) {
        const int nxt = cur + 1 == NB ? 0 : cur + 1;
#ifndef EXP_NOLOAD
        if (kt + 1 < ntiles) A_GLOAD(kt + 1);
#endif
        if (MODE != 0) { if (pend) { A_PV(pbuf, pf); pend = false; } }
        if (kt * 64 <= q0w + 31) {
            const lptr Kb = lds + cur * A_KBUF + koffb;
            f32x16 S0, S1;
#pragma unroll
            for (int i = 0; i < 16; ++i) { S0[i] = 0.f; S1[i] = 0.f; }
            {
                constexpr int CH = NKS > 6 ? 4 : NKS;
#pragma unroll
                for (int c0 = 0; c0 < NKS; c0 += CH) {
                    bf16x8 kf0[CH], kf1[CH];
#pragma unroll
                    for (int j = 0; j < CH; ++j) { kf0[j] = *(const LAS bf16x8*)(Kb + pir * KS + (c0 + j) * 32); kf1[j] = *(const LAS bf16x8*)(Kb + (32 + pir) * KS + (c0 + j) * 32); }
                    __builtin_amdgcn_sched_barrier(0);
                    __builtin_amdgcn_s_setprio(1);
#pragma unroll
                    for (int j = 0; j < CH; ++j) {
                        S0 = __builtin_amdgcn_mfma_f32_32x32x16_bf16(kf0[j], q[c0 + j], S0, 0, 0, 0);
                        S1 = __builtin_amdgcn_mfma_f32_32x32x16_bf16(kf1[j], q[c0 + j], S1, 0, 0, 0);
                    }
                    __builtin_amdgcn_s_setprio(0);
                    __builtin_amdgcn_sched_barrier(0);
                }
            }
#ifndef EXP_NOSM
            const int kb0 = kt * 64 + 8 * h;
            const bool diag = (kt * 64 + 63 > q0w);
            if (MODE == 0) {
                const float cs = ex2(l2g * (float)(64 * ((q0w >> 6) - kt)));
                if (diag) {
#pragma unroll
                    for (int i = 0; i < 16; ++i) { const int k0 = kb0 + 16 * (i >> 3) + (i & 7); S0[i] = (k0 <= qq) ? S0[i] * cs : 0.f; S1[i] = (k0 + 32 <= qq) ? S1[i] * cs : 0.f; }
                } else {
#pragma unroll
                    for (int i = 0; i < 16; ++i) { S0[i] *= cs; S1[i] *= cs; }
                }
            } else {
                float boff = 0.f;
                if (MODE == 1) {
                    if (q0w - (kt * 64 + 63) >= 113) boff = b31;
                    else {
                        const LAS float* lut = (const LAS float*)(lds + A_LUT);
#pragma unroll
                        for (int i = 0; i < 16; ++i) { const int k0 = kb0 + 16 * (i >> 3) + (i & 7); int d0 = qq - k0, d1 = d0 - 32;
                            d0 = d0 < 0 ? 0 : (d0 > 127 ? 127 : d0); d1 = d1 < 0 ? 0 : (d1 > 127 ? 127 : d1); S0[i] += lut[d0]; S1[i] += lut[d1]; }
                    }
                }
                if (diag) {
#pragma unroll
                    for (int i = 0; i < 16; ++i) { const int k0 = kb0 + 16 * (i >> 3) + (i & 7); if (k0 > qq) S0[i] = -INFINITY; if (k0 + 32 > qq) S1[i] = -INFINITY; }
                }
                float mx = fmaxf(S0[0], S1[0]);
#pragma unroll
                for (int i = 1; i < 16; ++i) mx = fmaxf(mx, fmaxf(S0[i], S1[i]));
                mx = fmaxf(mx, shx(mx, 32, lane)) + boff;
                if (__builtin_amdgcn_ballot_w64(mx - mrun > 8.f) != 0ull) {
                    const float mn = fmaxf(mrun, mx), al = ex2(mrun - mn); mrun = mn; lrun *= al;
#pragma unroll
                    for (int vb = 0; vb < NVB; ++vb)
#pragma unroll
                        for (int i = 0; i < 16; ++i) O[vb][i] *= al;
                }
                const float nmo = boff - mrun;
                const f32x2_t nm2 = {nmo, nmo}; f32x2_t ps2 = {0.f, 0.f};
#pragma unroll
                for (int i = 0; i < 8; ++i) {
                    f32x2_t a = (f32x2_t){S0[2 * i], S0[2 * i + 1]} + nm2, c = (f32x2_t){S1[2 * i], S1[2 * i + 1]} + nm2;
                    a.x = ex2(a.x); a.y = ex2(a.y); c.x = ex2(c.x); c.y = ex2(c.y); ps2 += a; ps2 += c;
                    S0[2 * i] = a.x; S0[2 * i + 1] = a.y; S1[2 * i] = c.x; S1[2 * i + 1] = c.y; }
                lrun += ps2.x + ps2.y;
            }
#endif
#pragma unroll
            for (int s = 0; s < 2; ++s) {
                u32x4 t0, t1;
                t0.x = cvtpk(S0[8 * s + 0], S0[8 * s + 1]); t0.y = cvtpk(S0[8 * s + 2], S0[8 * s + 3]); t0.z = cvtpk(S0[8 * s + 4], S0[8 * s + 5]); t0.w = cvtpk(S0[8 * s + 6], S0[8 * s + 7]);
                t1.x = cvtpk(S1[8 * s + 0], S1[8 * s + 1]); t1.y = cvtpk(S1[8 * s + 2], S1[8 * s + 3]); t1.z = cvtpk(S1[8 * s + 4], S1[8 * s + 5]); t1.w = cvtpk(S1[8 * s + 6], S1[8 * s + 7]);
                pf[0][s] = __builtin_bit_cast(bf16x8, t0); pf[1][s] = __builtin_bit_cast(bf16x8, t1);
            }
            if (late) { pend = true; pbuf = cur; } else { A_PV(cur, pf); }
        }
#ifndef EXP_NOLOAD
        if (kt + 1 < ntiles) A_LWRITE(nxt);
#endif
#ifndef EXP_NOBAR
        __syncthreads();
#endif
        cur = nxt;
    }
    if (MODE != 0) { if (pend) { A_PV(pbuf, pf); pend = false; } if (MODE == 1) __syncthreads(); }
#undef A_PV
#undef A_GLOAD
#undef A_LWRITE
#if defined(EXP_NOSM) || defined(EXP_NOLOAD) || defined(EXP_NOBAR) || defined(EXP_NOQK) || defined(EXP_NOPV)
    {
        float chk = lrun;
#pragma unroll
        for (int vb = 0; vb < NVB; ++vb)
#pragma unroll
            for (int i = 0; i < 16; ++i) { chk += O[vb][i]; O[vb][i] = 0.f; }
        if (chk == 1234567.875f) atomicAdd((unsigned*)(ws + 524288), 1u);
        lrun = 1.f; }
#endif
    const size_t trow = (size_t)(tok0 + qq);
    if (MODE == 0) {
        float ss = 0.f;
#pragma unroll
        for (int vb = 0; vb < NVB; ++vb)
#pragma unroll
            for (int i = 0; i < 16; ++i) ss += O[vb][i] * O[vb][i];
        ss += shx(ss, 32, lane);
        LAS float* xch = (LAS float*)(lds + A_XCH);
        if (h == 0) xch[w * 32 + r] = ss;
        __syncthreads();
        const float tot = ss + xch[(w ^ 1) * 32 + r];
        const float rs = 1.0f / sqrtf(tot * (1.f / 256.f) + EPS);
#pragma unroll
        for (int vb = 0; vb < NVB; ++vb)
#pragma unroll
            for (int g = 0; g < 4; ++g) { const size_t idx = trow * 1024 + hd * 256 + pp * 128 + vb * 32 + 8 * g + 4 * h; const u32x2 gw = *(const u32x2*)(P.RG + idx);
                u32x2 o; o.x = cvtpk(O[vb][4 * g] * rs * bflo(gw.x), O[vb][4 * g + 1] * rs * bfhi(gw.x)); o.y = cvtpk(O[vb][4 * g + 2] * rs * bflo(gw.y), O[vb][4 * g + 3] * rs * bfhi(gw.y));
                *(u32x2*)(P.RO + idx) = o; }
    } else if (MODE == 1) {
        const float lt = lrun + shx(lrun, 32, lane), il = 1.0f / lt;
        LAS float* X = (LAS float*)lds + (size_t)rg * 64 * 64;
        if (pp == 1) {
#pragma unroll
            for (int vb = 0; vb < NVB; ++vb)
#pragma unroll
                for (int i = 0; i < 16; ++i) X[(vb * 16 + i) * 64 + lane] = O[vb][i] * il;
        }
        __syncthreads();
        if (pp == 0) {
            const float lam = ((const float*)(ws + WS_LAM))[PP.l], oml = ((const float*)(ws + WS_LAM))[2 + PP.l];
            float ss = 0.f;
#pragma unroll
            for (int vb = 0; vb < NVB; ++vb)
#pragma unroll
                for (int i = 0; i < 16; ++i) { const float v = O[vb][i] * il - lam * X[(vb * 16 + i) * 64 + lane]; O[vb][i] = v; ss += v * v; }
            ss += shx(ss, 32, lane);
            const float rs = oml / sqrtf(ss * (1.f / 128.f) + EPS);
#pragma unroll
            for (int vb = 0; vb < NVB; ++vb)
#pragma unroll
                for (int g = 0; g < 4; ++g) { const int dv = vb * 32 + 8 * g + 4 * h; const f32x4 gg = *(const f32x4*)(P.subg + dv);
                    u32x2 o; o.x = cvtpk(O[vb][4 * g] * rs * gg[0], O[vb][4 * g + 1] * rs * gg[1]); o.y = cvtpk(O[vb][4 * g + 2] * rs * gg[2], O[vb][4 * g + 3] * rs * gg[3]);
                    *(u32x2*)(P.DQ + trow * 1024 + hd * 128 + dv) = o; }
        }
    } else {
        const float lt = lrun + shx(lrun, 32, lane), il = 1.0f / lt;
#pragma unroll
        for (int vb = 0; vb < NVB; ++vb)
#pragma unroll
            for (int g = 0; g < 4; ++g) { u32x2 o; o.x = cvtpk(O[vb][4 * g] * il, O[vb][4 * g + 1] * il); o.y = cvtpk(O[vb][4 * g + 2] * il, O[vb][4 * g + 3] * il);
                *(u32x2*)(P.QMn + trow * 1024 + hd * 64 + vb * 32 + 8 * g + 4 * h) = o; }
    }
}
#pragma float_control(pop)
DI unsigned xcc_id_() { return (unsigned)__builtin_amdgcn_s_getreg((3 << 11) | 20) & 0xFu; }
DI void attn_phase(lptr lds, const AttnP P, unsigned* counter, const int wv) {
    const int x0 = (int)(xcc_id_() & 7u);
    for (int sft = 0; sft < 8; ++sft) {
        const int qx = (x0 + sft) & 7;
        for (;;) {
            __syncthreads();
            if (tidx(wv) == 0) *(LAS int*)(lds + A_MISC) = (int)atomicAdd(counter + qx, 1u);
            __syncthreads();
            const int idx = __builtin_amdgcn_readfirstlane(*(LAS int*)(lds + A_MISC));
            if (idx >= 320) break;
            if (idx < 128) { const int hg = idx >> 5, r = idx & 31; attn_unit<2>(lds, P, qx, hg * 4 + (r & 3), 7 - (r >> 2), wv); }
            else if (idx < 256) { const int j = idx - 128, hg = j >> 5, r = j & 31; attn_unit<1>(lds, P, qx, hg * 2 + (r & 1), 15 - (r >> 1), wv); }
            else { const int j = idx - 256, hg = j >> 5, r = j & 31; attn_unit<0>(lds, P, qx, hg * 2 + (r & 1), 15 - (r >> 1), wv); }
        }
    }
}

struct P4Order {
    pg8::StaticOrder so; int l, wv;
    __device__ void init(int G, int c, int l_) { so.init(TH, 1024, G, c); l = l_; }
    __device__ bool next(int i, pg8::Unit& u) const {
        const int kind = i % 6;
        if (!so.next(i / 6, u)) return false;
        u.rpm = u.pm; u.rpn = u.pn; u.kind = kind;
        const int br = kind >> 1;
        int apan, bpan;
        if (kind & 1) { apan = br == 0 ? (int)(WS_RO >> 19) : (br == 1 ? (int)(WS_DQ >> 19) : (int)(WS_QMN >> 19)); bpan = (int)(WS_W >> 19) + l * 90 + (int)(WO_RO / 262144) + 4 * br; }
        else { apan = (int)(WS_H >> 19); bpan = (int)(WS_W >> 19) + l * 90 + (int)(WO_G / 262144) + 4 * br; }
        u.pm += apan; u.pn += bpan;
        return true;
    }
    __device__ __forceinline__ void a_ready(const pg8::Unit&) const {}
    __device__ __forceinline__ void done(const pg8::Unit&) const {}
};
struct EpiP4 {
    static constexpr bool PERM = true, AFTER_DRAIN = false;
    bf16* G; float* M32; bf16* MG;
    DI void operator()(EPI_ARGS) const {
        pg8::Unit r = u; r.pm = u.rpm; r.pn = u.rpn;
        const size_t GS = (size_t)TH * 1024;
        switch (u.kind) {
            case 0: EpiAct<0>{G, 1024}(acc, r, wr, wc, fr, fq); break;
            case 1: EpiBranch<0>{G, M32, MG}(acc, r, wr, wc, fr, fq); break;
            case 2: EpiAct<0>{G + GS, 1024}(acc, r, wr, wc, fr, fq); break;
            case 3: EpiBranch<1>{G + GS, M32, MG}(acc, r, wr, wc, fr, fq); break;
            case 4: EpiAct<0>{G + 2 * GS, 1024}(acc, r, wr, wc, fr, fq); break;
            default: EpiBranch<2>{G + 2 * GS, M32, MG}(acc, r, wr, wc, fr, fq); break;
        }
    }
};

constexpr size_t WS_BAR = 131072;
#define XB_TMO      128
#define XB_XCNT(j)  (256  + 64 * (j))
#define XB_XSUB(j)  (1280 + 64 * (j))
#define XB_XGEN(j)  (2304 + 64 * (j))
#define XB_TOP      3328
#define XB_TOPGEN   3392
#define XCD_BAR_WORDS 3456
#define XB_SPIN_CAP (1u << 18)
constexpr int LDS_XB = 143360;
DI unsigned xb_ld(unsigned* p)              { return __hip_atomic_load(p, __ATOMIC_RELAXED, __HIP_MEMORY_SCOPE_AGENT); }
DI unsigned xb_add(unsigned* p, unsigned v) { return __hip_atomic_fetch_add(p, v, __ATOMIC_RELAXED, __HIP_MEMORY_SCOPE_AGENT); }
DI unsigned xb_xcc_id() { return (unsigned)__builtin_amdgcn_s_getreg((3 << 11) | 20) & 0xFu; }
#define XB_SPIN(cond, bar) do { unsigned _sp = 0; while (cond) { __builtin_amdgcn_s_sleep(1); \
    if ((++_sp & 255u) == 0u) { if (xb_ld(&(bar)[XB_TMO])) break; if (_sp > XB_SPIN_CAP) { atomicAdd(&(bar)[XB_TMO], 1u); break; } } } } while (0)
DI void xcd_barrier_complete(unsigned* bar, unsigned x, unsigned& nloc, unsigned& nx) {
    const unsigned G = gridDim.x;
    unsigned sum, cnt, mine, sp = 0u;
    for (;;) {
        sum = 0u; cnt = 0u; mine = 0u;
#pragma unroll
        for (unsigned j = 0; j < 16; ++j) { const unsigned c = xb_ld(&bar[XB_XCNT(j)]); sum += c; cnt += (c > 0u) ? 1u : 0u; mine = (j == x) ? c : mine; }
        if (sum == G) break;
        __builtin_amdgcn_s_sleep(1);
        if ((++sp & 255u) == 0u) { if (xb_ld(&bar[XB_TMO])) break; if (sp > XB_SPIN_CAP) { atomicAdd(&bar[XB_TMO], 1u); break; } }
    }
    nloc = mine > 0u ? mine : 1u; nx = cnt > 0u ? cnt : 1u;
}
DI void xcd_barrier(unsigned* bar, lptr lds, const int wv) {
    asm volatile("s_waitcnt vmcnt(0)" ::: "memory");
    __syncthreads();
    if (tidx(wv) == 0) {
        volatile LAS unsigned* st = (volatile LAS unsigned*)(lds + LDS_XB);
        const unsigned x = xb_xcc_id();
        __builtin_amdgcn_s_waitcnt(0);
        unsigned nloc = st[0], nx = st[1];
        if (nloc == 0u) { xcd_barrier_complete(bar, x, nloc, nx); st[0] = nloc; st[1] = nx; }
        const unsigned old = xb_add(&bar[XB_XSUB(x)], 1u);
        const unsigned gen = old / nloc;
        if (old + 1u == (gen + 1u) * nloc) {
            __builtin_amdgcn_fence(__ATOMIC_RELEASE, "agent");
            asm volatile("s_waitcnt vmcnt(0)" ::: "memory");
            const unsigned og = xb_add(&bar[XB_TOP], 1u);
            const unsigned tg = og / nx;
            if (og + 1u == (tg + 1u) * nx) xb_add(&bar[XB_TOPGEN], 1u);
            else XB_SPIN(xb_ld(&bar[XB_TOPGEN]) == tg, bar);
            __builtin_amdgcn_fence(__ATOMIC_ACQUIRE, "agent");
            xb_add(&bar[XB_XGEN(x)], 1u);
            asm volatile("s_waitcnt vmcnt(0)" ::: "memory");
        } else {
            XB_SPIN(xb_ld(&bar[XB_XGEN(x)]) == gen, bar);
            __builtin_amdgcn_fence(__ATOMIC_ACQUIRE, "agent");
            asm volatile("s_waitcnt vmcnt(0)" ::: "memory");
        }
    }
    __syncthreads();
}
constexpr int N_PHASES = 39;
template <class Epi> DI void run_gemm(lptr lds, int wv, const bf16* A, const bf16* Bt, int M, int N, int K, const Epi& E) {
#ifdef DIS_GEMM
    return;
#endif
    int bx_ = (int)blockIdx.x; asm volatile("" : "+s"(bx_));
    pg8::Gemm g{A, Bt, M, N, K}; pg8::StaticOrder S; S.init(M, N, (int)gridDim.x, bx_); S.wv = wv;
    pg8::gemm_phase<Epi, pg8::StaticOrder, true, true>(lds, g, S, E);
}
__global__ void __launch_bounds__(NTHR) mega_fwd(Params p) {
    extern __shared__ __attribute__((aligned(16))) unsigned char lds_raw[];
    lptr lds = (lptr)lds_raw;
#if !MK_MULTI
    cg::grid_group grid = cg::this_grid();
#endif
    const int wv = __builtin_amdgcn_readfirstlane((int)threadIdx.x >> 6);
#if !MK_MULTI
    if (threadIdx.x == 0) { ((volatile LAS unsigned*)(lds + LDS_XB))[0] = 0u; ((volatile LAS unsigned*)(lds + LDS_XB))[1] = 0u; (void)xb_add((unsigned*)(p.ws + WS_BAR) + XB_XCNT(xb_xcc_id()), 1u); }
    __syncthreads();
#endif
    int ph = p.ph_lo; const int ph_hi = p.ph_hi;
#ifdef MK_TS
#ifndef TS_DIV
#define TS_DIV 32.f
#endif
    if (blockIdx.x == 0 && threadIdx.x == 0) ((unsigned long long*)(p.ws + 262144))[0] = __builtin_amdgcn_s_memrealtime();
#endif
    if (ph == 0) {
#ifndef DIS_PRO
        prologue(p, lds, wv);
        norm_rows(p.x, p.pre_mix_g, (bf16*)(p.ws + WS_H), TH, wv);
#endif
        ++ph;
#if !MK_MULTI
        if (ph_hi < 0) grid.sync();
        if (ph < ph_hi) xcd_barrier((unsigned*)(p.ws + WS_BAR), lds, wv);
#endif
    }
    const float* xin0 = p.x; float* const outp = p.out; unsigned char* ws0 = p.ws;
    for (; ph < ph_hi; ++ph) {
        size_t z_ = 0; asm volatile("" : "+s"(z_));
        unsigned char* ws = ws0 + z_;
#ifdef MK_TS
        if (blockIdx.x == 0 && tidx(wv) == 0) ((unsigned long long*)(ws + 262144))[ph] = __builtin_amdgcn_s_memrealtime();
#endif
        const float* gains = (const float*)(ws + WS_GAIN);
        bf16* H = (bf16*)(ws + WS_H);
        const int hb = (ph - 1) / 19, k19 = (ph - 1) % 19;
        const size_t xoff = (size_t)hb * TH * DM;
        if (k19 == 0) continue;
        else {
            const int l = (k19 - 1) / 9, k = (k19 - 1) % 9;
            const bf16* Wb = (const bf16*)(ws + WS_W) + (size_t)l * WO_END;
            if (k == 0) {
                EpiIn1 E1{ws};
                run_gemm(lds, wv, H, Wb + WO_IN1, TH, 4608, 1024, E1);
                EpiVt E2{(bf16*)(ws + WS_RVT), (bf16*)(ws + WS_DVT), nullptr, 0.f};
                run_gemm(lds, wv, Wb + WO_V, H, 2048, TH, 1024, E2);
            } else if (k == 1) {
                EpiUq Eq{(bf16*)(ws + WS_QMN), (bf16*)(ws + WS_QMP), (const float*)(ws + WS_SSQ_CQ), (const float*)(ws + WS_MCOS), (const float*)(ws + WS_MSIN), wv};
                run_gemm(lds, wv, (const bf16*)(ws + WS_CQ), Wb + WO_UQ, TH, 1536, 256, Eq);
                EpiUk Ek{(bf16*)(ws + WS_KMN), (const float*)(ws + WS_SSQ_CKV)};
                run_gemm(lds, wv, (const bf16*)(ws + WS_CKV), Wb + WO_UK, TH, 1024, 256, Ek);
                EpiVt Ev{(bf16*)(ws + WS_VMT), (bf16*)(ws + WS_VMT), (const float*)(ws + WS_SSQ_CKV), 1.f / 128.f};
                run_gemm(lds, wv, Wb + WO_UV, (const bf16*)(ws + WS_CKV), 1024, TH, 256, Ev);
            } else if (k == 2) {
#ifndef DIS_ATTN
                AttnP P{ws, l};
                attn_phase(lds, P, (unsigned*)(ws + WS_CNT) + (hb * 2 + l) * 8, wv);
#endif
            } else if (k == 3) {
                bf16* G = (bf16*)(ws + WS_G); float* M32 = (float*)(ws + WS_M32); bf16* MG = (bf16*)(ws + WS_MG);
                const size_t GS = (size_t)TH * 1024;
                int bx_ = (int)blockIdx.x; asm volatile("" : "+s"(bx_));
                P4Order S; S.init((int)gridDim.x, bx_, l); S.wv = wv;
                pg8::Gemm g{(const bf16*)ws, (const bf16*)ws, TH, 1024, 1024};
                pg8::gemm_phase<EpiP4, P4Order, true, true>(lds, g, S, EpiP4{G, M32, MG});
                (void)Wb; (void)GS;
            } else if (k == 4) {
                run_gemm(lds, wv, (const bf16*)(ws + WS_MG), Wb + WO_OUT, TH, 1024, 1024, EpiY{(bf16*)(ws + WS_Y), (float*)(ws + WS_SSQ_Y)});
            } else if (k == 5) {
                resid_rows((l == 0 ? xin0 : (const float*)outp) + xoff, (const bf16*)(ws + WS_Y), (const float*)(ws + WS_SSQ_Y), gains + 2048 + l * DM, outp + xoff, gains + 4096 + l * DM, H, TH, wv);
            } else if (k == 6) {
                run_gemm(lds, wv, H, Wb + WO_UP, TH, DFF, 1024, EpiAct<1>{(bf16*)(ws + WS_U), DFF});
            } else if (k == 7) {
                run_gemm(lds, wv, (const bf16*)(ws + WS_U), Wb + WO_DOWN, TH, 1024, DFF, EpiY{(bf16*)(ws + WS_Y), (float*)(ws + WS_SSQ_Y)});
            } else {
                resid_rows(outp + xoff, (const bf16*)(ws + WS_Y), (const float*)(ws + WS_SSQ_Y), gains + 6144 + l * DM, outp + xoff, l == 0 ? gains + DM : nullptr, H, TH, wv, true);
                if (l == 1 && hb == 0) norm_rows(xin0 + (size_t)TH * DM, gains, H, TH, wv);
            }
        }
#if !MK_MULTI
        if (ph + 1 < ph_hi) xcd_barrier((unsigned*)(ws + WS_BAR), lds, wv);
#endif
    }
#ifdef MK_TS
    if (blockIdx.x == 0 && tidx(wv) == 0) {
        unsigned long long* ts = (unsigned long long*)(ws0 + 262144); ts[N_PHASES] = __builtin_amdgcn_s_memrealtime();
        unsigned long long sum = 0;
        for (int q = 1; q < N_PHASES; ++q) { const int k19 = (q - 1) % 19; const int k = k19 == 0 ? 9 : (k19 - 1) % 9; if (MK_TS == k || (MK_TS == 10 && (k == 6 || k == 7)) || (MK_TS == 11 && (k == 5 || k == 8 || k == 9)) || MK_TS == 12) sum += ts[q + 1] - ts[q]; }
        if (MK_TS == 13) sum = ts[1] - ts[0];
        outp[0] = (float)sum * (0.01f / TS_DIV);
    }
#endif
}

extern "C" void kernel_launch(void* const* d_in, const int* in_sizes, int n_in, void* d_out, int out_size, void* d_ws, size_t ws_size, hipStream_t stream) {
    static int grid = 0;
    if (grid == 0) {
        if (n_in != 22 || ws_size < WS_END) { fprintf(stderr, "kernel_launch: unexpected inputs (n_in %d, ws %zu)\n", n_in, ws_size); grid = -1; return; }
        int dev = 0, cus = 0, per_cu = 0;
        hipGetDevice(&dev); hipDeviceGetAttribute(&cus, hipDeviceAttributeMultiprocessorCount, dev);
        if (hipFuncSetAttribute((const void*)mega_fwd, hipFuncAttributeMaxDynamicSharedMemorySize, LDS_BYTES) != hipSuccess) { fprintf(stderr, "kernel_launch: hipFuncSetAttribute failed\n"); grid = -1; return; }
        if (hipOccupancyMaxActiveBlocksPerMultiprocessor(&per_cu, (const void*)mega_fwd, NTHR, LDS_BYTES) != hipSuccess || per_cu < 1) { fprintf(stderr, "kernel_launch: occupancy query gave %d\n", per_cu); per_cu = 1; }
        (void)hipGetLastError();
        grid = cus * per_cu;
        if (grid > 256) grid = 256;
    }
    if (grid < 0) return;
    Params p{};
    const float** pf = (const float**)&p;
    for (int i = 0; i < 22; ++i) pf[i] = (const float*)d_in[i];
    p.out = (float*)d_out; p.ws = (unsigned char*)d_ws;
#if MK_MULTI
#ifdef MK_CHECK
    hipLaunchKernelGGL(chk_clear, dim3(1), dim3(128), 0, stream, (unsigned char*)d_ws);
#endif
    for (int ph = 0; ph < N_PHASES; ++ph) { p.ph_lo = ph; p.ph_hi = ph + 1; hipLaunchKernelGGL(mega_fwd, dim3(grid), dim3(NTHR), LDS_BYTES, stream, p);
#ifdef MK_CHECK
        if (ph >= 1) hipLaunchKernelGGL(chk, dim3(256), dim3(256), 0, stream, p, ph);
#endif
    }
#ifdef MK_CHECK
    hipLaunchKernelGGL(chk_report, dim3(1), dim3(64), 0, stream, (unsigned char*)d_ws, (float*)d_out);
#endif
#else
    p.ph_lo = 0; p.ph_hi = N_PHASES;
    if (hipMemsetAsync((char*)d_ws + WS_BAR, 0, XCD_BAR_WORDS * 4, stream) != hipSuccess) { fprintf(stderr, "kernel_launch: memset of the barrier words failed\n"); return; }
    void* args[] = {&p};
    hipError_t e = hipLaunchCooperativeKernel((const void*)mega_fwd, dim3(grid), dim3(NTHR), args, LDS_BYTES, stream);
    if (e != hipSuccess) fprintf(stderr, "cooperative launch failed: %s (grid %d)\n", hipGetErrorString(e), grid);
#endif
}
```
